# Optimizing an MI355X kernel written in HIP

```python
import jax, jax.numpy as jnp
from jax import lax
import numpy as np

D_MODEL = 1024
BATCH = 2
SEQ = 8192
DEPTH = 2

GRID_W = 64
RMS_EPS = 1e-6

ML_WIDTH = D_MODEL
ML_HEADS = 4
ML_HEAD_DIM = ML_WIDTH // ML_HEADS
ML_CHUNK = 64

NA_WIDTH = D_MODEL
NA_HEADS = 16
NA_HEAD_DIM = NA_WIDTH // NA_HEADS
NA_KH = 8
NA_KW = 16

GQ_WIDTH = D_MODEL
GQ_HEADS = 8
GQ_HEAD_DIM = GQ_WIDTH // GQ_HEADS
GQ_KV_HEADS = 2
GQ_KV_WIDTH = GQ_KV_HEADS * GQ_HEAD_DIM
GQ_BLOCK = 128
ROPE_THETA = 10000.0
ROPE_HALF = GQ_HEAD_DIM // 4

CV_WIDTH = D_MODEL
CV_K = 3

EVEN_SPLIT = (ML_WIDTH,) * 5 + (4 * ML_HEADS,) + (NA_WIDTH,) * 4
ODD_SPLIT = (GQ_WIDTH, GQ_KV_WIDTH, GQ_KV_WIDTH, GQ_WIDTH) + (CV_WIDTH,) * 4
EVEN_IN = sum(EVEN_SPLIT)
ODD_IN = sum(ODD_SPLIT)
MIX_EVEN = ML_WIDTH + NA_WIDTH
MIX_ODD = GQ_WIDTH + CV_WIDTH

kernel_name = "hybrid_mlstm_natten_gqa_shortconv_encoder"


def _split(a, sizes):
    return jnp.split(a, np.cumsum(sizes)[:-1].tolist(), axis=-1)


def rmsnorm(x, g):
    x32 = x.astype(jnp.float32)
    y = x32 * lax.rsqrt(jnp.mean(x32 * x32, axis=-1, keepdims=True) + RMS_EPS)
    return (y * g.astype(jnp.float32)).astype(x.dtype)


def mlstm_scan(q, k, v, ig, lf):
    B, H, S, dh = q.shape
    L = ML_CHUNK
    nc = S // L

    def chunks(a):
        return jnp.moveaxis(a.reshape(B, H, nc, L, *a.shape[3:]), 2, 0)

    tril = jnp.tril(jnp.ones((L, L), dtype=bool))

    def step(carry, xs):
        c_mat, n_vec, m = carry
        qc, kc, vc, igc, lfc = xs
        b = jnp.cumsum(lfc, axis=-1)
        g = b[..., -1]
        d = jnp.where(tril, b[..., :, None] - b[..., None, :] + igc[..., None, :], -jnp.inf)
        inter = b + m[..., None]
        m_t = jnp.maximum(inter, jnp.max(d, axis=-1))
        w = jnp.exp(d - m_t[..., None]) * jnp.einsum('bhtd,bhsd->bhts', qc, kc)
        decay = jnp.exp(inter - m_t)
        num = decay[..., None] * jnp.einsum('bhvk,bhtk->bhtv', c_mat, qc) + jnp.einsum('bhts,bhsv->bhtv', w, vc)
        den = decay * jnp.einsum('bhk,bhtk->bht', n_vec, qc) + jnp.sum(w, axis=-1)
        h = num / jnp.maximum(jnp.abs(den), jnp.exp(-m_t))[..., None]
        a = g[..., None] - b + igc
        m_new = jnp.maximum(g + m, jnp.max(a, axis=-1))
        carry_scale = jnp.exp(g + m - m_new)
        wk = jnp.exp(a - m_new[..., None])
        c_new = carry_scale[..., None, None] * c_mat + jnp.einsum('bhsv,bhsk->bhvk', wk[..., None] * vc, kc)
        n_new = carry_scale[..., None] * n_vec + jnp.einsum('bhs,bhsk->bhk', wk, kc)
        return (c_new, n_new, m_new), h

    f32 = jnp.float32
    init = (jnp.zeros((B, H, dh, dh), f32), jnp.zeros((B, H, dh), f32), jnp.zeros((B, H), f32))
    _, h = lax.scan(step, init, (chunks(q), chunks(k), chunks(v), chunks(ig), chunks(lf)))
    return jnp.moveaxis(h, 0, 2).reshape(B, H, S, dh)


def mlstm_branch(q, k, v, o, z, gates, gate_b, norm_g):
    B, S, _ = q.shape
    f32 = jnp.float32

    def heads(a):
        return a.reshape(B, S, ML_HEADS, ML_HEAD_DIM).transpose(0, 2, 1, 3).astype(f32)

    qh, kh, vh = heads(q), heads(k) * (ML_HEAD_DIM ** -0.5), heads(v)
    g = (gates.astype(f32) + gate_b.astype(f32)).reshape(B, S, 4, ML_HEADS).transpose(2, 0, 3, 1)
    ig_f, lf_f = g[0], jax.nn.log_sigmoid(g[1])
    ig_b, lf_b = g[2], jax.nn.log_sigmoid(g[3])
    h_f = mlstm_scan(qh, kh, vh, ig_f, lf_f)
    rev = lambda a: jnp.flip(a, axis=2)
    h_b = rev(mlstm_scan(rev(qh), rev(kh), rev(vh), rev(ig_b), rev(lf_b)))
    h = h_f + h_b
    h = h * lax.rsqrt(jnp.mean(h * h, axis=-1, keepdims=True) + RMS_EPS)
    h = h.transpose(0, 2, 1, 3).reshape(B, S, ML_WIDTH) * norm_g.astype(f32)
    out = h * jax.nn.sigmoid(o.astype(f32)) * jax.nn.silu(z.astype(f32))
    return out.astype(q.dtype)


def na_branch(q, k, v, z, rpb):
    B, S, _ = q.shape
    rows = S // GRID_W
    kh = min(NA_KH, rows)

    def grid(a):
        return a.reshape(B, rows, GRID_W, NA_HEADS, NA_HEAD_DIM).transpose(0, 3, 1, 2, 4)

    qg, kg, vg = grid(q) * (NA_HEAD_DIM ** -0.5), grid(k), grid(v)
    c = jnp.arange(GRID_W)
    c0 = jnp.clip(c - NA_KW // 2, 0, GRID_W - NA_KW)
    col_idx = c0[:, None] + jnp.arange(NA_KW)[None, :]
    dc = col_idx - c[:, None] + (NA_KW - 1)

    def row(r):
        r0 = jnp.clip(r - kh // 2, 0, rows - kh)
        kr = lax.dynamic_slice_in_dim(kg, r0, kh, axis=2)
        vr = lax.dynamic_slice_in_dim(vg, r0, kh, axis=2)
        kw = jnp.take(kr, col_idx, axis=3)
        vw = jnp.take(vr, col_idx, axis=3)
        qr = lax.dynamic_index_in_dim(qg, r, axis=2, keepdims=False)
        s = jnp.einsum('bhcd,bhicjd->bhcij', qr, kw).astype(jnp.float32)
        dr = r0 + jnp.arange(kh) - r + (NA_KH - 1)
        bias = rpb[:, dr[None, :, None], dc[:, None, :]]
        s = s + bias.astype(jnp.float32)
        p = jax.nn.softmax(s.reshape(B, NA_HEADS, GRID_W, kh * NA_KW), axis=-1).reshape(s.shape)
        return jnp.einsum('bhcij,bhicjd->bhcd', p.astype(vw.dtype), vw)

    out = lax.map(row, jnp.arange(rows))
    out = out.transpose(1, 0, 3, 2, 4).reshape(B, S, NA_WIDTH)
    return out * jax.nn.silu(z)


def axial_rope_tables(S):
    t = jnp.arange(S)
    pos = jnp.stack([t // GRID_W, t % GRID_W], axis=-1).astype(jnp.float32)
    inv = ROPE_THETA ** (-jnp.arange(ROPE_HALF, dtype=jnp.float32) / ROPE_HALF)
    ang = pos[:, :, None] * inv
    return jnp.cos(ang)[:, None], jnp.sin(ang)[:, None]


def apply_rope(x, cos, sin):
    xs = x.astype(jnp.float32).reshape(*x.shape[:-1], 2, 2, ROPE_HALF)
    x1, x2 = xs[..., 0, :], xs[..., 1, :]
    out = jnp.stack([x1 * cos - x2 * sin, x1 * sin + x2 * cos], axis=-2)
    return out.reshape(x.shape).astype(x.dtype)


def gqa_branch(q, k, v, z, qn_g, kn_g):
    B, S, _ = q.shape
    qh = rmsnorm(q.reshape(B, S, GQ_HEADS, GQ_HEAD_DIM), qn_g)
    kh = rmsnorm(k.reshape(B, S, GQ_KV_HEADS, GQ_HEAD_DIM), kn_g)
    vh = v.reshape(B, S, GQ_KV_HEADS, GQ_HEAD_DIM)
    cos, sin = axial_rope_tables(S)
    qh, kh = apply_rope(qh, cos, sin), apply_rope(kh, cos, sin)
    grp = GQ_HEADS // GQ_KV_HEADS
    nb = S // GQ_BLOCK
    qb = qh.reshape(B, nb, GQ_BLOCK, GQ_KV_HEADS, grp, GQ_HEAD_DIM).transpose(1, 0, 3, 4, 2, 5)
    qb = qb * (GQ_HEAD_DIM ** -0.5)
    kt = kh.transpose(0, 2, 1, 3)
    vt = vh.transpose(0, 2, 1, 3)

    def block(qblk):
        s = jnp.einsum('bkgqd,bksd->bkgqs', qblk, kt).astype(jnp.float32)
        p = jax.nn.softmax(s, axis=-1).astype(vt.dtype)
        return jnp.einsum('bkgqs,bksd->bkgqd', p, vt)

    out = lax.map(block, qb)
    out = out.transpose(1, 0, 4, 2, 3, 5).reshape(B, S, GQ_WIDTH)
    return out * jax.nn.silu(z)


def conv_branch(bg, cg, xin, z, w, b):
    xc = cg * xin
    xp = jnp.pad(xc, ((0, 0), (1, 1), (0, 0)))
    y = xp[:, :-2] * w[0] + xp[:, 1:-1] * w[1] + xp[:, 2:] * w[2] + b
    return bg * y * jax.nn.silu(z)


def even_mixer(u, w_in, gate_b, w_out, ml_norm_g, na_rpb):
    p = u @ w_in
    ml_q, ml_k, ml_v, ml_o, ml_z, ml_gates, na_q, na_k, na_v, na_z = _split(p, EVEN_SPLIT)
    a = mlstm_branch(ml_q, ml_k, ml_v, ml_o, ml_z, ml_gates, gate_b, ml_norm_g)
    bb = na_branch(na_q, na_k, na_v, na_z, na_rpb)
    return jnp.concatenate([a, bb], axis=-1) @ w_out


def odd_mixer(u, w_in, w_out, q_norm_g, k_norm_g, conv_w, conv_b):
    p = u @ w_in
    g_q, g_k, g_v, g_z, c_b, c_c, c_x, c_z = _split(p, ODD_SPLIT)
    a = gqa_branch(g_q, g_k, g_v, g_z, q_norm_g, k_norm_g)
    d = conv_branch(c_b, c_c, c_x, c_z, conv_w, conv_b)
    return jnp.concatenate([a, d], axis=-1) @ w_out


def setup_inputs(seed: int = 0) -> dict:
    key = jax.random.key(seed)
    ks = jax.random.split(key, 14)
    n_even = (DEPTH + 1) // 2
    n_odd = DEPTH // 2
    f32 = jnp.float32

    def nrm(k, shape, scale):
        return jax.random.normal(k, shape, f32) * scale

    f_base = jnp.linspace(3.0, 6.0, ML_HEADS, dtype=f32)
    z_h = jnp.zeros((ML_HEADS,), f32)
    gate_base = jnp.concatenate([z_h, f_base, z_h, f_base])
    return {
        "x": nrm(ks[0], (BATCH, SEQ, D_MODEL), 1.0),
        "norm_g": 1.0 + nrm(ks[1], (DEPTH, D_MODEL), 0.02),
        "final_g": 1.0 + nrm(ks[2], (D_MODEL,), 0.02),
        "ev_w_in": nrm(ks[3], (n_even, D_MODEL, EVEN_IN), D_MODEL ** -0.5),
        "ev_gate_b": gate_base + nrm(ks[4], (n_even, 4 * ML_HEADS), 0.1),
        "ev_w_out": nrm(ks[5], (n_even, MIX_EVEN, D_MODEL), MIX_EVEN ** -0.5),
        "ev_ml_norm_g": 1.0 + nrm(ks[6], (n_even, ML_WIDTH), 0.02),
        "ev_na_rpb": nrm(ks[7], (n_even, NA_HEADS, 2 * NA_KH - 1, 2 * NA_KW - 1), 0.1),
        "od_w_in": nrm(ks[8], (n_odd, D_MODEL, ODD_IN), D_MODEL ** -0.5),
        "od_w_out": nrm(ks[9], (n_odd, MIX_ODD, D_MODEL), MIX_ODD ** -0.5),
        "od_q_norm_g": 1.0 + nrm(ks[10], (n_odd, GQ_HEAD_DIM), 0.02),
        "od_k_norm_g": 1.0 + nrm(ks[11], (n_odd, GQ_HEAD_DIM), 0.02),
        "od_conv_w": nrm(ks[12], (n_odd, CV_K, CV_WIDTH), CV_K ** -0.5),
        "od_conv_b": nrm(ks[13], (n_odd, CV_WIDTH), 0.02),
    }


def reference(x, norm_g, final_g, ev_w_in, ev_gate_b, ev_w_out, ev_ml_norm_g, ev_na_rpb,
              od_w_in, od_w_out, od_q_norm_g, od_k_norm_g, od_conv_w, od_conv_b):
    h = x
    for layer in range(DEPTH):
        u = rmsnorm(h, norm_g[layer])
        j = layer // 2
        if layer % 2 == 0:
            y = even_mixer(u, ev_w_in[j], ev_gate_b[j], ev_w_out[j], ev_ml_norm_g[j], ev_na_rpb[j])
        else:
            y = odd_mixer(u, od_w_in[j], od_w_out[j], od_q_norm_g[j], od_k_norm_g[j],
                          od_conv_w[j], od_conv_b[j])
        h = h + y.astype(h.dtype)
    return rmsnorm(h, final_g)
```

```cpp
#include <hip/hip_runtime.h>
#include <cstdio>
#include <cstdint>
#include <cmath>
namespace pg8 {
#define PG8_LAS __attribute__((address_space(3)))
typedef unsigned short bf16_t;
typedef short bf16x8 __attribute__((ext_vector_type(8)));
typedef float f32x4 __attribute__((ext_vector_type(4)));
typedef unsigned u32x4 __attribute__((ext_vector_type(4)));
constexpr int BM = 256, BK = 64, HALF = 128, HTB = HALF * BK * 2  , STAGE_BYTES = 8 * HTB, NXCD = 8, WGM = 8;

__host__ __device__ __forceinline__ int lds_byte(int r, int c) { const int st = (r >> 4) * 2 + (c >> 5), rr = r & 15, cc = c & 31, ob = rr * 64 + cc * 2; return st * 1024 + (ob ^ (((ob >> 9) & 1) << 5)); }
__host__ __device__ __forceinline__ void stage_rc(int b, int& R, int& C) { const int st = b / 1024, sb = b % 1024, swz = sb ^ (((sb >> 9) & 1) << 5); R = (st >> 1) * 16 + swz / 64; C = (st & 1) * 32 + (swz % 64) / 2; }
__host__ __device__ __forceinline__ int perm32(int rho) { const int n = rho >> 4, i = rho & 15; return 8 * (i >> 2) + 4 * n + (i & 3); }

struct Unit { int pm, pn; };
struct Gemm { const bf16_t* A; const bf16_t* Bt; int M, N, K; };

struct StaticOrder {
    int nM, nN, nwg, G, c;
    __host__ __device__ void init(int M, int N, int G_, int c_) { nM = M / BM; nN = N / BM; nwg = nM * nN; G = G_; c = c_; }
    __host__ __device__ bool next(int i, Unit& u) const {
        const long L = (long)i * G + c; if (L >= nwg) return false;
        int wgid = (int)L; { const int q = nwg / NXCD, r = nwg % NXCD, xcd = wgid % NXCD, off = wgid / NXCD; wgid = (xcd < r ? xcd * (q + 1) : r * (q + 1) + (xcd - r) * q) + off; }
        const int nig = WGM * nN, gid = wgid / nig, fm = gid * WGM, gsz = (nM - fm) < WGM ? (nM - fm) : WGM;
        u.pm = fm + ((wgid % nig) % gsz); u.pn = (wgid % nig) / gsz; return true;
    }
    __device__ __forceinline__ void a_ready(const Unit&) const {}
    __device__ __forceinline__ void done(const Unit&) const {}
};

typedef float f32x2 __attribute__((ext_vector_type(2)));
typedef __bf16 bf16x2_t __attribute__((ext_vector_type(2)));
__device__ __forceinline__ unsigned cvt_pk_bf16(float lo, float hi) { f32x2 v = {lo, hi}; bf16x2_t b = __builtin_convertvector(v, bf16x2_t); return __builtin_bit_cast(unsigned, b); }
__device__ __forceinline__ float fexp(float x) { return __builtin_amdgcn_exp2f(x * 1.4426950408889634f); }
__device__ __forceinline__ float sigm(float x) { return __builtin_amdgcn_rcpf(1.f + fexp(-x)); }
__device__ __forceinline__ float silu(float x) { return x * sigm(x); }

struct TileOut { bf16_t* dst; int ldc; int col0; int mode; float scale; };
struct EpiAct {
    static constexpr bool PERM = true, AFTER_DRAIN = false;
    int gid;
    bf16_t *T0, *T1, *T2, *T3, *T4, *T5;
    const float* rs; int rs_mode;
    __device__ __forceinline__ TileOut tile(int pn) const {
        TileOut t;
        if (gid == 0) {
            if (pn < 4)       t = TileOut{T0, 1024, 256 * pn, 0, 1.f};
            else if (pn < 8)  t = TileOut{T1, 1024, 256 * (pn - 4), 0, 0.0625f};
            else if (pn < 12) t = TileOut{T2, 1024, 256 * (pn - 8), 0, 1.f};
            else              t = TileOut{T3, 1024, 128 * (pn - 12), 2, 1.f};
        } else if (gid == 1) {
            if (pn < 4)       t = TileOut{T0, 1024, 256 * pn, 0, 0.125f};
            else if (pn < 8)  t = TileOut{T1, 1024, 256 * (pn - 4), 0, 1.f};
            else if (pn < 12) t = TileOut{T2, 1024, 256 * (pn - 8), 0, 1.f};
            else              t = TileOut{T3, 1024, 256 * (pn - 12), 1, 1.f};
        } else {
            if (pn < 4)        t = TileOut{T0, 1024, 256 * pn, 0, 1.f};
            else if (pn == 4)  t = TileOut{T1, 256, 0, 0, 1.f};
            else if (pn == 5)  t = TileOut{T2, 256, 0, 0, 1.f};
            else if (pn < 10)  t = TileOut{T3, 1024, 256 * (pn - 6), 1, 1.f};
            else if (pn < 18)  t = TileOut{T4, 1024, 128 * (pn - 10), 3, 1.f};
            else               t = TileOut{T5, 1024, 128 * (pn - 18), 4, 1.f};
        }
        return t;
    }
    __device__ __forceinline__ void operator()(const f32x4 (&acc)[2][2][4][2], const Unit& u, int wr, int wc, int fr, int fq) const {
        const TileOut t = tile(u.pn);
        const int rbase = u.pm * BM + wr * 64 + fr, cl = wc * 32 + 8 * fq;
#pragma unroll
        for (int ai = 0; ai < 2; ++ai)
#pragma unroll
            for (int m = 0; m < 4; ++m) {
                const int row = rbase + ai * HALF + m * 16;
                float r = t.scale;
                if (rs_mode == 1) r *= rs[row];
                else if (rs_mode == 2) { const f32x4* pp = (const f32x4*)(rs + (size_t)row * 16); const f32x4 a = pp[0], b = pp[1], c = pp[2], d = pp[3];
                    const float s = ((a[0] + a[1]) + (a[2] + a[3])) + ((b[0] + b[1]) + (b[2] + b[3])) + ((c[0] + c[1]) + (c[2] + c[3])) + ((d[0] + d[1]) + (d[2] + d[3]));
                    r *= __builtin_amdgcn_rsqf(s * (1.f / 1024.f) + 1e-6f); }
                bf16_t* rowp = t.dst + (size_t)row * t.ldc + t.col0 + cl;
                if (t.mode <= 1) {
#pragma unroll
                    for (int bj = 0; bj < 2; ++bj) { f32x4 v0 = acc[ai][bj][m][0] * r, v1 = acc[ai][bj][m][1] * r;
                        if (t.mode == 1) {
#pragma unroll
                            for (int j = 0; j < 4; ++j) { v0[j] = silu(v0[j]); v1[j] = silu(v1[j]); } }
                        u32x4 w; w.x = cvt_pk_bf16(v0[0], v0[1]); w.y = cvt_pk_bf16(v0[2], v0[3]); w.z = cvt_pk_bf16(v1[0], v1[1]); w.w = cvt_pk_bf16(v1[2], v1[3]);
                        *(u32x4*)(rowp + bj * HALF) = w; }
                } else {
                    f32x4 o[2];
#pragma unroll
                    for (int n = 0; n < 2; ++n) { const f32x4 a = acc[ai][0][m][n] * r, b = acc[ai][1][m][n] * r;
#pragma unroll
                        for (int j = 0; j < 4; ++j) o[n][j] = (t.mode == 2) ? sigm(a[j]) * silu(b[j]) : (t.mode == 3) ? a[j] * b[j] : a[j] * silu(b[j]); }
                    u32x4 w; w.x = cvt_pk_bf16(o[0][0], o[0][1]); w.y = cvt_pk_bf16(o[0][2], o[0][3]); w.z = cvt_pk_bf16(o[1][0], o[1][1]); w.w = cvt_pk_bf16(o[1][2], o[1][3]);
                    *(u32x4*)rowp = w;
                }
            }
    }
};
struct EpiResid {
    static constexpr bool PERM = false, AFTER_DRAIN = false;
    const float* base; float* out; bf16_t* outb; float* part;
    __device__ __forceinline__ void operator()(const f32x4 (&acc)[2][2][4][2], const Unit& u, int wr, int wc, int fr, int fq) const {
        typedef unsigned u32x2v __attribute__((ext_vector_type(2)));
        const int col0 = u.pn * BM + wc * 32 + 4 * fq;
#pragma unroll
        for (int ai = 0; ai < 2; ++ai)
#pragma unroll
            for (int m = 0; m < 4; ++m) { const int row = u.pm * BM + ai * HALF + wr * 64 + m * 16 + fr; const size_t off = (size_t)row * 1024 + col0; float ss = 0.f;
#pragma unroll
                for (int bj = 0; bj < 2; ++bj)
#pragma unroll
                    for (int n = 0; n < 2; ++n) { const f32x4 bs = *(const f32x4*)(base + off + bj * HALF + n * 16); const f32x4 o = bs + acc[ai][bj][m][n];
                        *(f32x4*)(out + off + bj * HALF + n * 16) = o; ss += (o[0] * o[0] + o[1] * o[1]) + (o[2] * o[2] + o[3] * o[3]);
                        if (outb) { u32x2v w; w.x = cvt_pk_bf16(o[0], o[1]); w.y = cvt_pk_bf16(o[2], o[3]); *(u32x2v*)(outb + off + bj * HALF + n * 16) = w; } }
                ss += __shfl_xor(ss, 16); ss += __shfl_xor(ss, 32);
                if (part && fq == 0) part[(size_t)row * 16 + u.pn * 4 + wc] = ss;
                if (m & 1) asm volatile("" ::: "memory"); }
    }
};

template <class Epi, class Sched, bool ALIGN_EPI = false, bool SP2 = false>
__device__ __forceinline__ void gemm_phase(PG8_LAS unsigned char* lds, const Gemm g, const Sched& S, const Epi& E) {
    const int tid = threadIdx.x, wid = __builtin_amdgcn_readfirstlane(tid >> 6), lane = tid & 63, wr = wid >> 2, wc = wid & 3, fr = lane & 15, fq = lane >> 4;
    const int K = g.K, nt = K / BK;
    unsigned voffA[2], voffB[2];
#pragma unroll
    for (int i = 0; i < 2; ++i) { int R, C; stage_rc(tid * 16 + i * 8192, R, C); const int Rb = Epi::PERM ? ((R & ~31) + perm32(R & 31)) : R;
        voffA[i] = (unsigned)(R * K + C) * 2u; voffB[i] = (unsigned)(Rb * K + C) * 2u; }
    const size_t kstep = (size_t)(BK * 2);
    const size_t hstep = (size_t)HALF * K * 2;
    const size_t tstep = 2 * hstep;
    const unsigned ldsw = (unsigned)wid * 1024u;
    const int aoff = lds_byte(wr * 64 + fr, fq * 8), boff = lds_byte(wc * 32 + fr, fq * 8);
#define PG8_SA(b, h) (((b) * 2 + (h)) * HTB)
#define PG8_SB(b, h) ((4 + (b) * 2 + (h)) * HTB)
#define PG8_STAGE(bufoff, gbase, voff) do { _Pragma("unroll") for (int _i = 0; _i < 2; ++_i) \
        __builtin_amdgcn_global_load_lds((const unsigned*)((const char*)(gbase) + (voff)[_i]), (PG8_LAS unsigned*)(lds + (bufoff) + ldsw + _i * 8192), 16, 0, 0); } while (0)
#define PG8_LDA(dst, b, h) do { _Pragma("unroll") for (int m = 0; m < 4; ++m) _Pragma("unroll") for (int k = 0; k < 2; ++k) dst[m][k] = *(const PG8_LAS bf16x8*)(lds + PG8_SA(b, h) + aoff + m * 2048 + k * 1024); } while (0)
#define PG8_LDB(dst, b, h) do { _Pragma("unroll") for (int n = 0; n < 2; ++n) _Pragma("unroll") for (int k = 0; k < 2; ++k) dst[n][k] = *(const PG8_LAS bf16x8*)(lds + PG8_SB(b, h) + boff + n * 2048 + k * 1024); } while (0)
#define PG8_MMA(ai, bj, At, Bt) do { __builtin_amdgcn_s_setprio(1); _Pragma("unroll") for (int m = 0; m < 4; ++m) _Pragma("unroll") for (int n = 0; n < 2; ++n) _Pragma("unroll") for (int k = 0; k < 2; ++k) \
        acc[ai][bj][m][n] = __builtin_amdgcn_mfma_f32_16x16x32_bf16(Bt[n][k], At[m][k], acc[ai][bj][m][n], 0, 0, 0); __builtin_amdgcn_s_setprio(0); } while (0)
#define PG8_WAIT_V(n) asm volatile("s_waitcnt vmcnt(" #n ")" ::: "memory")
#define PG8_WAIT_L(n) asm volatile("s_waitcnt lgkmcnt(" #n ")" ::: "memory")
#define PG8_BAR __builtin_amdgcn_s_barrier()
#define PG8_SCHED __builtin_amdgcn_sched_barrier(0)
    Unit cur, nxt; int ui = 0;
    if (!S.next(0, cur)) return;
    f32x4 acc[2][2][4][2];
#pragma unroll
    for (int a = 0; a < 2; ++a)
#pragma unroll
        for (int b = 0; b < 2; ++b)
#pragma unroll
            for (int m = 0; m < 4; ++m)
#pragma unroll
                for (int n = 0; n < 2; ++n) acc[a][b][m][n] = (f32x4){0.f, 0.f, 0.f, 0.f};
    bf16x8 At[4][2], B0[2][2], B1[2][2];
    const char* cA = (const char*)g.A + (size_t)cur.pm * tstep; const char* cB = (const char*)g.Bt + (size_t)cur.pn * tstep;
    S.a_ready(cur);
    if constexpr (SP2) {
        PG8_STAGE(PG8_SB(0, 0), cB, voffB); PG8_STAGE(PG8_SB(0, 1), cB + hstep, voffB); PG8_STAGE(PG8_SA(0, 0), cA, voffA); PG8_STAGE(PG8_SA(0, 1), cA + hstep, voffA);
        if (wr == 1) PG8_BAR;
        PG8_WAIT_V(2); PG8_BAR;
        PG8_STAGE(PG8_SB(1, 0), cB + kstep, voffB); PG8_STAGE(PG8_SA(1, 0), cA + kstep, voffA); PG8_STAGE(PG8_SB(1, 1), cB + hstep + kstep, voffB);
        PG8_WAIT_V(6); PG8_BAR;
    } else {
        PG8_STAGE(PG8_SB(0, 0), cB, voffB); PG8_STAGE(PG8_SA(0, 0), cA, voffA); PG8_STAGE(PG8_SB(0, 1), cB + hstep, voffB); PG8_STAGE(PG8_SA(0, 1), cA + hstep, voffA);
        if (wr == 1) PG8_BAR;
        PG8_WAIT_V(4); PG8_BAR;
        PG8_STAGE(PG8_SB(1, 0), cB + kstep, voffB); PG8_STAGE(PG8_SA(1, 0), cA + kstep, voffA); PG8_STAGE(PG8_SB(1, 1), cB + hstep + kstep, voffB);
        PG8_WAIT_V(6); PG8_BAR;
    }
    for (;;) {
        const bool has_next = S.next(ui + 1, nxt);
        const char* nA = has_next ? (const char*)g.A + (size_t)nxt.pm * tstep : cA; const char* nB = has_next ? (const char*)g.Bt + (size_t)nxt.pn * tstep : cB;
        for (int t = 0; t < nt; t += 2) {
            const bool last = (t == nt - 2);
            const char* a1 = cA + (size_t)(t + 1) * kstep;
            const char* a2 = last ? nA : cA + (size_t)(t + 2) * kstep; const char* b2 = last ? nB : cB + (size_t)(t + 2) * kstep;
            const char* a3 = a2 + kstep; const char* b3 = b2 + kstep;
            if (last && has_next) S.a_ready(nxt);
            if constexpr (SP2) {
            PG8_LDB(B0, 0, 0); PG8_LDB(B1, 0, 1); PG8_SCHED; PG8_LDA(At, 0, 0); PG8_STAGE(PG8_SA(1, 1), a1 + hstep, voffA);
            PG8_WAIT_V(8); PG8_WAIT_L(0); PG8_BAR; PG8_MMA(0, 0, At, B0); PG8_MMA(0, 1, At, B1); PG8_BAR; PG8_SCHED;
            PG8_LDA(At, 0, 1); PG8_STAGE(PG8_SB(0, 0), b2, voffB); PG8_STAGE(PG8_SB(0, 1), b2 + hstep, voffB); PG8_STAGE(PG8_SA(0, 0), a2, voffA);
            PG8_WAIT_V(8); PG8_WAIT_L(0); PG8_BAR; PG8_MMA(1, 0, At, B0); PG8_MMA(1, 1, At, B1); PG8_BAR; PG8_SCHED;
            PG8_LDB(B0, 1, 0); PG8_LDB(B1, 1, 1); PG8_SCHED; PG8_LDA(At, 1, 0); PG8_STAGE(PG8_SA(0, 1), a2 + hstep, voffA);
            PG8_WAIT_V(8); PG8_WAIT_L(0); PG8_BAR; PG8_MMA(0, 0, At, B0); PG8_MMA(0, 1, At, B1); PG8_BAR; PG8_SCHED;
            PG8_LDA(At, 1, 1); PG8_STAGE(PG8_SB(1, 0), b3, voffB); PG8_STAGE(PG8_SB(1, 1), b3 + hstep, voffB); PG8_STAGE(PG8_SA(1, 0), a3, voffA);
            PG8_WAIT_V(8); PG8_WAIT_L(0); PG8_BAR; PG8_MMA(1, 0, At, B0); PG8_MMA(1, 1, At, B1); PG8_BAR; PG8_SCHED;
            } else {
            PG8_LDB(B0, 0, 0); PG8_SCHED; PG8_LDA(At, 0, 0); PG8_STAGE(PG8_SA(1, 1), a1 + hstep, voffA);
            PG8_WAIT_L(8); PG8_BAR; PG8_WAIT_L(0); PG8_MMA(0, 0, At, B0); PG8_BAR; PG8_SCHED;
            PG8_LDB(B1, 0, 1); PG8_STAGE(PG8_SB(0, 0), b2, voffB);
            PG8_BAR; PG8_WAIT_L(0); PG8_MMA(0, 1, At, B1); PG8_BAR;
            PG8_LDA(At, 0, 1); PG8_STAGE(PG8_SA(0, 0), a2, voffA);
            PG8_BAR; PG8_WAIT_L(0); PG8_MMA(1, 0, At, B0); PG8_BAR; PG8_SCHED;
            PG8_STAGE(PG8_SB(0, 1), b2 + hstep, voffB);
            PG8_WAIT_V(6); PG8_BAR; PG8_MMA(1, 1, At, B1); PG8_BAR;
            PG8_LDB(B0, 1, 0); PG8_SCHED; PG8_LDA(At, 1, 0); PG8_STAGE(PG8_SA(0, 1), a2 + hstep, voffA);
            PG8_WAIT_L(8); PG8_BAR; PG8_WAIT_L(0); PG8_MMA(0, 0, At, B0); PG8_BAR; PG8_SCHED;
            PG8_LDB(B1, 1, 1); PG8_STAGE(PG8_SB(1, 0), b3, voffB);
            PG8_BAR; PG8_WAIT_L(0); PG8_MMA(0, 1, At, B1); PG8_BAR;
            PG8_LDA(At, 1, 1); PG8_STAGE(PG8_SA(1, 0), a3, voffA);
            PG8_BAR; PG8_WAIT_L(0); PG8_MMA(1, 0, At, B0); PG8_BAR; PG8_SCHED;
            PG8_STAGE(PG8_SB(1, 1), b3 + hstep, voffB);
            PG8_WAIT_V(6); PG8_BAR; PG8_MMA(1, 1, At, B1); PG8_BAR;
            }
        }
        if constexpr (ALIGN_EPI) { if (wr == 0) PG8_BAR; }
        if constexpr (!Epi::AFTER_DRAIN) { E(acc, cur, wr, wc, fr, fq); S.done(cur); }
        if (!has_next) break;
#pragma unroll
        for (int a = 0; a < 2; ++a)
#pragma unroll
            for (int b = 0; b < 2; ++b)
#pragma unroll
                for (int m = 0; m < 4; ++m)
#pragma unroll
                    for (int n = 0; n < 2; ++n) acc[a][b][m][n] = (f32x4){0.f, 0.f, 0.f, 0.f};
        cur = nxt; cA = nA; cB = nB; ++ui;
        if constexpr (ALIGN_EPI) { if (wr == 1) PG8_BAR; }
    }
    PG8_WAIT_V(0);
    if constexpr (!ALIGN_EPI) { if (wr == 0) PG8_BAR; }
    PG8_BAR;
    if constexpr (Epi::AFTER_DRAIN) { E.fused(acc, cur, wr, wc, fr, fq, lds, wid, lane); S.done(cur); }
#undef PG8_SA
#undef PG8_SB
#undef PG8_STAGE
#undef PG8_LDA
#undef PG8_LDB
#undef PG8_MMA
#undef PG8_WAIT_V
#undef PG8_WAIT_L
#undef PG8_BAR
#undef PG8_SCHED
}
}
#define GAS __attribute__((address_space(1)))
#define LAS __attribute__((address_space(3)))
typedef unsigned short bf16;
typedef unsigned v4u __attribute__((ext_vector_type(4)));
typedef float f32x4 __attribute__((ext_vector_type(4)));
typedef short bf16x8 __attribute__((ext_vector_type(8)));
typedef GAS unsigned gu32;
typedef GAS unsigned long long gu64;
#define RLX_AGENT __ATOMIC_RELAXED, __HIP_MEMORY_SCOPE_AGENT
#define LDS_WAIT() asm volatile("s_waitcnt lgkmcnt(0)" ::: "memory")
#define VM_WAIT() asm volatile("s_waitcnt vmcnt(0)" ::: "memory")
__device__ __forceinline__ unsigned long long rt() { return __builtin_amdgcn_s_memrealtime(); }
__device__ __forceinline__ unsigned f2bf(float f) { unsigned u = __builtin_bit_cast(unsigned, f); return (u + 0x7fffu + ((u >> 16) & 1u)) >> 16; }
__device__ __forceinline__ unsigned pk2(float lo, float hi) { return f2bf(lo) | (f2bf(hi) << 16); }

#define XB_TMO      128
#define XB_XCNT(j)  (256  + 64 * (j))
#define XB_XSUB(j)  (1280 + 64 * (j))
#define XB_XGEN(j)  (2304 + 64 * (j))
#define XB_TOP      3328
#define XB_TOPGEN   3392
#define XCD_BAR_WORDS 3456
#define XB_SPIN_CAP (1u << 18)

__device__ __forceinline__ unsigned xb_ld(unsigned* p)              { return __hip_atomic_load(p, __ATOMIC_RELAXED, __HIP_MEMORY_SCOPE_AGENT); }
__device__ __forceinline__ unsigned xb_add(unsigned* p, unsigned v) { return __hip_atomic_fetch_add(p, v, __ATOMIC_RELAXED, __HIP_MEMORY_SCOPE_AGENT); }
__device__ __forceinline__ unsigned xb_xcc_id() { return (unsigned)__builtin_amdgcn_s_getreg((3 << 11) | 20) & 0xFu; }
#define XB_SPIN(cond, bar) do { unsigned _sp = 0; while (cond) { __builtin_amdgcn_s_sleep(1); \
    if ((++_sp & 255u) == 0u) { if (xb_ld(&(bar)[XB_TMO])) break; if (_sp > XB_SPIN_CAP) { atomicAdd(&(bar)[XB_TMO], 1u); break; } } } } while (0)

struct XcdBarrier {
    unsigned* bar; unsigned x;
    volatile LAS unsigned* st;
};

__device__ __forceinline__ XcdBarrier xcd_barrier_post(unsigned* bar, volatile LAS unsigned* st) {
    XcdBarrier b; b.bar = bar; b.x = xb_xcc_id(); b.st = st;
    if (threadIdx.x == 0) (void)xb_add(&bar[XB_XCNT(b.x)], 1u);
    return b;
}
__device__ __forceinline__ void xcd_barrier_complete(unsigned* bar, unsigned x, unsigned& nloc, unsigned& nx) {
    const unsigned G = gridDim.x * gridDim.y * gridDim.z;
    unsigned sum, cnt, mine, sp = 0u;
    for (;;) {
        sum = 0u; cnt = 0u; mine = 0u;
#pragma unroll
        for (unsigned j = 0; j < 16; ++j) { const unsigned c = xb_ld(&bar[XB_XCNT(j)]); sum += c; cnt += (c > 0u) ? 1u : 0u; mine = (j == x) ? c : mine; }
        if (sum == G) break;
        __builtin_amdgcn_s_sleep(1);
        if ((++sp & 255u) == 0u) { if (xb_ld(&bar[XB_TMO])) break; if (sp > XB_SPIN_CAP) { atomicAdd(&bar[XB_TMO], 1u); break; } }
    }
    nloc = mine > 0u ? mine : 1u; nx = cnt > 0u ? cnt : 1u;
}

__device__ __forceinline__ void xcd_barrier(const XcdBarrier& b) {
    asm volatile("s_waitcnt vmcnt(0)" ::: "memory");
    __syncthreads();
    if (threadIdx.x == 0) {
        unsigned* bar = b.bar;
        __builtin_amdgcn_s_waitcnt(0);
        unsigned nloc = b.st[0], nx = b.st[1];
        if (nloc == 0u) { xcd_barrier_complete(bar, b.x, nloc, nx); b.st[0] = nloc; b.st[1] = nx; }
        const unsigned old = xb_add(&bar[XB_XSUB(b.x)], 1u);
        const unsigned gen = old / nloc;
        if (old + 1u == (gen + 1u) * nloc) {
            __builtin_amdgcn_fence(__ATOMIC_RELEASE, "agent");
            asm volatile("s_waitcnt vmcnt(0)" ::: "memory");
            const unsigned og = xb_add(&bar[XB_TOP], 1u);
            const unsigned tg = og / nx;
            if (og + 1u == (tg + 1u) * nx) xb_add(&bar[XB_TOPGEN], 1u);
            else XB_SPIN(xb_ld(&bar[XB_TOPGEN]) == tg, bar);
            __builtin_amdgcn_fence(__ATOMIC_ACQUIRE, "agent");
            xb_add(&bar[XB_XGEN(b.x)], 1u);
            asm volatile("s_waitcnt vmcnt(0)" ::: "memory");
        } else {
            XB_SPIN(xb_ld(&bar[XB_XGEN(b.x)]) == gen, bar);
            __builtin_amdgcn_fence(__ATOMIC_ACQUIRE, "agent");
            asm volatile("s_waitcnt vmcnt(0)" ::: "memory");
        }
    }
    __syncthreads();
}
typedef unsigned u32x4 __attribute__((ext_vector_type(4)));
constexpr int NWAVES = 8, NTHR = 512;
constexpr int BATCH = 2, SEQ = 8192, DM = 1024, M = BATCH * SEQ;
constexpr int EVEN_IN = 9232, ODD_IN = 6656;
constexpr float RMS_EPS = 1e-6f;
constexpr int NPHASE = 13;

constexpr size_t MiB = 1u << 20;
constexpr size_t WS_CTL = 0, CTL_ZERO_BYTES = 64 * 1024;
constexpr size_t WS_GATES = 1 * MiB;
constexpr size_t WS_PART = 2 * MiB;
constexpr size_t WS_RS0 = 3 * MiB;
constexpr size_t WS_ROPE = 3 * MiB + 64 * 1024;
constexpr size_t WS_NST = 3 * MiB + 128 * 1024;
constexpr size_t WS_CHSC = 3 * MiB + 640 * 1024;
constexpr size_t WS_W1T = 4 * MiB, WS_W2T = 22 * MiB, WS_U0 = 26 * MiB, WS_W3T = 26 * MiB;
constexpr size_t WS_A0 = 58 * MiB, WS_A1 = 90 * MiB, WS_A2 = 122 * MiB, WS_A3 = 154 * MiB, WS_MIX0 = 186 * MiB, WS_W4T = 250 * MiB;
constexpr size_t WS_H1B = WS_A0, WS_GQ = WS_A1, WS_GZ = WS_A2, WS_XC = WS_A3, WS_CG = 186 * MiB, WS_GK = 218 * MiB, WS_GV = 226 * MiB, WS_MIX1 = 4 * MiB;
constexpr size_t WS_END = 256 * MiB;
constexpr int CW_BAR = 4096;
constexpr int RING_BYTES = 131072, LDSCTL_OFF = 143360, MISC_OFF = LDSCTL_OFF + 320, LDS_BYTES = 147456;
static_assert(66560 + 128 * 528 <= LDSCTL_OFF, "LDS map");

typedef unsigned short bf16_t;
typedef short s16x4 __attribute__((ext_vector_type(4)));
typedef float f32x16 __attribute__((ext_vector_type(16)));
typedef unsigned u32x2 __attribute__((ext_vector_type(2)));
using pg8::cvt_pk_bf16; using pg8::fexp;

__device__ __forceinline__ float bf2f(unsigned short v) { return __uint_as_float((unsigned)v << 16); }
__device__ __forceinline__ bf16_t f2b(float x) { return (bf16_t)(cvt_pk_bf16(x, 0.f) & 0xffffu); }
__device__ __forceinline__ int crow(int r, int hi) { return (r & 3) + 8 * (r >> 2) + 4 * hi; }
__device__ __forceinline__ int v_st(int k, int c) { const int kk = (k & ~0xC) | ((k & 4) << 1) | ((k & 8) >> 1); return ((kk >> 3) * 4 + (c >> 5)) * 512 + ((kk & 7) * 32 + (c & 31)) * 2; }
__device__ __forceinline__ int v_rd_base(int lane) { return ((lane & 3) << 3) | (((lane >> 2) & 3) << 6) | (((lane >> 4) & 1) << 5) | (((lane >> 5) & 1) << 8); }
__device__ __forceinline__ int kswz512(int row, int colB) { return row * 528 + colB; }
__device__ __forceinline__ int kswz256(int row, int colB) { return row * 256 + (colB ^ ((row & 7) << 4)); }
typedef short v4i16_t __attribute__((ext_vector_type(4)));
__device__ __forceinline__ s16x4 vtr(LAS unsigned char* p) { return __builtin_bit_cast(s16x4, __builtin_amdgcn_ds_read_tr16_b64_v4i16((LAS v4i16_t*)p)); }
__device__ __forceinline__ bf16x8 tr_frag(LAS unsigned char* img_plus_rdbase, int d0, int ks) {
    LAS unsigned char* p = img_plus_rdbase + d0 * 512 + ks * 4096; const s16x4 lo = vtr(p), hi = vtr(p + 2048);
    return (bf16x8){lo[0], lo[1], lo[2], lo[3], hi[0], hi[1], hi[2], hi[3]};
}
__device__ __forceinline__ float swap_add(float v) { auto rr = __builtin_amdgcn_permlane32_swap(__float_as_uint(v), __float_as_uint(v), false, false); return __uint_as_float(rr[0]) + __uint_as_float(rr[1]); }
__device__ __forceinline__ float swap_max(float v) { auto rr = __builtin_amdgcn_permlane32_swap(__float_as_uint(v), __float_as_uint(v), false, false); return fmaxf(__uint_as_float(rr[0]), __uint_as_float(rr[1])); }
#define PK4(P, BASE, OUT) do { unsigned a0_ = cvt_pk_bf16(P[BASE + 0], P[BASE + 1]), a1_ = cvt_pk_bf16(P[BASE + 2], P[BASE + 3]);   \
    unsigned b0_ = cvt_pk_bf16(P[BASE + 4], P[BASE + 5]), b1_ = cvt_pk_bf16(P[BASE + 6], P[BASE + 7]);                              \
    auto r0_ = __builtin_amdgcn_permlane32_swap(a0_, b0_, false, false); auto r1_ = __builtin_amdgcn_permlane32_swap(a1_, b1_, false, false); \
    u32x4 w_ = {r0_[0], r1_[0], r0_[1], r1_[1]}; OUT = __builtin_bit_cast(bf16x8, w_); } while (0)

struct Args { const float* in[14]; float* out; unsigned char* ws; int ph_lo, ph_hi; };
#define LAUNDER_S(p) asm volatile("" : "+s"(p))
struct Frame {
    LAS unsigned char* lds; volatile LAS unsigned* MISC; gu32* ctl;
    int tid, lane, wave, vcu, G;
    float* out; unsigned char* ws;
};
#define WSP(T, off) ((T*)(F.ws + (off)))
__device__ __forceinline__ bool phase_enter(Frame& F) { LAUNDER_S(F.ws); LAUNDER_S(F.out); asm volatile("" : "+v"(F.tid)); F.lane = F.tid & 63; F.wave = __builtin_amdgcn_readfirstlane(F.tid >> 6); return true; }

__device__ __forceinline__ int map_w1(int d) {
    const int tile = d >> 8, r = d & 255;
    if (tile < 12) return d;
    if (tile < 20) { const int t = tile - 12; return r < 128 ? 3072 + 128 * t + r : 4096 + 128 * t + (r - 128); }
    return 5136 + (d - 5120);
}
__device__ __forceinline__ int map_w3(int d) {
    const int tile = d >> 8, r = d & 255;
    if (tile < 10) return d;
    if (tile < 18) { const int t = tile - 10; return r < 128 ? 3584 + 128 * t + r : 4608 + 128 * t + (r - 128); }
    { const int t = tile - 18; return r < 128 ? 2560 + 128 * t + r : 5632 + 128 * t + (r - 128); }
}
__device__ __forceinline__ void transpose_item(const float* W, int ldw, int K, bf16_t* WT, int drow0, int scol0, const float* gain, LAS float* scr, int kb, int lane) {
    const int k0 = 64 * kb;
#pragma unroll 8
    for (int i = 0; i < 32; ++i) { const int kk = 2 * i + (lane >> 5); const float gs = gain ? gain[k0 + kk] : 1.f; scr[kk * 33 + (lane & 31)] = W[(size_t)(k0 + kk) * ldw + scol0 + (lane & 31)] * gs; }
    LDS_WAIT(); asm volatile("" ::: "memory");
    const int c = lane & 7;
#pragma unroll
    for (int j = 0; j < 4; ++j) { const int n = (lane >> 3) + 8 * j; const LAS float* s = scr + (8 * c) * 33 + n;
        v4u o; o.x = cvt_pk_bf16(s[0 * 33], s[1 * 33]); o.y = cvt_pk_bf16(s[2 * 33], s[3 * 33]); o.z = cvt_pk_bf16(s[4 * 33], s[5 * 33]); o.w = cvt_pk_bf16(s[6 * 33], s[7 * 33]);
        *(v4u*)(WT + (size_t)(drow0 + n) * K + k0 + 8 * c) = o; }
    LDS_WAIT(); asm volatile("" ::: "memory");
}
__device__ __forceinline__ float logsigmoidf_(float x) { return fminf(x, 0.f) - log1pf(expf(-fabsf(x))); }
__device__ __forceinline__ void p0_prologue(Frame& F, const Args& A_) {
    LAS float* scr = (LAS float*)(F.lds + F.wave * 16384);
    const int gw = F.vcu * NWAVES + F.wave, NGW = F.G * NWAVES;
    constexpr int I_W1 = 16 * 288, I_W2 = 32 * 32, I_W4 = 32 * 32;
    for (int it = gw; it < I_W1 + I_W2 + I_W4; it += NGW) {
        int r = it;
        if (r < I_W1) { const int kb = r / 288, d = 32 * (r % 288); transpose_item(A_.in[3], EVEN_IN, 1024, WSP(bf16_t, WS_W1T), d, map_w1(d), nullptr, scr, kb, F.lane); continue; } r -= I_W1;
        if (r < I_W2) { const int kb = r / 32, d = 32 * (r % 32); transpose_item(A_.in[5], 1024, 2048, WSP(bf16_t, WS_W2T), d, d, nullptr, scr, kb, F.lane); continue; } r -= I_W2;
        { const int kb = r / 32, d = 32 * (r % 32); transpose_item(A_.in[9], 1024, 2048, WSP(bf16_t, WS_W4T), d, d, nullptr, scr, kb, F.lane); }
    }
    { const int gt = blockIdx.x * NTHR + F.tid;
      if (gt < 6144) { const int isc = gt >= 4096; const int e = isc ? gt - 4096 : gt; const int pos = e >> 5, i = e & 31;
          const float inv = powf(10000.f, -(float)i / 32.f); const float ang = (float)pos * inv;
          float* tb = WSP(float, WS_ROPE) + (isc ? 8192 : 0); tb[e * 2] = cosf(ang); tb[e * 2 + 1] = sinf(ang); } }
    __syncthreads();
    LAS float* wg = (LAS float*)F.lds;
    { const float* W = A_.in[3]; const float* g0 = A_.in[1];
      for (int idx = F.tid; idx < 16384; idx += NTHR) { const int k = idx >> 4, j = idx & 15; wg[k * 17 + j] = g0[k] * W[(size_t)k * EVEN_IN + 5120 + j]; } }
    __syncthreads();
    const float* x = A_.in[0]; const float* g0 = A_.in[1]; const float* gb = A_.in[4];
    bf16_t* U0 = WSP(bf16_t, WS_U0); float* rs0 = WSP(float, WS_RS0); float* gates = WSP(float, WS_GATES);
    for (int task = F.wave * F.G + F.vcu; task < M / 16; task += NGW) {
        const int i = F.lane & 15, kk = F.lane >> 4; const int row = task * 16 + i;
        const float* xr = x + (size_t)row * 1024 + 4 * kk; bf16_t* ur = U0 + (size_t)row * 1024 + 4 * kk;
        f32x4 acc = {0.f, 0.f, 0.f, 0.f}; float ss = 0.f;
#pragma unroll 4
        for (int s = 0; s < 64; ++s) {
            const f32x4 xv = *(const f32x4*)(xr + 16 * s); const f32x4 gv = *(const f32x4*)(g0 + 16 * s + 4 * kk);
            ss += (xv[0] * xv[0] + xv[1] * xv[1]) + (xv[2] * xv[2] + xv[3] * xv[3]);
            u32x2 w; w.x = cvt_pk_bf16(xv[0] * gv[0], xv[1] * gv[1]); w.y = cvt_pk_bf16(xv[2] * gv[2], xv[3] * gv[3]); *(u32x2*)(ur + 16 * s) = w;
#pragma unroll
            for (int e = 0; e < 4; ++e) { const float bv = wg[(16 * s + 4 * kk + e) * 17 + i]; acc = __builtin_amdgcn_mfma_f32_16x16x4f32(xv[e], bv, acc, 0, 0, 0); }
        }
        ss += __shfl_xor(ss, 16); ss += __shfl_xor(ss, 32);
        const float r = 1.0f / sqrtf(ss * (1.f / 1024.f) + RMS_EPS);
        if (kk == 0) rs0[row] = r;
        const int j = i, gi = j >> 2, hh = j & 3; const float bias = gb[j];
        f32x4 gv;
#pragma unroll
        for (int reg = 0; reg < 4; ++reg) { const float rr = __shfl(r, 4 * kk + reg); float g = acc[reg] * rr + bias; if (gi & 1) g = logsigmoidf_(g); gv[reg] = g; }
        const int row0 = task * 16 + 4 * kk; const int b = row0 >> 13, t = row0 & 8191;
        *(f32x4*)(gates + ((size_t)((gi * 2 + b) * 4 + hh)) * 8192 + t) = gv;
    }
}

constexpr int L_TAB = 0, L_KIMG = 16384, L_VIMG = 50176, L_CIMG = 66560;
constexpr int T_IGF = 0, T_LFF = 256, T_IGB = 512, T_LFB = 768, T_BF = 1024, T_CB = 1280, T_X0 = 1536, T_X1 = 1792, T_X2 = 2048, T_X3 = 2304, T_AF2 = 3072, T_AB2 = 3328, T_NF = 3584, T_NB = 3840;
__device__ __forceinline__ void gate_tables(LAS float* T, const float* gates, int b, int h, int c, int tid) {
    if (tid < 256) {
#pragma unroll
        for (int gi = 0; gi < 4; ++gi) T[gi * 256 + tid] = gates[((size_t)((gi * 2 + b) * 4 + h)) * 8192 + c * 256 + tid]; }
    __syncthreads();
    if (tid < 256) { float s = 0.f; for (int j = 0; j <= tid; ++j) s += T[T_LFF + j]; T[T_BF + tid] = s; }
    else { const int t = tid - 256; float s = 0.f; for (int j = 255; j >= t; --j) s += T[T_LFB + j]; T[T_CB + t] = s; }
    __syncthreads();
}
#define GLD8(base, boff) (*(const bf16x8*)((const char*)(base) + (size_t)(unsigned)(boff)))
#define GP16(base, boff) (*(bf16_t*)((char*)(base) + (size_t)(unsigned)(boff)))
#define GPC16(base, boff) (*(const bf16_t*)((const char*)(base) + (size_t)(unsigned)(boff)))
__device__ __forceinline__ void stage_k256(LAS unsigned char* L, const bf16_t* src, int ld, unsigned kgo, unsigned klo) {
#pragma unroll
    for (int i = 0; i < 4; ++i) *(LAS bf16x8*)(L + L_KIMG + klo + i * (16 * 528)) = GLD8(src + (size_t)(16 * i) * ld, kgo);
}
__device__ __forceinline__ void x1_unit(Frame& F, const Args& A_, int unit) {
    const int bh = unit >> 5, c = unit & 31, b = bh >> 2, h = bh & 3;
    int tid = F.tid; asm volatile("" : "+v"(tid)); const int lane = tid & 63, wave = F.wave, r32 = lane & 31, hi = lane >> 5;
    LAS unsigned char* L = F.lds; LAS float* T = (LAS float*)(L + L_TAB);
    const size_t grow0 = (size_t)b * SEQ + c * 256;
    const bf16_t* kb = WSP(bf16_t, WS_A1) + grow0 * 1024 + h * 256; const bf16_t* vb = WSP(bf16_t, WS_A2) + grow0 * 1024 + h * 256;
    bf16_t* states = (bf16_t*)F.out; float* nst = WSP(float, WS_NST); float* chsc = WSP(float, WS_CHSC);
    LAUNDER_S(kb); LAUNDER_S(vb); LAUNDER_S(states); LAUNDER_S(nst);
    gate_tables(T, WSP(float, WS_GATES), b, h, c, tid);
    const float Gf = T[T_BF + 255], Gb = T[T_CB + 0];
    if (tid < 256) { T[T_X0 + tid] = Gf - T[T_BF + tid] + T[T_IGF + tid]; T[T_X1 + tid] = Gb - T[T_CB + tid] + T[T_IGB + tid]; }
    __syncthreads();
    float mlf = -1e30f, mlb = -1e30f;
    for (int j = 0; j < 256; ++j) { mlf = fmaxf(mlf, T[T_X0 + j]); mlb = fmaxf(mlb, T[T_X1 + j]); }
    __syncthreads();
    if (tid < 256) { T[T_X2 + tid] = expf(T[T_X0 + tid] - mlf); T[T_X3 + tid] = expf(T[T_X1 + tid] - mlb); }
    if (tid == 0) { float* p = chsc + (size_t)((0 * 8 + bh) * 32 + c) * 4; p[0] = Gf; p[1] = mlf; float* q = chsc + (size_t)((1 * 8 + bh) * 32 + c) * 4; q[0] = Gb; q[1] = mlb; }
    __syncthreads();
    const int sr = tid >> 4, sc8 = (tid & 15) * 8;
    const unsigned go = (unsigned)(sr * 1024 + sc8) * 2u; const unsigned lo0 = (unsigned)v_st(sr, sc8), lo1 = (unsigned)v_st(32 + sr, sc8);
    LAS unsigned char* rdk = L + L_KIMG + v_rd_base(lane); LAS unsigned char* rdv = L + L_VIMG + (wave >> 2) * 16384 + (wave & 3) * 512 + v_rd_base(lane);
#pragma unroll 1
    for (int dir = 0; dir < 2; ++dir) {
        f32x16 acc[8];
#pragma unroll
        for (int j = 0; j < 8; ++j) acc[j] = f32x16{};
        float dn = 0.f; const int wofs = dir ? T_X3 : T_X2;
#pragma unroll 1
        for (int t4 = 0; t4 < 4; ++t4) {
            const bf16_t* kt = kb + (size_t)(t4 * 64) * 1024; const bf16_t* vt = vb + (size_t)(t4 * 64) * 1024;
#pragma unroll
            for (int half = 0; half < 2; ++half)
#pragma unroll
                for (int q = 0; q < 2; ++q) {
                    const bf16x8 kv = GLD8(kt + (size_t)(32 * q) * 1024 + half * 128, go);
                    const bf16x8 vv = GLD8(vt + (size_t)(32 * q) * 1024 + half * 128, go);
                    const float w = T[wofs + t4 * 64 + sr + 32 * q];
                    u32x4 pv; pv.x = cvt_pk_bf16(bf2f(vv[0]) * w, bf2f(vv[1]) * w); pv.y = cvt_pk_bf16(bf2f(vv[2]) * w, bf2f(vv[3]) * w); pv.z = cvt_pk_bf16(bf2f(vv[4]) * w, bf2f(vv[5]) * w); pv.w = cvt_pk_bf16(bf2f(vv[6]) * w, bf2f(vv[7]) * w);
                    *(LAS bf16x8*)(L + L_KIMG + half * 16384 + (q ? lo1 : lo0)) = kv;
                    *(LAS u32x4*)(L + L_VIMG + half * 16384 + (q ? lo1 : lo0)) = pv; }
            __syncthreads();
#pragma unroll
            for (int ks = 0; ks < 4; ++ks) { const bf16x8 Af = tr_frag(rdv, 0, ks);
#pragma unroll
                for (int j = 0; j < 8; ++j) { const bf16x8 Bf = tr_frag(rdk + (j >> 2) * 16384, j & 3, ks); acc[j] = __builtin_amdgcn_mfma_f32_32x32x16_bf16(Af, Bf, acc[j], 0, 0, 0); } }
            if (tid < 256) { const int k = tid; LAS unsigned char* kp = L + L_KIMG + (k >> 7) * 16384 + (((k & 127) >> 5) * 512 + (k & 31) * 2);
#pragma unroll 8
                for (int key = 0; key < 64; ++key) { const int kk = (key & ~0xC) | ((key & 4) << 1) | ((key & 8) >> 1);
                    dn += T[wofs + t4 * 64 + key] * bf2f(*(LAS bf16_t*)(kp + (kk >> 3) * 2048 + (kk & 7) * 64)); } }
            __syncthreads();
        }
        bf16_t* dst = states + (size_t)((dir * 8 + bh) * 32 + c) * 65536 + (size_t)(32 * wave) * 256;
        const unsigned so = (unsigned)(4 * hi * 256 + r32) * 2u;
#pragma unroll
        for (int r = 0; r < 16; ++r) {
#pragma unroll
            for (int j = 0; j < 8; ++j) GP16(dst, so + ((r & 3) + 8 * (r >> 2)) * 512 + 64 * j) = f2b(acc[j][r]);
            if ((r & 3) == 3) asm volatile("" ::: "memory"); }
        if (tid < 256) nst[(size_t)((dir * 8 + bh) * 32 + c) * 256 + tid] = dn;
    }
    __syncthreads();
}
__device__ __forceinline__ void x2_scan(Frame& F) {
    const int bid = F.vcu, tid = F.tid; LAS float* T = (LAS float*)(F.lds);
    bf16_t* states = (bf16_t*)F.out; float* nst = WSP(float, WS_NST); float* chsc = WSP(float, WS_CHSC);
#pragma unroll 1
    for (int blk = bid; blk < 256; blk += F.G) {
        const int chain = blk >> 4, dir = chain >> 3; const bool first = (blk & 15) == 0;
        if (tid == 0) { float m = -1e30f;
            for (int i = 0; i < 32; ++i) { const int c = dir ? 31 - i : i; float* p = chsc + (size_t)(chain * 32 + c) * 4; const float G = p[0], ml = p[1];
                if (first) p[2] = m; const float mo = fmaxf(G + m, ml); T[i] = expf(G + m - mo); T[32 + i] = expf(ml - mo); m = mo; } }
        __syncthreads();
        const unsigned e8 = (unsigned)((blk & 15) * 512 + tid) * 16u;
        float st[8];
#pragma unroll
        for (int j = 0; j < 8; ++j) st[j] = 0.f;
        bf16_t* cb = states + (size_t)(chain * 32) * 65536;
#pragma unroll 4
        for (int i = 0; i < 32; ++i) { const int c = dir ? 31 - i : i; bf16_t* p = (bf16_t*)((char*)(cb + (size_t)c * 65536) + (size_t)e8);
            const bf16x8 d = *(const bf16x8*)p; const float so = T[i], sw = T[32 + i];
            u32x4 w; w.x = cvt_pk_bf16(st[0], st[1]); w.y = cvt_pk_bf16(st[2], st[3]); w.z = cvt_pk_bf16(st[4], st[5]); w.w = cvt_pk_bf16(st[6], st[7]); *(u32x4*)p = w;
#pragma unroll
            for (int j = 0; j < 8; ++j) st[j] = so * st[j] + sw * bf2f(d[j]); }
        if (first && tid < 256) { float sn = 0.f;
            for (int i = 0; i < 32; ++i) { const int c = dir ? 31 - i : i; float* p = nst + (size_t)(chain * 32 + c) * 256 + tid; const float d = *p; *p = sn; sn = T[i] * sn + T[32 + i] * d; } }
        __syncthreads();
    }
}
template <int NK> __device__ __forceinline__ void st_tile(f32x16& p0, f32x16& p1, LAS unsigned char* kp, const bf16x8* qr) {
    p0 = f32x16{}; p1 = f32x16{};
#pragma unroll
    for (int d0 = 0; d0 < NK; ++d0) { const bf16x8 b0 = *(const LAS bf16x8*)(kp + 32 * d0), b1 = *(const LAS bf16x8*)(kp + 32 * 528 + 32 * d0);
        p0 = __builtin_amdgcn_mfma_f32_32x32x16_bf16(b0, qr[d0], p0, 0, 0, 0); p1 = __builtin_amdgcn_mfma_f32_32x32x16_bf16(b1, qr[d0], p1, 0, 0, 0); }
}
__device__ __forceinline__ void x3_unit(Frame& F, const Args& A_, int unit) {
    const int bh = unit >> 5, c = unit & 31, b = bh >> 2, h = bh & 3;
    int tid = F.tid; asm volatile("" : "+v"(tid)); const int lane = tid & 63, wave = F.wave, r32 = lane & 31, hi = lane >> 5;
    LAS unsigned char* L = F.lds; LAS float* T = (LAS float*)(L + L_TAB);
    const size_t grow0 = (size_t)b * SEQ + c * 256;
    const bf16_t* qb = WSP(bf16_t, WS_A0) + grow0 * 1024 + h * 256; const bf16_t* kb = WSP(bf16_t, WS_A1) + grow0 * 1024 + h * 256;
    const bf16_t* vb = WSP(bf16_t, WS_A2) + grow0 * 1024 + h * 256; const bf16_t* gb = WSP(bf16_t, WS_A3) + (grow0 + 32 * wave) * 1024 + h * 256;
    const bf16_t* states = (const bf16_t*)F.out; const float* nst = WSP(float, WS_NST); const float* chsc = WSP(float, WS_CHSC);
    bf16_t* mb0 = WSP(bf16_t, WS_MIX0) + (grow0 + 32 * wave) * 2048 + h * 256;
    const float* ng = A_.in[6] + h * 256;
    LAUNDER_S(qb); LAUNDER_S(kb); LAUNDER_S(vb); LAUNDER_S(gb); LAUNDER_S(mb0); LAUNDER_S(states);
    gate_tables(T, WSP(float, WS_GATES), b, h, c, tid);
    if (tid < 256) { T[T_X0 + tid] = T[T_IGF + tid] - T[T_BF + tid]; T[T_NF + tid] = nst[(size_t)((0 * 8 + bh) * 32 + c) * 256 + tid]; }
    else { const int t = tid - 256; T[T_X1 + t] = T[T_IGB + t] - T[T_CB + t]; T[T_NB + t] = nst[(size_t)((1 * 8 + bh) * 32 + c) * 256 + t]; }
    const float mf = chsc[(size_t)((0 * 8 + bh) * 32 + c) * 4 + 2], mb = chsc[(size_t)((1 * 8 + bh) * 32 + c) * 4 + 2];
    __syncthreads();
    if (tid < 256) { float m = mf; for (int j = 0; j <= tid; ++j) m = fmaxf(m, T[T_X0 + j]); T[T_X2 + tid] = m; }
    else { const int t = tid - 256; float m = mb; for (int j = 255; j >= t; --j) m = fmaxf(m, T[T_X1 + j]); T[T_X3 + t] = m; }
    __syncthreads();
    const int tq = 32 * wave + r32;
    bf16x8 qr[16];
    { const unsigned qo = (unsigned)(tq * 1024 + 8 * hi) * 2u;
#pragma unroll
      for (int d0 = 0; d0 < 16; ++d0) qr[d0] = GLD8(qb + 16 * d0, qo); }
    const float Rf = T[T_X2 + tq], Rb = T[T_X3 + tq];
    float denf = 0.f, denb = 0.f;
#pragma unroll 1
    for (int j = 0; j < 4; ++j) {
        int t_ = tid; asm volatile("" : "+v"(t_));
        const unsigned kgo = (unsigned)((t_ >> 5) * 1024 + (t_ & 31) * 8) * 2u, klo = (unsigned)((t_ >> 5) * 528 + (t_ & 31) * 16);
        LAS unsigned char* kp = L + L_KIMG + (t_ & 31) * 528 + 16 * ((t_ >> 5) & 1);
        stage_k256(L, kb + (size_t)(64 * j) * 1024, 1024, kgo, klo);
        __syncthreads();
        f32x16 p0, p1; st_tile<16>(p0, p1, kp, qr);
        LAS float* tf = T + T_X0 + 64 * j + 4 * hi; LAS float* tb = T + T_X1 + 64 * j + 4 * hi; const int sb0 = 64 * j + 4 * hi;
#pragma unroll
        for (int r = 0; r < 16; ++r) { const int cr = (r & 3) + 8 * (r >> 2);
            const float uf0 = tf[cr], uf1 = tf[cr + 32], ub0 = tb[cr], ub1 = tb[cr + 32];
            const float ef0 = fexp(uf0 - Rf), ef1 = fexp(uf1 - Rf), eb0 = fexp(ub0 - Rb), eb1 = fexp(ub1 - Rb);
            const int s0 = sb0 + cr, s1 = s0 + 32;
            denf += ((s0 <= tq) ? ef0 : 0.f) * p0[r] + ((s1 <= tq) ? ef1 : 0.f) * p1[r];
            denb += ((s0 >= tq) ? eb0 : 0.f) * p0[r] + ((s1 >= tq) ? eb1 : 0.f) * p1[r];
            if ((r & 3) == 3) asm volatile("" ::: "memory"); }
        __syncthreads();
    }
    denf = swap_add(denf); denb = swap_add(denb);
    float nqf = 0.f, nqb = 0.f;
#pragma unroll
    for (int d0 = 0; d0 < 16; ++d0) {
#pragma unroll
        for (int jj = 0; jj < 8; ++jj) { const float qv = bf2f(qr[d0][jj]); nqf += qv * T[T_NF + 16 * d0 + 8 * hi + jj]; nqb += qv * T[T_NB + 16 * d0 + 8 * hi + jj]; }
        asm volatile("" ::: "memory"); }
    nqf = swap_add(nqf); nqb = swap_add(nqb);
    float sf, sb;
    { const float ef = fexp(mf - Rf), eb = fexp(mb - Rb);
      const float dtf = ef * nqf + denf, dtb = eb * nqb + denb;
      sf = 1.f / fmaxf(fabsf(dtf), expf(-T[T_BF + tq] - Rf)); sb = 1.f / fmaxf(fabsf(dtb), expf(-T[T_CB + tq] - Rb));
      if (hi == 0) { T[T_AF2 + tq] = ef * sf; T[T_AB2 + tq] = eb * sb; } }
    __syncthreads();
#pragma unroll 1
    for (int dvh = 0; dvh < 2; ++dvh) {
        int t_ = tid; asm volatile("" : "+v"(t_));
        const unsigned kgo = (unsigned)((t_ >> 5) * 1024 + (t_ & 31) * 8) * 2u, klo = (unsigned)((t_ >> 5) * 528 + (t_ & 31) * 16);
        LAS unsigned char* kp = L + L_KIMG + (t_ & 31) * 528 + 16 * ((t_ >> 5) & 1);
        LAS unsigned char* rdv = L + L_VIMG + v_rd_base(t_ & 63);
        LAS unsigned char* cp = L + L_CIMG + (t_ & 31) * 528 + 16 * ((t_ >> 5) & 1);
        const unsigned vgo = (unsigned)((t_ >> 4) * 1024 + (t_ & 15) * 8) * 2u, vlo0 = (unsigned)v_st(t_ >> 4, (t_ & 15) * 8), vlo1 = (unsigned)v_st(32 + (t_ >> 4), (t_ & 15) * 8);
        const unsigned cgo = (unsigned)((t_ >> 5) * 256 + (t_ & 31) * 8) * 2u;
        f32x16 o[4];
#pragma unroll
        for (int d = 0; d < 4; ++d) o[d] = f32x16{};
#pragma unroll 1
        for (int dir = 0; dir < 2; ++dir) {
            const bf16_t* cs = states + (size_t)((dir * 8 + bh) * 32 + c) * 65536 + (size_t)(128 * dvh) * 256;
#pragma unroll
            for (int i = 0; i < 8; ++i) *(LAS bf16x8*)(L + L_CIMG + klo + i * (16 * 528)) = GLD8(cs + (size_t)(16 * i) * 256, cgo);
            __syncthreads();
            LAS float* ta = T + (dir ? T_AB2 : T_AF2) + 32 * wave + 4 * hi;
#pragma unroll
            for (int d = 0; d < 4; ++d) { f32x16 tmp = f32x16{};
#pragma unroll
                for (int d0 = 0; d0 < 16; ++d0) { const bf16x8 Bf = *(const LAS bf16x8*)(cp + d * (32 * 528) + 32 * d0); tmp = __builtin_amdgcn_mfma_f32_32x32x16_bf16(qr[d0], Bf, tmp, 0, 0, 0); }
#pragma unroll
                for (int r = 0; r < 16; ++r) o[d][r] += tmp[r] * ta[(r & 3) + 8 * (r >> 2)]; }
            __syncthreads();
        }
#pragma unroll 1
        for (int j = 0; j < 4; ++j) {
            stage_k256(L, kb + (size_t)(64 * j) * 1024, 1024, kgo, klo);
            { const bf16_t* vt = vb + (size_t)(64 * j) * 1024 + 128 * dvh;
              *(LAS bf16x8*)(L + L_VIMG + vlo0) = GLD8(vt, vgo); *(LAS bf16x8*)(L + L_VIMG + vlo1) = GLD8(vt + (size_t)32 * 1024, vgo); }
            __syncthreads();
            f32x16 p0, p1; st_tile<16>(p0, p1, kp, qr);
            LAS float* tf = T + T_X0 + 64 * j + 4 * hi; LAS float* tb = T + T_X1 + 64 * j + 4 * hi; const int sb0 = 64 * j + 4 * hi;
#pragma unroll
            for (int r = 0; r < 16; ++r) { const int cr = (r & 3) + 8 * (r >> 2);
                const float uf0 = tf[cr], uf1 = tf[cr + 32], ub0 = tb[cr], ub1 = tb[cr + 32];
                const float ef0 = fexp(uf0 - Rf) * sf, ef1 = fexp(uf1 - Rf) * sf, eb0 = fexp(ub0 - Rb) * sb, eb1 = fexp(ub1 - Rb) * sb;
                const int s0 = sb0 + cr, s1 = s0 + 32;
                p0[r] *= ((s0 <= tq) ? ef0 : 0.f) + ((s0 >= tq) ? eb0 : 0.f);
                p1[r] *= ((s1 <= tq) ? ef1 : 0.f) + ((s1 >= tq) ? eb1 : 0.f);
                if ((r & 3) == 3) asm volatile("" ::: "memory"); }
            bf16x8 pa0, pa1, pa2, pa3;
            PK4(p0, 0, pa0); PK4(p0, 8, pa1); PK4(p1, 0, pa2); PK4(p1, 8, pa3);
#pragma unroll
            for (int d = 0; d < 4; ++d) {
                o[d] = __builtin_amdgcn_mfma_f32_32x32x16_bf16(pa0, tr_frag(rdv, d, 0), o[d], 0, 0, 0);
                o[d] = __builtin_amdgcn_mfma_f32_32x32x16_bf16(pa1, tr_frag(rdv, d, 1), o[d], 0, 0, 0);
                o[d] = __builtin_amdgcn_mfma_f32_32x32x16_bf16(pa2, tr_frag(rdv, d, 2), o[d], 0, 0, 0);
                o[d] = __builtin_amdgcn_mfma_f32_32x32x16_bf16(pa3, tr_frag(rdv, d, 3), o[d], 0, 0, 0); }
            __syncthreads();
        }
        int l_ = lane; asm volatile("" : "+v"(l_));
        const unsigned oo = (unsigned)(4 * (l_ >> 5) * 2048 + (l_ & 31)) * 2u, go_ = (unsigned)(4 * (l_ >> 5) * 1024 + (l_ & 31)) * 2u;
        if (dvh == 0) {
#pragma unroll
            for (int r = 0; r < 16; ++r) { unsigned ro = oo + ((r & 3) + 8 * (r >> 2)) * 4096; asm volatile("" : "+v"(ro));
#pragma unroll
                for (int d = 0; d < 4; ++d) GP16(mb0, ro + 64 * d) = f2b(o[d][r]);
                if ((r & 3) == 3) asm volatile("" ::: "memory"); }
        } else {
            asm volatile("s_waitcnt vmcnt(0)" ::: "memory");
#pragma unroll
            for (int r = 0; r < 16; ++r) { unsigned ro = oo + ((r & 3) + 8 * (r >> 2)) * 4096, rg = go_ + ((r & 3) + 8 * (r >> 2)) * 2048; asm volatile("" : "+v"(ro), "+v"(rg));
                float h0[4]; float s = (o[0][r] * o[0][r] + o[1][r] * o[1][r]) + (o[2][r] * o[2][r] + o[3][r] * o[3][r]);
#pragma unroll
                for (int d = 0; d < 4; ++d) { h0[d] = bf2f(GP16(mb0, ro + 64 * d)); s += h0[d] * h0[d]; }
                s += __shfl_xor(s, 1); s += __shfl_xor(s, 2); s += __shfl_xor(s, 4); s += __shfl_xor(s, 8); s += __shfl_xor(s, 16);
                const float rinv = 1.0f / sqrtf(s * (1.f / 256.f) + RMS_EPS);
#pragma unroll
                for (int d = 0; d < 4; ++d) {
                    GP16(mb0, ro + 256 + 64 * d) = f2b(o[d][r] * rinv * ng[128 + 32 * d + r32] * bf2f(GPC16(gb, rg + 256 + 64 * d)));
                    GP16(mb0, ro + 64 * d) = f2b(h0[d] * rinv * ng[32 * d + r32] * bf2f(GPC16(gb, rg + 64 * d))); }
                asm volatile("" ::: "memory"); }
        }
    }
    __syncthreads();
}

__device__ __forceinline__ void na_unit(Frame& F, const Args& A_, int unit) {
    const int b = unit >> 9, r = (unit >> 2) & 127, hg = unit & 3;
    int tid = F.tid; asm volatile("" : "+v"(tid)); const int lane = tid & 63, wave = F.wave, r32 = lane & 31, hi = lane >> 5;
    LAS unsigned char* L = F.lds; LAS float* T = (LAS float*)(L + L_TAB); LAS float* wsf = (LAS float*)(L + 8192) + wave * 64;
    const float* rpb = A_.in[7];
    for (int idx = tid; idx < 1860; idx += NTHR) T[idx] = rpb[hg * 1860 + idx];
    const int hd = wave >> 1, qb = wave & 1, cq = 32 * qb + r32, head = 4 * hg + hd;
    const int c0 = min(max(cq - 8, 0), 48), r0 = min(max(r - 4, 0), 120);
    const size_t rowq = (size_t)b * SEQ + r * 64;
    const bf16_t* qbp = WSP(bf16_t, WS_A0) + (rowq + 32 * qb) * 1024 + head * 64;
    const bf16_t* zbp = WSP(bf16_t, WS_A3) + (rowq + 32 * qb) * 1024 + head * 64;
    bf16_t* obp = WSP(bf16_t, WS_MIX0) + (rowq + 32 * qb) * 2048 + 1024 + head * 64;
    const bf16_t* kbp = WSP(bf16_t, WS_A1) + ((size_t)b * SEQ + (size_t)r0 * 64) * 1024 + 256 * hg;
    const bf16_t* vbp = WSP(bf16_t, WS_A2) + ((size_t)b * SEQ + (size_t)r0 * 64) * 1024 + 256 * hg;
    bf16x8 qr[4];
    { const unsigned qo = (unsigned)(r32 * 1024 + 8 * hi) * 2u;
#pragma unroll
      for (int d0 = 0; d0 < 4; ++d0) qr[d0] = GLD8(qbp + 16 * d0, qo); }
    float m = -1e30f, l = 0.f; f32x16 o[2]; o[0] = f32x16{}; o[1] = f32x16{};
    LAS unsigned char* rdv = L + L_VIMG + (hd >> 1) * 16384 + (2 * (hd & 1)) * 512 + v_rd_base(lane);
    LAS unsigned char* kp = L + L_KIMG + r32 * 528 + 128 * hd + 16 * hi;
    const unsigned kgo = (unsigned)((tid >> 5) * 1024 + (tid & 31) * 8) * 2u, klo = (unsigned)((tid >> 5) * 528 + (tid & 31) * 16);
    unsigned vlo[4];
#pragma unroll
    for (int q = 0; q < 4; ++q) { const int key = (tid >> 5) + 16 * q, col8 = (tid & 31) * 8; vlo[q] = (unsigned)((col8 >> 7) * 16384 + v_st(key, col8 & 127)); }
    __syncthreads();
#pragma unroll 1
    for (int i = 0; i < 8; ++i) {
        stage_k256(L, kbp + (size_t)(64 * i) * 1024, 1024, kgo, klo);
#pragma unroll
        for (int q = 0; q < 4; ++q) *(LAS bf16x8*)(L + L_VIMG + vlo[q]) = GLD8(vbp + (size_t)(64 * i + 16 * q) * 1024, kgo);
        __syncthreads();
        f32x16 p0, p1; st_tile<4>(p0, p1, kp, qr);
        const int dr = r0 + i - r + 7; const LAS float* brow = T + hd * 465 + dr * 31 + (15 - cq);
        float pmax = -1e30f;
#pragma unroll
        for (int rr = 0; rr < 16; ++rr) { const int ck0 = crow(rr, hi), ck1 = ck0 + 32;
            const bool v0 = (unsigned)(ck0 - c0) < 16u, v1 = (unsigned)(ck1 - c0) < 16u;
            const float b0 = brow[min(max(ck0, cq - 15), cq + 15)], b1 = brow[min(max(ck1, cq - 15), cq + 15)];
            p0[rr] = v0 ? p0[rr] + b0 : -1e30f; p1[rr] = v1 ? p1[rr] + b1 : -1e30f; pmax = fmaxf(pmax, fmaxf(p0[rr], p1[rr])); }
        pmax = swap_max(pmax);
        const float mn = fmaxf(m, pmax), alpha = fexp(m - mn); m = mn;
        float ps = 0.f;
#pragma unroll
        for (int rr = 0; rr < 16; ++rr) { const float e0 = fexp(p0[rr] - mn), e1 = fexp(p1[rr] - mn); p0[rr] = (p0[rr] > -1e29f) ? e0 : 0.f; p1[rr] = (p1[rr] > -1e29f) ? e1 : 0.f; ps += p0[rr] + p1[rr]; }
        ps = swap_add(ps); l = l * alpha + ps;
        if (hi == 0) wsf[r32] = alpha;
#pragma unroll
        for (int d = 0; d < 2; ++d)
#pragma unroll
            for (int rr = 0; rr < 16; ++rr) o[d][rr] *= wsf[crow(rr, hi)];
        bf16x8 pa0, pa1, pa2, pa3;
        PK4(p0, 0, pa0); PK4(p0, 8, pa1); PK4(p1, 0, pa2); PK4(p1, 8, pa3);
#pragma unroll
        for (int d = 0; d < 2; ++d) {
            o[d] = __builtin_amdgcn_mfma_f32_32x32x16_bf16(pa0, tr_frag(rdv, d, 0), o[d], 0, 0, 0);
            o[d] = __builtin_amdgcn_mfma_f32_32x32x16_bf16(pa1, tr_frag(rdv, d, 1), o[d], 0, 0, 0);
            o[d] = __builtin_amdgcn_mfma_f32_32x32x16_bf16(pa2, tr_frag(rdv, d, 2), o[d], 0, 0, 0);
            o[d] = __builtin_amdgcn_mfma_f32_32x32x16_bf16(pa3, tr_frag(rdv, d, 3), o[d], 0, 0, 0); }
        __syncthreads();
    }
    if (hi == 0) wsf[32 + r32] = l;
    const unsigned zo = (unsigned)(4 * hi * 1024 + r32) * 2u, oo = (unsigned)(4 * hi * 2048 + r32) * 2u;
#pragma unroll
    for (int rr = 0; rr < 16; ++rr) { const float rli = 1.f / wsf[32 + crow(rr, hi)]; const int cr = (rr & 3) + 8 * (rr >> 2);
#pragma unroll
        for (int d = 0; d < 2; ++d) GP16(obp, oo + cr * 4096 + 64 * d) = f2b(o[d][rr] * rli * bf2f(GPC16(zbp, zo + cr * 2048 + 64 * d)));
        if ((rr & 3) == 3) asm volatile("" ::: "memory"); }
    __syncthreads();
}

__device__ __forceinline__ void p9_krope_conv(Frame& F, const Args& A_) {
    const int gw = F.vcu * NWAVES + F.wave, NGW = F.G * NWAVES, lane = F.lane;
    bf16_t* gk = WSP(bf16_t, WS_GK); const float* kng = A_.in[11]; const float* ropeR = WSP(float, WS_ROPE); const float* ropeC = ropeR + 8192;
    for (int row = gw; row < M; row += NGW) {
        const int hd = lane >> 5, i = lane & 31; bf16_t* p = gk + (size_t)row * 256 + hd * 128 + i;
        float x[4]; float ss = 0.f;
#pragma unroll
        for (int e = 0; e < 4; ++e) { x[e] = bf2f(p[32 * e]); ss += x[e] * x[e]; }
        ss += __shfl_xor(ss, 1); ss += __shfl_xor(ss, 2); ss += __shfl_xor(ss, 4); ss += __shfl_xor(ss, 8); ss += __shfl_xor(ss, 16);
        const float rr = 1.0f / sqrtf(ss * (1.f / 128.f) + RMS_EPS);
#pragma unroll
        for (int e = 0; e < 4; ++e) x[e] = x[e] * rr * kng[32 * e + i];
        const int t = row & 8191, pr = t >> 6, pc = t & 63;
        const float cr = ropeR[(pr * 32 + i) * 2], sr = ropeR[(pr * 32 + i) * 2 + 1], cc = ropeC[(pc * 32 + i) * 2], sc = ropeC[(pc * 32 + i) * 2 + 1];
        p[0] = f2b(x[0] * cr - x[1] * sr); p[32] = f2b(x[0] * sr + x[1] * cr); p[64] = f2b(x[2] * cc - x[3] * sc); p[96] = f2b(x[2] * sc + x[3] * cc);
    }
    const bf16_t* xc = WSP(bf16_t, WS_XC); const bf16_t* cg = WSP(bf16_t, WS_CG); bf16_t* mix1 = WSP(bf16_t, WS_MIX1); const float* cw = A_.in[12]; const float* cbv = A_.in[13];
    const int gt = F.vcu * NTHR + F.tid, NGT = F.G * NTHR;
    for (int it = gt; it < M * 128; it += NGT) {
        const int row = it >> 7, c8 = (it & 127) * 8, t = row & 8191;
        const bf16x8 z8 = {0, 0, 0, 0, 0, 0, 0, 0};
        const bf16x8 x0 = *(const bf16x8*)(xc + (size_t)row * 1024 + c8);
        const bf16x8 xm = t > 0 ? *(const bf16x8*)(xc + (size_t)(row - 1) * 1024 + c8) : z8;
        const bf16x8 xp = t < SEQ - 1 ? *(const bf16x8*)(xc + (size_t)(row + 1) * 1024 + c8) : z8;
        const bf16x8 g8 = *(const bf16x8*)(cg + (size_t)row * 1024 + c8);
        float y[8];
#pragma unroll
        for (int j = 0; j < 8; ++j) y[j] = bf2f(g8[j]) * (bf2f(xm[j]) * cw[c8 + j] + bf2f(x0[j]) * cw[1024 + c8 + j] + bf2f(xp[j]) * cw[2048 + c8 + j] + cbv[c8 + j]);
        u32x4 w; w.x = cvt_pk_bf16(y[0], y[1]); w.y = cvt_pk_bf16(y[2], y[3]); w.z = cvt_pk_bf16(y[4], y[5]); w.w = cvt_pk_bf16(y[6], y[7]);
        *(u32x4*)(mix1 + (size_t)row * 2048 + 1024 + c8) = w;
    }
}

namespace gqa {
constexpr int D = 128, NW = 8, QBLK = 32, KVBLK = 64, LDQ = 1024, LDK = 256;
constexpr float SCALE = 0.088388347648318440f;
constexpr float THR = 8.f;
constexpr size_t SHM_V = KVBLK * D * 2, SHM_K = KVBLK * D * 2;
#define KSWZ(row, colB) ((row) * 256 + ((colB) ^ (((row) & 7) << 4)))
#define SBAR() __builtin_amdgcn_sched_barrier(0)
__device__ __forceinline__ unsigned cvtpk(float lo, float hi) { unsigned r; asm volatile("v_cvt_pk_bf16_f32 %0, %1, %2" : "=v"(r) : "v"(lo), "v"(hi)); return r; }
__device__ __forceinline__ void partialSM(f32x16& p0, f32x16& p1, float& m_reg, float& mn, float& alpha) {
  constexpr float C = SCALE * 1.4426950408889634f;
  float pmax = p0[0]; for (int r = 1; r < 16; ++r) pmax = fmaxf(pmax, p0[r]); for (int r = 0; r < 16; ++r) pmax = fmaxf(pmax, p1[r]);
  { auto rr = __builtin_amdgcn_permlane32_swap(__float_as_uint(pmax), __float_as_uint(pmax), false, false);
    pmax = fmaxf(__uint_as_float(rr[0]), __uint_as_float(rr[1])); }
  if (__builtin_expect(__all(pmax - m_reg <= THR / SCALE), 1)) { mn = m_reg; alpha = 1.f; }
  else { mn = fmaxf(m_reg, pmax); alpha = __builtin_amdgcn_exp2f((m_reg - mn) * C); m_reg = mn; }
  float mnC = -mn * C;
  for (int r = 0; r < 16; ++r) p0[r] = fmaf(p0[r], C, mnC); for (int r = 0; r < 16; ++r) p1[r] = fmaf(p1[r], C, mnC);
  for (int r = 0; r < 16; ++r) p0[r] = __builtin_amdgcn_exp2f(p0[r]);
}
__device__ __forceinline__ void finishSM(f32x16& p0, f32x16& p1, float alpha, float& l_reg, bf16x8& pa0, bf16x8& pa1, bf16x8& pa2, bf16x8& pa3) {
  for (int r = 0; r < 16; ++r) p1[r] = __builtin_amdgcn_exp2f(p1[r]);
  float ps = 0; for (int r = 0; r < 16; ++r) ps += p0[r]; for (int r = 0; r < 16; ++r) ps += p1[r];
  { auto rr = __builtin_amdgcn_permlane32_swap(__float_as_uint(ps), __float_as_uint(ps), false, false);
    ps = __uint_as_float(rr[0]) + __uint_as_float(rr[1]); }
  l_reg = l_reg * alpha + ps;
#define GPK4(P, BASE, OUT) do { unsigned a0 = cvtpk(P[BASE + 0], P[BASE + 1]), a1 = cvtpk(P[BASE + 2], P[BASE + 3]);   \
    unsigned b0 = cvtpk(P[BASE + 4], P[BASE + 5]), b1 = cvtpk(P[BASE + 6], P[BASE + 7]);                              \
    auto r0 = __builtin_amdgcn_permlane32_swap(a0, b0, false, false); auto r1 = __builtin_amdgcn_permlane32_swap(a1, b1, false, false); \
    u32x4 w = {r0[0], r1[0], r0[1], r1[1]}; OUT = *reinterpret_cast<bf16x8*>(&w); } while (0)
  GPK4(p0, 0, pa0); GPK4(p0, 8, pa1); GPK4(p1, 0, pa2); GPK4(p1, 8, pa3);
#undef GPK4
}
__device__ __forceinline__ void qkt(f32x16& p0, f32x16& p1, const bf16_t* Ks, const bf16x8* qr, int r32, int hi) {
  p0 = f32x16{}; p1 = f32x16{};
  for (int d0 = 0; d0 < 8; ++d0) { int cb = (d0 * 16 + hi * 8) * 2;
    bf16x8 b0 = *reinterpret_cast<const bf16x8*>((const char*)Ks + KSWZ(r32, cb));
    bf16x8 b1 = *reinterpret_cast<const bf16x8*>((const char*)Ks + KSWZ(32 + r32, cb));
    p0 = __builtin_amdgcn_mfma_f32_32x32x16_bf16(b0, qr[d0], p0, 0, 0, 0);
    p1 = __builtin_amdgcn_mfma_f32_32x32x16_bf16(b1, qr[d0], p1, 0, 0, 0); }
}
constexpr int v_rd_off(int d0, int ks, int half) { return d0 * 512 + ks * 4096 + half * 2048; }
template <int OFF> __device__ __forceinline__ s16x4 tr_read(int vb) {
  s16x4 r; asm volatile("ds_read_b64_tr_b16 %0, %1 offset:%2" : "=&v"(r) : "v"(vb), "i"(OFF) : "memory"); return r;
}
template <int D0> __device__ __forceinline__ void pv_one(f32x16& od, int vb, bf16x8 pa0, bf16x8 pa1, bf16x8 pa2, bf16x8 pa3) {
  const s16x4 l0 = tr_read<v_rd_off(D0, 0, 0)>(vb), h0 = tr_read<v_rd_off(D0, 0, 1)>(vb), l1 = tr_read<v_rd_off(D0, 1, 0)>(vb), h1 = tr_read<v_rd_off(D0, 1, 1)>(vb);
  const s16x4 l2 = tr_read<v_rd_off(D0, 2, 0)>(vb), h2 = tr_read<v_rd_off(D0, 2, 1)>(vb), l3 = tr_read<v_rd_off(D0, 3, 0)>(vb), h3 = tr_read<v_rd_off(D0, 3, 1)>(vb);
  asm volatile("s_waitcnt lgkmcnt(0)" ::: "memory"); SBAR();
#define PK(L, H) (bf16x8){L[0], L[1], L[2], L[3], H[0], H[1], H[2], H[3]}
  od = __builtin_amdgcn_mfma_f32_32x32x16_bf16(pa0, PK(l0, h0), od, 0, 0, 0);
  od = __builtin_amdgcn_mfma_f32_32x32x16_bf16(pa1, PK(l1, h1), od, 0, 0, 0);
  od = __builtin_amdgcn_mfma_f32_32x32x16_bf16(pa2, PK(l2, h2), od, 0, 0, 0);
  od = __builtin_amdgcn_mfma_f32_32x32x16_bf16(pa3, PK(l3, h3), od, 0, 0, 0);
#undef PK
}
__device__ __forceinline__ void pv_d0(f32x16* o, int vb, bf16x8 pa0, bf16x8 pa1, bf16x8 pa2, bf16x8 pa3) {
  pv_one<0>(o[0], vb, pa0, pa1, pa2, pa3); pv_one<1>(o[1], vb, pa0, pa1, pa2, pa3); pv_one<2>(o[2], vb, pa0, pa1, pa2, pa3); pv_one<3>(o[3], vb, pa0, pa1, pa2, pa3);
}
__device__ __forceinline__ void unit(const bf16_t* __restrict__ GQ, const bf16_t* __restrict__ Kh, const bf16_t* __restrict__ Vh, const bf16_t* __restrict__ GZ, bf16_t* __restrict__ MIX,
                                     const float* __restrict__ qng, const float* __restrict__ ropeR, const float* __restrict__ ropeC, int qrow0, int head, int seq, char* lds, int tid_in) {
  int tid = tid_in; asm volatile("" : "+v"(tid)); const int wid = __builtin_amdgcn_readfirstlane(tid >> 6), lane = tid & 63, r32 = lane & 31, hi = lane >> 5;
  LAUNDER_S(Kh); LAUNDER_S(Vh); LAUNDER_S(GQ); LAUNDER_S(GZ); LAUNDER_S(MIX);
  bf16_t* V_lds = (bf16_t*)lds; bf16_t* K_lds = (bf16_t*)(lds + 2 * SHM_V);
  float* ws = (float*)(lds + 2 * SHM_V + 2 * SHM_K) + wid * 64; float* li_l = ws; float* al_l = ws + 32;
  float m_reg = -1e30f, l_reg = 0; f32x16 o[4] = {}; bf16x8 qr[8];
  {
    const int row = qrow0 + wid * QBLK + r32; const bf16_t* qp_ = GQ + (size_t)(qrow0 + wid * QBLK) * LDQ + head * D; const unsigned qo_ = (unsigned)(r32 * LDQ + hi * 8) * 2u;
    bf16x8 v[8]; float ss = 0.f;
#pragma unroll
    for (int d0 = 0; d0 < 8; ++d0) { v[d0] = GLD8(qp_ + d0 * 16, qo_);
#pragma unroll
      for (int j = 0; j < 8; ++j) { const float f = bf2f(v[d0][j]); ss += f * f; } }
    ss = swap_add(ss);
    const float rq = 1.0f / sqrtf(ss * (1.f / 128.f) + RMS_EPS);
    const int t = row & 8191, pr = t >> 6, pc = t & 63;
#pragma unroll
    for (int ax = 0; ax < 2; ++ax)
#pragma unroll
      for (int dd = 0; dd < 2; ++dd) { const int da = 4 * ax + dd, db = da + 2; const float* tb = ax ? ropeC + (size_t)pc * 64 : ropeR + (size_t)pr * 64;
        float o1[8], o2[8];
#pragma unroll
        for (int j = 0; j < 8; ++j) { const int i = 16 * dd + 8 * hi + j; const float c = tb[i * 2], s = tb[i * 2 + 1];
          const float x1 = bf2f(v[da][j]) * rq * qng[16 * da + 8 * hi + j], x2 = bf2f(v[db][j]) * rq * qng[16 * db + 8 * hi + j];
          o1[j] = x1 * c - x2 * s; o2[j] = x1 * s + x2 * c; }
        { u32x4 w = {cvt_pk_bf16(o1[0], o1[1]), cvt_pk_bf16(o1[2], o1[3]), cvt_pk_bf16(o1[4], o1[5]), cvt_pk_bf16(o1[6], o1[7])}; qr[da] = __builtin_bit_cast(bf16x8, w); }
        { u32x4 w = {cvt_pk_bf16(o2[0], o2[1]), cvt_pk_bf16(o2[2], o2[3]), cvt_pk_bf16(o2[4], o2[5]), cvt_pk_bf16(o2[6], o2[7])}; qr[db] = __builtin_bit_cast(bf16x8, w); }
        asm volatile("" ::: "memory"); }
  }
  const int sr = tid >> 4, sc = (tid & 15) * 8, vst0 = v_st(sr, sc), vst1 = v_st(32 + sr, sc);
  const int vb0 = (int)(uintptr_t)V_lds + v_rd_base(lane);
  struct { bf16x8 vs0, vs1, ks0, ks1; } sr_[1];
  const unsigned so0 = (unsigned)(sr * LDK + sc) * 2u, so1 = (unsigned)((32 + sr) * LDK + sc) * 2u;
#define SLOAD(i, k0) do { const bf16_t* vt_ = Vh + (size_t)(k0) * LDK; const bf16_t* kt_ = Kh + (size_t)(k0) * LDK; \
    sr_[i].vs0 = GLD8(vt_, so0); sr_[i].vs1 = GLD8(vt_, so1); sr_[i].ks0 = GLD8(kt_, so0); sr_[i].ks1 = GLD8(kt_, so1); } while (0)
#define SWRITE(b, i) do { *(bf16x8*)((char*)V_lds + (b) * SHM_V + vst0) = sr_[i].vs0;          \
    *(bf16x8*)((char*)V_lds + (b) * SHM_V + vst1) = sr_[i].vs1; int kc = sc * 2;               \
    *(bf16x8*)((char*)K_lds + (b) * SHM_K + KSWZ(sr, kc)) = sr_[i].ks0;                       \
    *(bf16x8*)((char*)K_lds + (b) * SHM_K + KSWZ(32 + sr, kc)) = sr_[i].ks1; } while (0)
#define SWAIT() asm volatile("s_waitcnt vmcnt(0)" ::: "memory")
#define RESC(a) do { if (__any((a) < 1.f)) { if (hi == 0) al_l[r32] = (a); asm volatile("s_waitcnt lgkmcnt(0)" ::: "memory"); \
    for (int d = 0; d < 4; ++d) for (int r = 0; r < 16; ++r) o[d][r] *= al_l[crow(r, hi)]; } } while (0)
  f32x16 pA0, pA1, pB0, pB1; float mnA, mnB, alA, alB; bf16x8 pa0, pa1, pa2, pa3; const int NT = seq / KVBLK;
  constexpr int SE = 0, SO = 0;
  SLOAD(SE, 0); asm volatile("s_waitcnt vmcnt(0)" ::: "memory"); SWRITE(0, SE); __syncthreads();
  qkt(pA0, pA1, K_lds, qr, r32, hi); partialSM(pA0, pA1, m_reg, mnA, alA);
  SLOAD(SO, KVBLK);
  SWAIT(); SWRITE(1, SO); __syncthreads();
  for (int j = 1; j + 1 < NT; j += 2) {
    SBAR(); qkt(pB0, pB1, (bf16_t*)((char*)K_lds + SHM_K), qr, r32, hi);
    finishSM(pA0, pA1, alA, l_reg, pa0, pa1, pa2, pa3); SBAR();
    SLOAD(SO, (j + 1) * KVBLK); SBAR();
    pv_d0(o, vb0, pa0, pa1, pa2, pa3); partialSM(pB0, pB1, m_reg, mnB, alB);
    __syncthreads(); SWAIT(); SWRITE(0, SE);
    RESC(alB); __syncthreads();
    SBAR(); qkt(pA0, pA1, K_lds, qr, r32, hi);
    finishSM(pB0, pB1, alB, l_reg, pa0, pa1, pa2, pa3); SBAR();
    SLOAD(SE, (j + 2) * KVBLK); SBAR();
    pv_d0(o, vb0 + (int)SHM_V, pa0, pa1, pa2, pa3); partialSM(pA0, pA1, m_reg, mnA, alA);
    __syncthreads(); SWAIT(); SWRITE(1, SO);
    RESC(alA); __syncthreads();
  }
  SBAR(); qkt(pB0, pB1, (bf16_t*)((char*)K_lds + SHM_K), qr, r32, hi);
  finishSM(pA0, pA1, alA, l_reg, pa0, pa1, pa2, pa3); SBAR();
  pv_d0(o, vb0, pa0, pa1, pa2, pa3); partialSM(pB0, pB1, m_reg, mnB, alB);
  __syncthreads(); RESC(alB);
  finishSM(pB0, pB1, alB, l_reg, pa0, pa1, pa2, pa3); SBAR();
  pv_d0(o, vb0 + (int)SHM_V, pa0, pa1, pa2, pa3);
  if (hi == 0) li_l[r32] = l_reg; asm volatile("s_waitcnt lgkmcnt(0)" ::: "memory");
  const bf16_t* zb_ = GZ + (size_t)(qrow0 + wid * QBLK) * 1024 + head * D; bf16_t* ob_ = MIX + (size_t)(qrow0 + wid * QBLK) * 2048 + head * D;
  const unsigned zo_ = (unsigned)(4 * hi * 1024 + r32) * 2u, oo_ = (unsigned)(4 * hi * 2048 + r32) * 2u;
#pragma unroll
  for (int r = 0; r < 16; ++r) { const float rli = __builtin_amdgcn_rcpf(li_l[crow(r, hi)]); const int cr = (r & 3) + 8 * (r >> 2);
#pragma unroll
    for (int d0 = 0; d0 < 4; ++d0) GP16(ob_, oo_ + cr * 4096 + 64 * d0) = f2b(o[d0][r] * rli * bf2f(GPC16(zb_, zo_ + cr * 2048 + 64 * d0)));
    if ((r & 3) == 3) asm volatile("" ::: "memory"); }
  __syncthreads();
#undef SLOAD
#undef SWRITE
#undef SWAIT
#undef RESC
}
#undef KSWZ
#undef SBAR
}

__device__ __forceinline__ void p12_final(Frame& F, const Args& A_) {
    const int gw = F.vcu * NWAVES + F.wave, NGW = F.G * NWAVES; const float* fg = A_.in[2];
    for (int row = gw; row < M; row += NGW) {
        f32x4* p = (f32x4*)(F.out + (size_t)row * 1024) + F.lane; f32x4 v[4]; float s = 0.f;
#pragma unroll
        for (int j = 0; j < 4; ++j) { v[j] = p[64 * j]; s += (v[j][0] * v[j][0] + v[j][1] * v[j][1]) + (v[j][2] * v[j][2] + v[j][3] * v[j][3]); }
#pragma unroll
        for (int o = 1; o < 64; o <<= 1) s += __shfl_xor(s, o);
        const float r = 1.0f / sqrtf(s * (1.f / 1024.f) + RMS_EPS);
#pragma unroll
        for (int j = 0; j < 4; ++j) { const f32x4 g = *((const f32x4*)fg + F.lane + 64 * j); p[64 * j] = v[j] * r * g; }
    }
}

__global__ void __launch_bounds__(NTHR, 2) mega_fwd(Args args) {
    extern __shared__ __attribute__((aligned(16))) unsigned char lds[];
    Frame F;
    F.lds = (LAS unsigned char*)lds; F.MISC = (volatile LAS unsigned*)(F.lds + MISC_OFF);
    F.tid = threadIdx.x; F.lane = F.tid & 63; F.wave = __builtin_amdgcn_readfirstlane(F.tid >> 6);
    F.G = gridDim.x; { const int bx = blockIdx.x; F.vcu = (F.G % 8 == 0) ? (bx % 8) * (F.G / 8) + bx / 8 : bx; }
    F.ws = args.ws; F.out = args.out; F.ctl = (gu32*)(args.ws + WS_CTL);
    for (int u = F.tid; u < (LDS_BYTES - LDSCTL_OFF) / 4; u += NTHR) ((LAS unsigned*)(F.lds + LDSCTL_OFF))[u] = 0u;
    __syncthreads();
    XcdBarrier bar = xcd_barrier_post((unsigned*)(F.ctl + CW_BAR), F.MISC + 8);
    const int lo = args.ph_lo, hi = args.ph_hi;
#ifndef PHMASK
#define PHMASK 0x1fff
#endif
#define IN(k) (((PHMASK >> (k)) & 1) && lo <= (k) && (k) < hi && phase_enter(F))
#define SEAM(k) do { if (IN(k) && IN((k) + 1)) xcd_barrier(bar); } while (0)

    if (IN(0)) { p0_prologue(F, args); } SEAM(0);
    if (IN(1)) {
        pg8::Gemm g{WSP(bf16_t, WS_U0), WSP(bf16_t, WS_W1T), M, 5120, 1024}; pg8::StaticOrder S; S.init(M, 5120, F.G, (int)blockIdx.x);
        pg8::EpiAct E{0, WSP(bf16_t, WS_A0), WSP(bf16_t, WS_A1), WSP(bf16_t, WS_A2), WSP(bf16_t, WS_A3), nullptr, nullptr, WSP(float, WS_RS0), 1};
        pg8::gemm_phase<pg8::EpiAct, pg8::StaticOrder, true, true>(F.lds, g, S, E);
    } SEAM(1);
    if (IN(2)) { for (int u = F.vcu; u < 256; u += F.G) x1_unit(F, args, u); } SEAM(2);
    if (IN(3)) { x2_scan(F); } SEAM(3);
    if (IN(4)) { for (int u = F.vcu; u < 256; u += F.G) x3_unit(F, args, u); } SEAM(4);
    if (IN(5)) {
        pg8::Gemm g{WSP(bf16_t, WS_U0), WSP(bf16_t, WS_W1T) + (size_t)5120 * 1024, M, 4096, 1024}; pg8::StaticOrder S; S.init(M, 4096, F.G, (int)blockIdx.x);
        pg8::EpiAct E{1, WSP(bf16_t, WS_A0), WSP(bf16_t, WS_A1), WSP(bf16_t, WS_A2), WSP(bf16_t, WS_A3), nullptr, nullptr, WSP(float, WS_RS0), 1};
        pg8::gemm_phase<pg8::EpiAct, pg8::StaticOrder, true, true>(F.lds, g, S, E);
    } SEAM(5);
    if (IN(6)) {
        { LAS float* scr = (LAS float*)(F.lds + F.wave * 16384); const int gw = F.vcu * NWAVES + F.wave, NGW = F.G * NWAVES;
          for (int it = gw; it < 16 * 208; it += NGW) { const int kb = it / 208, d = 32 * (it % 208); transpose_item(args.in[8], ODD_IN, 1024, WSP(bf16_t, WS_W3T), d, map_w3(d), args.in[1] + 1024, scr, kb, F.lane); }
          __syncthreads(); }
#pragma unroll 1
        for (int i = 0; i < 4; ++i) { const int u = F.vcu * 4 + i; if (u < 1024) na_unit(F, args, u); }
    } SEAM(6);
    if (IN(7)) {
        pg8::Gemm g{WSP(bf16_t, WS_MIX0), WSP(bf16_t, WS_W2T), M, 1024, 2048}; pg8::StaticOrder S; S.init(M, 1024, F.G, (int)blockIdx.x);
        pg8::EpiResid E{args.in[0], F.out, WSP(bf16_t, WS_H1B), WSP(float, WS_PART)};
        pg8::gemm_phase<pg8::EpiResid, pg8::StaticOrder, false, true>(F.lds, g, S, E);
    } SEAM(7);
    if (IN(8)) {
        pg8::Gemm g{WSP(bf16_t, WS_H1B), WSP(bf16_t, WS_W3T), M, 6656, 1024}; pg8::StaticOrder S; S.init(M, 6656, F.G, (int)blockIdx.x);
        pg8::EpiAct E{2, WSP(bf16_t, WS_GQ), WSP(bf16_t, WS_GK), WSP(bf16_t, WS_GV), WSP(bf16_t, WS_GZ), WSP(bf16_t, WS_XC), WSP(bf16_t, WS_CG), WSP(float, WS_PART), 2};
        pg8::gemm_phase<pg8::EpiAct, pg8::StaticOrder, true, true>(F.lds, g, S, E);
    } SEAM(8);
    if (IN(9)) { p9_krope_conv(F, args); } SEAM(9);
    if (IN(10)) {
        const int combo = F.vcu >> 6, b = combo >> 1, kvh = combo & 1, idx = F.vcu & 63;
        if (F.vcu < 256)
#pragma unroll 1
        for (int i = 0; i < 2; ++i) { const int uu = idx * 2 + i, head = 4 * kvh + (uu >> 5), qblk = uu & 31;
            gqa::unit(WSP(bf16_t, WS_GQ), WSP(bf16_t, WS_GK) + (size_t)b * SEQ * 256 + kvh * 128, WSP(bf16_t, WS_GV) + (size_t)b * SEQ * 256 + kvh * 128, WSP(bf16_t, WS_GZ), WSP(bf16_t, WS_MIX1),
                      args.in[10], WSP(float, WS_ROPE), WSP(float, WS_ROPE) + 8192, b * SEQ + 256 * qblk, head, SEQ, (char*)lds, F.tid); }
    } SEAM(10);
    if (IN(11)) {
        pg8::Gemm g{WSP(bf16_t, WS_MIX1), WSP(bf16_t, WS_W4T), M, 1024, 2048}; pg8::StaticOrder S; S.init(M, 1024, F.G, (int)blockIdx.x);
        pg8::EpiResid E{F.out, F.out, nullptr, nullptr};
        pg8::gemm_phase<pg8::EpiResid, pg8::StaticOrder, false, true>(F.lds, g, S, E);
    } SEAM(11);
    if (IN(12)) { p12_final(F, args); }
#undef IN
#undef SEAM
}

extern "C" void kernel_launch(void* const* d_in, const int* in_sizes, int n_in, void* d_out, int out_size, void* d_ws, size_t ws_size, hipStream_t stream) {
    static int grid = 0;
    if (grid == 0) {
        if (n_in != 14 || in_sizes[0] != M * DM || out_size != M * DM || ws_size < WS_END) { fprintf(stderr, "kernel_launch: unexpected shapes/workspace: n_in %d in0 %d out %d ws %zu\n", n_in, n_in > 0 ? in_sizes[0] : -1, out_size, ws_size); grid = -1; return; }
        int dev = 0, cus = 0, per_cu = 0;
        if (hipGetDevice(&dev) != hipSuccess || hipDeviceGetAttribute(&cus, hipDeviceAttributeMultiprocessorCount, dev) != hipSuccess) { grid = -1; return; }
        if (hipFuncSetAttribute((const void*)mega_fwd, hipFuncAttributeMaxDynamicSharedMemorySize, LDS_BYTES) != hipSuccess) { fprintf(stderr, "kernel_launch: hipFuncSetAttribute failed\n"); grid = -1; return; }
        if (hipOccupancyMaxActiveBlocksPerMultiprocessor(&per_cu, (const void*)mega_fwd, NTHR, LDS_BYTES) != hipSuccess || per_cu < 1) { fprintf(stderr, "kernel_launch: occupancy query reports %d\n", per_cu); per_cu = 1; }
        (void)hipGetLastError();
        grid = cus;
    }
    if (grid < 0) return;
    if (hipMemsetAsync((char*)d_ws + WS_CTL, 0, CTL_ZERO_BYTES, stream) != hipSuccess) return;
    Args a{};
    for (int i = 0; i < 14; ++i) a.in[i] = (const float*)d_in[i];
    a.out = (float*)d_out; a.ws = (unsigned char*)d_ws;
#ifdef MK_SPLIT
    for (int p = 0; p < NPHASE; ++p) { a.ph_lo = p; a.ph_hi = p + 1; hipLaunchKernelGGL(mega_fwd, dim3(grid), dim3(NTHR), LDS_BYTES, stream, a); }
#else
    a.ph_lo = 0; a.ph_hi = NPHASE;
    hipLaunchKernelGGL(mega_fwd, dim3(grid), dim3(NTHR), LDS_BYTES, stream, a);
#endif
}
```

```cpp
#include <hip/hip_runtime.h>
#include <cstdio>
#include <cstdint>
#include <cmath>
namespace pg8 {
#define PG8_LAS __attribute__((address_space(3)))
typedef unsigned short bf16_t;
typedef short bf16x8 __attribute__((ext_vector_type(8)));
typedef float f32x4 __attribute__((ext_vector_type(4)));
typedef unsigned u32x4 __attribute__((ext_vector_type(4)));
constexpr int BM = 256, BK = 64, HALF = 128, HTB = HALF * BK * 2  , STAGE_BYTES = 8 * HTB, NXCD = 8, WGM = 8;

__host__ __device__ __forceinline__ int lds_byte(int r, int c) { const int st = (r >> 4) * 2 + (c >> 5), rr = r & 15, cc = c & 31, ob = rr * 64 + cc * 2; return st * 1024 + (ob ^ (((ob >> 9) & 1) << 5)); }
__host__ __device__ __forceinline__ void stage_rc(int b, int& R, int& C) { const int st = b / 1024, sb = b % 1024, swz = sb ^ (((sb >> 9) & 1) << 5); R = (st >> 1) * 16 + swz / 64; C = (st & 1) * 32 + (swz % 64) / 2; }
__host__ __device__ __forceinline__ int perm32(int rho) { const int n = rho >> 4, i = rho & 15; return 8 * (i >> 2) + 4 * n + (i & 3); }

struct Unit { int pm, pn; };
struct Gemm { const bf16_t* A; const bf16_t* Bt; int M, N, K; };

struct StaticOrder {
    int nM, nN, nwg, G, c;
    __host__ __device__ void init(int M, int N, int G_, int c_) { nM = M / BM; nN = N / BM; nwg = nM * nN; G = G_; c = c_; }
    __host__ __device__ bool next(int i, Unit& u) const {
        const long L = (long)i * G + c; if (L >= nwg) return false;
        int wgid = (int)L; { const int q = nwg / NXCD, r = nwg % NXCD, xcd = wgid % NXCD, off = wgid / NXCD; wgid = (xcd < r ? xcd * (q + 1) : r * (q + 1) + (xcd - r) * q) + off; }
        const int nig = WGM * nN, gid = wgid / nig, fm = gid * WGM, gsz = (nM - fm) < WGM ? (nM - fm) : WGM;
        u.pm = fm + ((wgid % nig) % gsz); u.pn = (wgid % nig) / gsz; return true;
    }
    __device__ __forceinline__ void a_ready(const Unit&) const {}
    __device__ __forceinline__ void done(const Unit&) const {}
};

typedef float f32x2 __attribute__((ext_vector_type(2)));
typedef __bf16 bf16x2_t __attribute__((ext_vector_type(2)));
__device__ __forceinline__ unsigned cvt_pk_bf16(float lo, float hi) { f32x2 v = {lo, hi}; bf16x2_t b = __builtin_convertvector(v, bf16x2_t); return __builtin_bit_cast(unsigned, b); }
__device__ __forceinline__ float fexp(float x) { return __builtin_amdgcn_exp2f(x * 1.4426950408889634f); }
__device__ __forceinline__ float sigm(float x) { return __builtin_amdgcn_rcpf(1.f + fexp(-x)); }
__device__ __forceinline__ float silu(float x) { return x * sigm(x); }

#define PG8_GAS __attribute__((address_space(1)))
struct TileOut { PG8_GAS bf16_t* dst; int ldc; int col0; int mode; float scale; };
struct EpiAct {
    static constexpr bool PERM = true, AFTER_DRAIN = false;
    int gid;
    PG8_GAS bf16_t *T0, *T1, *T2, *T3, *T4, *T5;
    const PG8_GAS float* rs; int rs_mode;
    __device__ __forceinline__ TileOut tile(int pn) const {
        TileOut t;
        if (gid == 0) {
            if (pn < 4)       t = TileOut{T0, 1024, 256 * pn, 0, 1.f};
            else if (pn < 8)  t = TileOut{T1, 1024, 256 * (pn - 4), 0, 0.0625f};
            else if (pn < 12) t = TileOut{T2, 1024, 256 * (pn - 8), 0, 1.f};
            else              t = TileOut{T3, 1024, 128 * (pn - 12), 2, 1.f};
        } else if (gid == 1) {
            if (pn < 4)       t = TileOut{T0, 1024, 256 * pn, 0, 0.125f};
            else if (pn < 8)  t = TileOut{T1, 1024, 256 * (pn - 4), 0, 1.f};
            else if (pn < 12) t = TileOut{T2, 1024, 256 * (pn - 8), 0, 1.f};
            else              t = TileOut{T3, 1024, 256 * (pn - 12), 1, 1.f};
        } else {
            if (pn < 4)        t = TileOut{T0, 1024, 256 * pn, 0, 1.f};
            else if (pn == 4)  t = TileOut{T1, 256, 0, 0, 1.f};
            else if (pn == 5)  t = TileOut{T2, 256, 0, 0, 1.f};
            else if (pn < 10)  t = TileOut{T3, 1024, 256 * (pn - 6), 1, 1.f};
            else if (pn < 18)  t = TileOut{T4, 1024, 128 * (pn - 10), 3, 1.f};
            else               t = TileOut{T5, 1024, 128 * (pn - 18), 4, 1.f};
        }
        return t;
    }
    __device__ __forceinline__ void operator()(const f32x4 (&acc)[2][2][4][2], const Unit& u, int wr, int wc, int fr, int fq) const {
        const TileOut t = tile(u.pn);
        const int rbase = u.pm * BM + wr * 64 + fr, cl = wc * 32 + 8 * fq;
#pragma unroll
        for (int ai = 0; ai < 2; ++ai)
#pragma unroll
            for (int m = 0; m < 4; ++m) {
                const int row = rbase + ai * HALF + m * 16;
                float r = t.scale;
                if (rs_mode == 1) r *= rs[row];
                else if (rs_mode == 2) { const PG8_GAS f32x4* pp = (const PG8_GAS f32x4*)(rs + (size_t)row * 16); const f32x4 a = pp[0], b = pp[1], c = pp[2], d = pp[3];
                    const float s = ((a[0] + a[1]) + (a[2] + a[3])) + ((b[0] + b[1]) + (b[2] + b[3])) + ((c[0] + c[1]) + (c[2] + c[3])) + ((d[0] + d[1]) + (d[2] + d[3]));
                    r *= __builtin_amdgcn_rsqf(s * (1.f / 1024.f) + 1e-6f); }
                PG8_GAS bf16_t* rowp = t.dst + (size_t)row * t.ldc + t.col0 + cl;
                if (t.mode <= 1) {
#pragma unroll
                    for (int bj = 0; bj < 2; ++bj) { f32x4 v0 = acc[ai][bj][m][0] * r, v1 = acc[ai][bj][m][1] * r;
                        if (t.mode == 1) {
#pragma unroll
                            for (int j = 0; j < 4; ++j) { v0[j] = silu(v0[j]); v1[j] = silu(v1[j]); } }
                        u32x4 w; w.x = cvt_pk_bf16(v0[0], v0[1]); w.y = cvt_pk_bf16(v0[2], v0[3]); w.z = cvt_pk_bf16(v1[0], v1[1]); w.w = cvt_pk_bf16(v1[2], v1[3]);
                        *(PG8_GAS u32x4*)(rowp + bj * HALF) = w; }
                } else {
                    f32x4 o[2];
#pragma unroll
                    for (int n = 0; n < 2; ++n) { const f32x4 a = acc[ai][0][m][n] * r, b = acc[ai][1][m][n] * r;
#pragma unroll
                        for (int j = 0; j < 4; ++j) o[n][j] = (t.mode == 2) ? sigm(a[j]) * silu(b[j]) : (t.mode == 3) ? a[j] * b[j] : a[j] * silu(b[j]); }
                    u32x4 w; w.x = cvt_pk_bf16(o[0][0], o[0][1]); w.y = cvt_pk_bf16(o[0][2], o[0][3]); w.z = cvt_pk_bf16(o[1][0], o[1][1]); w.w = cvt_pk_bf16(o[1][2], o[1][3]);
                    *(PG8_GAS u32x4*)rowp = w;
                }
            }
    }
};
struct EpiResid {
    static constexpr bool PERM = false, AFTER_DRAIN = false;
    const PG8_GAS float* base; PG8_GAS float* out; PG8_GAS bf16_t* outb; PG8_GAS float* part;
    __device__ __forceinline__ void operator()(const f32x4 (&acc)[2][2][4][2], const Unit& u, int wr, int wc, int fr, int fq) const {
        typedef unsigned u32x2v __attribute__((ext_vector_type(2)));
        const int col0 = u.pn * BM + wc * 32 + 4 * fq;
#pragma unroll
        for (int ai = 0; ai < 2; ++ai)
#pragma unroll
            for (int m = 0; m < 4; ++m) { const int row = u.pm * BM + ai * HALF + wr * 64 + m * 16 + fr; const size_t off = (size_t)row * 1024 + col0; float ss = 0.f;
#pragma unroll
                for (int bj = 0; bj < 2; ++bj)
#pragma unroll
                    for (int n = 0; n < 2; ++n) { const f32x4 bs = *(const PG8_GAS f32x4*)(base + off + bj * HALF + n * 16); const f32x4 o = bs + acc[ai][bj][m][n];
                        *(PG8_GAS f32x4*)(out + off + bj * HALF + n * 16) = o; ss += (o[0] * o[0] + o[1] * o[1]) + (o[2] * o[2] + o[3] * o[3]);
                        if (outb) { u32x2v w; w.x = cvt_pk_bf16(o[0], o[1]); w.y = cvt_pk_bf16(o[2], o[3]); *(PG8_GAS u32x2v*)(outb + off + bj * HALF + n * 16) = w; } }
                ss += __shfl_xor(ss, 16); ss += __shfl_xor(ss, 32);
                if (part && fq == 0) part[(size_t)row * 16 + u.pn * 4 + wc] = ss;
                if (m & 1) asm volatile("" ::: "memory"); }
    }
};

template <class Epi, class Sched, bool ALIGN_EPI = false, bool SP2 = false>
__device__ __forceinline__ void gemm_phase(PG8_LAS unsigned char* lds, const Gemm g, const Sched& S, const Epi& E) {
    const int tid = threadIdx.x, wid = __builtin_amdgcn_readfirstlane(tid >> 6), lane = tid & 63, wr = wid >> 2, wc = wid & 3, fr = lane & 15, fq = lane >> 4;
    const int K = g.K, nt = K / BK;
    unsigned voffA[2], voffB[2];
#pragma unroll
    for (int i = 0; i < 2; ++i) { int R, C; stage_rc(tid * 16 + i * 8192, R, C); const int Rb = Epi::PERM ? ((R & ~31) + perm32(R & 31)) : R;
        voffA[i] = (unsigned)(R * K + C) * 2u; voffB[i] = (unsigned)(Rb * K + C) * 2u; }
    const size_t kstep = (size_t)(BK * 2);
    const size_t hstep = (size_t)HALF * K * 2;
    const size_t tstep = 2 * hstep;
    const unsigned ldsw = (unsigned)wid * 1024u;
    const int aoff = lds_byte(wr * 64 + fr, fq * 8), boff = lds_byte(wc * 32 + fr, fq * 8);
#define PG8_SA(b, h) (((b) * 2 + (h)) * HTB)
#define PG8_SB(b, h) ((4 + (b) * 2 + (h)) * HTB)
#define PG8_STAGE(bufoff, gbase, voff) do { _Pragma("unroll") for (int _i = 0; _i < 2; ++_i) \
        __builtin_amdgcn_global_load_lds((const unsigned*)((const char*)(gbase) + (voff)[_i]), (PG8_LAS unsigned*)(lds + (bufoff) + ldsw + _i * 8192), 16, 0, 0); } while (0)
#define PG8_LDA(dst, b, h) do { _Pragma("unroll") for (int m = 0; m < 4; ++m) _Pragma("unroll") for (int k = 0; k < 2; ++k) dst[m][k] = *(const PG8_LAS bf16x8*)(lds + PG8_SA(b, h) + aoff + m * 2048 + k * 1024); } while (0)
#define PG8_LDB(dst, b, h) do { _Pragma("unroll") for (int n = 0; n < 2; ++n) _Pragma("unroll") for (int k = 0; k < 2; ++k) dst[n][k] = *(const PG8_LAS bf16x8*)(lds + PG8_SB(b, h) + boff + n * 2048 + k * 1024); } while (0)
#define PG8_MMA(ai, bj, At, Bt) do { __builtin_amdgcn_s_setprio(1); _Pragma("unroll") for (int m = 0; m < 4; ++m) _Pragma("unroll") for (int n = 0; n < 2; ++n) _Pragma("unroll") for (int k = 0; k < 2; ++k) \
        acc[ai][bj][m][n] = __builtin_amdgcn_mfma_f32_16x16x32_bf16(Bt[n][k], At[m][k], acc[ai][bj][m][n], 0, 0, 0); __builtin_amdgcn_s_setprio(0); } while (0)
#define PG8_WAIT_V(n) asm volatile("s_waitcnt vmcnt(" #n ")" ::: "memory")
#define PG8_WAIT_L(n) asm volatile("s_waitcnt lgkmcnt(" #n ")" ::: "memory")
#define PG8_BAR __builtin_amdgcn_s_barrier()
#define PG8_SCHED __builtin_amdgcn_sched_barrier(0)
    Unit cur, nxt; int ui = 0;
    if (!S.next(0, cur)) return;
    f32x4 acc[2][2][4][2];
#pragma unroll
    for (int a = 0; a < 2; ++a)
#pragma unroll
        for (int b = 0; b < 2; ++b)
#pragma unroll
            for (int m = 0; m < 4; ++m)
#pragma unroll
                for (int n = 0; n < 2; ++n) acc[a][b][m][n] = (f32x4){0.f, 0.f, 0.f, 0.f};
    bf16x8 At[4][2], B0[2][2], B1[2][2];
    const char* cA = (const char*)g.A + (size_t)cur.pm * tstep; const char* cB = (const char*)g.Bt + (size_t)cur.pn * tstep;
    S.a_ready(cur);
    if constexpr (SP2) {
        PG8_STAGE(PG8_SB(0, 0), cB, voffB); PG8_STAGE(PG8_SB(0, 1), cB + hstep, voffB); PG8_STAGE(PG8_SA(0, 0), cA, voffA); PG8_STAGE(PG8_SA(0, 1), cA + hstep, voffA);
        if (wr == 1) PG8_BAR;
        PG8_WAIT_V(2); PG8_BAR;
        PG8_STAGE(PG8_SB(1, 0), cB + kstep, voffB); PG8_STAGE(PG8_SA(1, 0), cA + kstep, voffA); PG8_STAGE(PG8_SB(1, 1), cB + hstep + kstep, voffB);
        PG8_WAIT_V(6); PG8_BAR;
    } else {
        PG8_STAGE(PG8_SB(0, 0), cB, voffB); PG8_STAGE(PG8_SA(0, 0), cA, voffA); PG8_STAGE(PG8_SB(0, 1), cB + hstep, voffB); PG8_STAGE(PG8_SA(0, 1), cA + hstep, voffA);
        if (wr == 1) PG8_BAR;
        PG8_WAIT_V(4); PG8_BAR;
        PG8_STAGE(PG8_SB(1, 0), cB + kstep, voffB); PG8_STAGE(PG8_SA(1, 0), cA + kstep, voffA); PG8_STAGE(PG8_SB(1, 1), cB + hstep + kstep, voffB);
        PG8_WAIT_V(6); PG8_BAR;
    }
    for (;;) {
        const bool has_next = S.next(ui + 1, nxt);
        const char* nA = has_next ? (const char*)g.A + (size_t)nxt.pm * tstep : cA; const char* nB = has_next ? (const char*)g.Bt + (size_t)nxt.pn * tstep : cB;
        for (int t = 0; t < nt; t += 2) {
            const bool last = (t == nt - 2);
            const char* a1 = cA + (size_t)(t + 1) * kstep;
            const char* a2 = last ? nA : cA + (size_t)(t + 2) * kstep; const char* b2 = last ? nB : cB + (size_t)(t + 2) * kstep;
            const char* a3 = a2 + kstep; const char* b3 = b2 + kstep;
            if (last && has_next) S.a_ready(nxt);
            if constexpr (SP2) {
            PG8_LDB(B0, 0, 0); PG8_LDB(B1, 0, 1); PG8_SCHED; PG8_LDA(At, 0, 0); PG8_STAGE(PG8_SA(1, 1), a1 + hstep, voffA);
            PG8_WAIT_V(8); PG8_WAIT_L(0); PG8_BAR; PG8_MMA(0, 0, At, B0); PG8_MMA(0, 1, At, B1); PG8_BAR; PG8_SCHED;
            PG8_LDA(At, 0, 1); PG8_STAGE(PG8_SB(0, 0), b2, voffB); PG8_STAGE(PG8_SB(0, 1), b2 + hstep, voffB); PG8_STAGE(PG8_SA(0, 0), a2, voffA);
            PG8_WAIT_V(8); PG8_WAIT_L(0); PG8_BAR; PG8_MMA(1, 0, At, B0); PG8_MMA(1, 1, At, B1); PG8_BAR; PG8_SCHED;
            PG8_LDB(B0, 1, 0); PG8_LDB(B1, 1, 1); PG8_SCHED; PG8_LDA(At, 1, 0); PG8_STAGE(PG8_SA(0, 1), a2 + hstep, voffA);
            PG8_WAIT_V(8); PG8_WAIT_L(0); PG8_BAR; PG8_MMA(0, 0, At, B0); PG8_MMA(0, 1, At, B1); PG8_BAR; PG8_SCHED;
            PG8_LDA(At, 1, 1); PG8_STAGE(PG8_SB(1, 0), b3, voffB); PG8_STAGE(PG8_SB(1, 1), b3 + hstep, voffB); PG8_STAGE(PG8_SA(1, 0), a3, voffA);
            PG8_WAIT_V(8); PG8_WAIT_L(0); PG8_BAR; PG8_MMA(1, 0, At, B0); PG8_MMA(1, 1, At, B1); PG8_BAR; PG8_SCHED;
            } else {
            PG8_LDB(B0, 0, 0); PG8_SCHED; PG8_LDA(At, 0, 0); PG8_STAGE(PG8_SA(1, 1), a1 + hstep, voffA);
            PG8_WAIT_L(8); PG8_BAR; PG8_WAIT_L(0); PG8_MMA(0, 0, At, B0); PG8_BAR; PG8_SCHED;
            PG8_LDB(B1, 0, 1); PG8_STAGE(PG8_SB(0, 0), b2, voffB);
            PG8_BAR; PG8_WAIT_L(0); PG8_MMA(0, 1, At, B1); PG8_BAR;
            PG8_LDA(At, 0, 1); PG8_STAGE(PG8_SA(0, 0), a2, voffA);
            PG8_BAR; PG8_WAIT_L(0); PG8_MMA(1, 0, At, B0); PG8_BAR; PG8_SCHED;
            PG8_STAGE(PG8_SB(0, 1), b2 + hstep, voffB);
            PG8_WAIT_V(6); PG8_BAR; PG8_MMA(1, 1, At, B1); PG8_BAR;
            PG8_LDB(B0, 1, 0); PG8_SCHED; PG8_LDA(At, 1, 0); PG8_STAGE(PG8_SA(0, 1), a2 + hstep, voffA);
            PG8_WAIT_L(8); PG8_BAR; PG8_WAIT_L(0); PG8_MMA(0, 0, At, B0); PG8_BAR; PG8_SCHED;
            PG8_LDB(B1, 1, 1); PG8_STAGE(PG8_SB(1, 0), b3, voffB);
            PG8_BAR; PG8_WAIT_L(0); PG8_MMA(0, 1, At, B1); PG8_BAR;
            PG8_LDA(At, 1, 1); PG8_STAGE(PG8_SA(1, 0), a3, voffA);
            PG8_BAR; PG8_WAIT_L(0); PG8_MMA(1, 0, At, B0); PG8_BAR; PG8_SCHED;
            PG8_STAGE(PG8_SB(1, 1), b3 + hstep, voffB);
            PG8_WAIT_V(6); PG8_BAR; PG8_MMA(1, 1, At, B1); PG8_BAR;
            }
        }
        if constexpr (ALIGN_EPI) { if (wr == 0) PG8_BAR; }
        if constexpr (!Epi::AFTER_DRAIN) { E(acc, cur, wr, wc, fr, fq); S.done(cur); }
        if (!has_next) break;
#pragma unroll
        for (int a = 0; a < 2; ++a)
#pragma unroll
            for (int b = 0; b < 2; ++b)
#pragma unroll
                for (int m = 0; m < 4; ++m)
#pragma unroll
                    for (int n = 0; n < 2; ++n) acc[a][b][m][n] = (f32x4){0.f, 0.f, 0.f, 0.f};
        cur = nxt; cA = nA; cB = nB; ++ui;
        if constexpr (ALIGN_EPI) { if (wr == 1) PG8_BAR; }
    }
    PG8_WAIT_V(0);
    if constexpr (!ALIGN_EPI) { if (wr == 0) PG8_BAR; }
    PG8_BAR;
    if constexpr (Epi::AFTER_DRAIN) { E.fused(acc, cur, wr, wc, fr, fq, lds, wid, lane); S.done(cur); }
#undef PG8_SA
#undef PG8_SB
#undef PG8_STAGE
#undef PG8_LDA
#undef PG8_LDB
#undef PG8_MMA
#undef PG8_WAIT_V
#undef PG8_WAIT_L
#undef PG8_BAR
#undef PG8_SCHED
}
}
#define GAS __attribute__((address_space(1)))
#define LAS __attribute__((address_space(3)))
typedef unsigned short bf16;
typedef unsigned v4u __attribute__((ext_vector_type(4)));
typedef float f32x4 __attribute__((ext_vector_type(4)));
typedef short bf16x8 __attribute__((ext_vector_type(8)));
typedef GAS unsigned gu32;
typedef GAS unsigned long long gu64;
#define RLX_AGENT __ATOMIC_RELAXED, __HIP_MEMORY_SCOPE_AGENT
#define LDS_WAIT() asm volatile("s_waitcnt lgkmcnt(0)" ::: "memory")
#define VM_WAIT() asm volatile("s_waitcnt vmcnt(0)" ::: "memory")
__device__ __forceinline__ unsigned long long rt() { return __builtin_amdgcn_s_memrealtime(); }
__device__ __forceinline__ unsigned f2bf(float f) { unsigned u = __builtin_bit_cast(unsigned, f); return (u + 0x7fffu + ((u >> 16) & 1u)) >> 16; }
__device__ __forceinline__ unsigned pk2(float lo, float hi) { return f2bf(lo) | (f2bf(hi) << 16); }

#define XB_TMO      128
#define XB_XCNT(j)  (256  + 64 * (j))
#define XB_XSUB(j)  (1280 + 64 * (j))
#define XB_XGEN(j)  (2304 + 64 * (j))
#define XB_TOP      3328
#define XB_TOPGEN   3392
#define XCD_BAR_WORDS 3456
#define XB_SPIN_CAP (1u << 18)

__device__ __forceinline__ unsigned xb_ld(unsigned* p)              { return __hip_atomic_load(p, __ATOMIC_RELAXED, __HIP_MEMORY_SCOPE_AGENT); }
__device__ __forceinline__ unsigned xb_add(unsigned* p, unsigned v) { return __hip_atomic_fetch_add(p, v, __ATOMIC_RELAXED, __HIP_MEMORY_SCOPE_AGENT); }
__device__ __forceinline__ unsigned xb_xcc_id() { return (unsigned)__builtin_amdgcn_s_getreg((3 << 11) | 20) & 0xFu; }
#define XB_SPIN(cond, bar) do { unsigned _sp = 0; while (cond) { __builtin_amdgcn_s_sleep(1); \
    if ((++_sp & 255u) == 0u) { if (xb_ld(&(bar)[XB_TMO])) break; if (_sp > XB_SPIN_CAP) { atomicAdd(&(bar)[XB_TMO], 1u); break; } } } } while (0)

struct XcdBarrier {
    unsigned* bar; unsigned x;
    volatile LAS unsigned* st;
};

__device__ __forceinline__ XcdBarrier xcd_barrier_post(unsigned* bar, volatile LAS unsigned* st) {
    XcdBarrier b; b.bar = bar; b.x = xb_xcc_id(); b.st = st;
    if (threadIdx.x == 0) (void)xb_add(&bar[XB_XCNT(b.x)], 1u);
    return b;
}
__device__ __forceinline__ void xcd_barrier_complete(unsigned* bar, unsigned x, unsigned& nloc, unsigned& nx) {
    const unsigned G = gridDim.x * gridDim.y * gridDim.z;
    unsigned sum, cnt, mine, sp = 0u;
    for (;;) {
        sum = 0u; cnt = 0u; mine = 0u;
#pragma unroll
        for (unsigned j = 0; j < 16; ++j) { const unsigned c = xb_ld(&bar[XB_XCNT(j)]); sum += c; cnt += (c > 0u) ? 1u : 0u; mine = (j == x) ? c : mine; }
        if (sum == G) break;
        __builtin_amdgcn_s_sleep(1);
        if ((++sp & 255u) == 0u) { if (xb_ld(&bar[XB_TMO])) break; if (sp > XB_SPIN_CAP) { atomicAdd(&bar[XB_TMO], 1u); break; } }
    }
    nloc = mine > 0u ? mine : 1u; nx = cnt > 0u ? cnt : 1u;
}

__device__ __forceinline__ void xcd_barrier(const XcdBarrier& b) {
    asm volatile("s_waitcnt vmcnt(0)" ::: "memory");
    __syncthreads();
    if (threadIdx.x == 0) {
        unsigned* bar = b.bar;
        __builtin_amdgcn_s_waitcnt(0);
        unsigned nloc = b.st[0], nx = b.st[1];
        if (nloc == 0u) { xcd_barrier_complete(bar, b.x, nloc, nx); b.st[0] = nloc; b.st[1] = nx; }
        const unsigned old = xb_add(&bar[XB_XSUB(b.x)], 1u);
        const unsigned gen = old / nloc;
        if (old + 1u == (gen + 1u) * nloc) {
            __builtin_amdgcn_fence(__ATOMIC_RELEASE, "agent");
            asm volatile("s_waitcnt vmcnt(0)" ::: "memory");
            const unsigned og = xb_add(&bar[XB_TOP], 1u);
            const unsigned tg = og / nx;
            if (og + 1u == (tg + 1u) * nx) xb_add(&bar[XB_TOPGEN], 1u);
            else XB_SPIN(xb_ld(&bar[XB_TOPGEN]) == tg, bar);
            __builtin_amdgcn_fence(__ATOMIC_ACQUIRE, "agent");
            xb_add(&bar[XB_XGEN(b.x)], 1u);
            asm volatile("s_waitcnt vmcnt(0)" ::: "memory");
        } else {
            XB_SPIN(xb_ld(&bar[XB_XGEN(b.x)]) == gen, bar);
            __builtin_amdgcn_fence(__ATOMIC_ACQUIRE, "agent");
            asm volatile("s_waitcnt vmcnt(0)" ::: "memory");
        }
    }
    __syncthreads();
}
typedef unsigned u32x4 __attribute__((ext_vector_type(4)));
constexpr int NWAVES = 8, NTHR = 512;
constexpr int BATCH = 2, SEQ = 8192, DM = 1024, M = BATCH * SEQ;
constexpr int EVEN_IN = 9232, ODD_IN = 6656;
constexpr float RMS_EPS = 1e-6f;
constexpr int NPHASE = 13;

constexpr size_t MiB = 1u << 20;
constexpr size_t WS_CTL = 0, CTL_ZERO_BYTES = 64 * 1024;
constexpr size_t WS_GATES = 1 * MiB;
constexpr size_t WS_PART = 2 * MiB;
constexpr size_t WS_RS0 = 3 * MiB;
constexpr size_t WS_ROPE = 3 * MiB + 64 * 1024;
constexpr size_t WS_NST = 3 * MiB + 128 * 1024;
constexpr size_t WS_CHSC = 3 * MiB + 640 * 1024;
constexpr size_t WS_W1T = 4 * MiB, WS_W2T = 22 * MiB, WS_U0 = 26 * MiB, WS_W3T = 26 * MiB;
constexpr size_t WS_A0 = 58 * MiB, WS_A1 = 90 * MiB, WS_A2 = 122 * MiB, WS_A3 = 154 * MiB, WS_MIX0 = 186 * MiB, WS_W4T = 250 * MiB;
constexpr size_t WS_H1B = WS_A0, WS_GQ = WS_A1, WS_GZ = WS_A2, WS_XC = WS_A3, WS_CG = 186 * MiB, WS_GK = 218 * MiB, WS_GV = 226 * MiB, WS_MIX1 = 4 * MiB;
constexpr size_t WS_END = 256 * MiB;
constexpr int CW_BAR = 4096;
constexpr int RING_BYTES = 131072, LDSCTL_OFF = 143360, MISC_OFF = LDSCTL_OFF + 320, LDS_BYTES = 147456;
static_assert(66560 + 128 * 528 <= LDSCTL_OFF, "LDS map");

typedef unsigned short bf16_t;
typedef short s16x4 __attribute__((ext_vector_type(4)));
typedef float f32x16 __attribute__((ext_vector_type(16)));
typedef unsigned u32x2 __attribute__((ext_vector_type(2)));
using pg8::cvt_pk_bf16; using pg8::fexp;

__device__ __forceinline__ float bf2f(unsigned short v) { return __uint_as_float((unsigned)v << 16); }
__device__ __forceinline__ bf16_t f2b(float x) { return (bf16_t)(cvt_pk_bf16(x, 0.f) & 0xffffu); }
__device__ __forceinline__ int crow(int r, int hi) { return (r & 3) + 8 * (r >> 2) + 4 * hi; }
__device__ __forceinline__ int v_st(int k, int c) { const int kk = (k & ~0xC) | ((k & 4) << 1) | ((k & 8) >> 1); return ((kk >> 3) * 4 + (c >> 5)) * 512 + ((kk & 7) * 32 + (c & 31)) * 2; }
__device__ __forceinline__ int v_rd_base(int lane) { return ((lane & 3) << 3) | (((lane >> 2) & 3) << 6) | (((lane >> 4) & 1) << 5) | (((lane >> 5) & 1) << 8); }
__device__ __forceinline__ int kswz512(int row, int colB) { return row * 528 + colB; }
__device__ __forceinline__ int kswz256(int row, int colB) { return row * 256 + (colB ^ ((row & 7) << 4)); }
typedef short v4i16_t __attribute__((ext_vector_type(4)));
__device__ __forceinline__ s16x4 vtr(LAS unsigned char* p) { return __builtin_bit_cast(s16x4, __builtin_amdgcn_ds_read_tr16_b64_v4i16((LAS v4i16_t*)p)); }
__device__ __forceinline__ bf16x8 tr_frag(LAS unsigned char* img_plus_rdbase, int d0, int ks) {
    LAS unsigned char* p = img_plus_rdbase + d0 * 512 + ks * 4096; const s16x4 lo = vtr(p), hi = vtr(p + 2048);
    return (bf16x8){lo[0], lo[1], lo[2], lo[3], hi[0], hi[1], hi[2], hi[3]};
}
__device__ __forceinline__ float swap_add(float v) { auto rr = __builtin_amdgcn_permlane32_swap(__float_as_uint(v), __float_as_uint(v), false, false); return __uint_as_float(rr[0]) + __uint_as_float(rr[1]); }
__device__ __forceinline__ float swap_max(float v) { auto rr = __builtin_amdgcn_permlane32_swap(__float_as_uint(v), __float_as_uint(v), false, false); return fmaxf(__uint_as_float(rr[0]), __uint_as_float(rr[1])); }
#define PK4(P, BASE, OUT) do { unsigned a0_ = cvt_pk_bf16(P[BASE + 0], P[BASE + 1]), a1_ = cvt_pk_bf16(P[BASE + 2], P[BASE + 3]);   \
    unsigned b0_ = cvt_pk_bf16(P[BASE + 4], P[BASE + 5]), b1_ = cvt_pk_bf16(P[BASE + 6], P[BASE + 7]);                              \
    auto r0_ = __builtin_amdgcn_permlane32_swap(a0_, b0_, false, false); auto r1_ = __builtin_amdgcn_permlane32_swap(a1_, b1_, false, false); \
    u32x4 w_ = {r0_[0], r1_[0], r0_[1], r1_[1]}; OUT = __builtin_bit_cast(bf16x8, w_); } while (0)

struct Args { const float* in[14]; float* out; unsigned char* ws; int ph_lo, ph_hi; };
#define LAUNDER_S(p) asm volatile("" : "+s"(p))
struct Frame {
    LAS unsigned char* lds; volatile LAS unsigned* MISC; gu32* ctl;
    int tid, lane, wave, vcu, G;
    GAS float* out; GAS unsigned char* ws;
};
#define WSP(T, off) ((GAS T*)(F.ws + (off)))
__device__ __forceinline__ const GAS float* inp(Frame& F, int k) {
    volatile LAS unsigned* t = (volatile LAS unsigned*)(F.lds + LDSCTL_OFF + 1024) + 2 * k;
    const unsigned lo = __builtin_amdgcn_readfirstlane(t[0]), hi = __builtin_amdgcn_readfirstlane(t[1]);
    return (const GAS float*)(((unsigned long long)hi << 32) | lo);
}
__device__ __forceinline__ bool phase_enter(Frame& F) { LAUNDER_S(F.ws); LAUNDER_S(F.out); asm volatile("" : "+v"(F.tid)); F.lane = F.tid & 63; F.wave = __builtin_amdgcn_readfirstlane(F.tid >> 6); return true; }

__device__ __forceinline__ int map_w1(int d) {
    const int tile = d >> 8, r = d & 255;
    if (tile < 12) return d;
    if (tile < 20) { const int t = tile - 12; return r < 128 ? 3072 + 128 * t + r : 4096 + 128 * t + (r - 128); }
    return 5136 + (d - 5120);
}
__device__ __forceinline__ int map_w3(int d) {
    const int tile = d >> 8, r = d & 255;
    if (tile < 10) return d;
    if (tile < 18) { const int t = tile - 10; return r < 128 ? 3584 + 128 * t + r : 4608 + 128 * t + (r - 128); }
    { const int t = tile - 18; return r < 128 ? 2560 + 128 * t + r : 5632 + 128 * t + (r - 128); }
}
__device__ __forceinline__ void transpose_item(const GAS float* W, int ldw, int K, GAS bf16_t* WT, int drow0, int scol0, const GAS float* gain, LAS float* scr, int kb, int lane) {
    const int k0 = 64 * kb;
#pragma unroll 8
    for (int i = 0; i < 32; ++i) { const int kk = 2 * i + (lane >> 5); const float gs = gain ? gain[k0 + kk] : 1.f; scr[kk * 33 + (lane & 31)] = W[(size_t)(k0 + kk) * ldw + scol0 + (lane & 31)] * gs; }
    LDS_WAIT(); asm volatile("" ::: "memory");
    const int c = lane & 7;
#pragma unroll
    for (int j = 0; j < 4; ++j) { const int n = (lane >> 3) + 8 * j; const LAS float* s = scr + (8 * c) * 33 + n;
        v4u o; o.x = cvt_pk_bf16(s[0 * 33], s[1 * 33]); o.y = cvt_pk_bf16(s[2 * 33], s[3 * 33]); o.z = cvt_pk_bf16(s[4 * 33], s[5 * 33]); o.w = cvt_pk_bf16(s[6 * 33], s[7 * 33]);
        *(GAS v4u*)(WT + (size_t)(drow0 + n) * K + k0 + 8 * c) = o; }
    LDS_WAIT(); asm volatile("" ::: "memory");
}
__device__ __forceinline__ float logsigmoidf_(float x) { return fminf(x, 0.f) - log1pf(expf(-fabsf(x))); }
__device__ __forceinline__ void p0_prologue(Frame& F, const Args& A_) {
    LAS float* scr = (LAS float*)(F.lds + F.wave * 16384);
    const int gw = F.vcu * NWAVES + F.wave, NGW = F.G * NWAVES;
    constexpr int I_W1 = 16 * 288, I_W2 = 32 * 32, I_W4 = 32 * 32;
    for (int it = gw; it < I_W1 + I_W2 + I_W4; it += NGW) {
        int r = it;
        if (r < I_W1) { const int kb = r / 288, d = 32 * (r % 288); transpose_item(inp(F, 3), EVEN_IN, 1024, WSP(bf16_t, WS_W1T), d, map_w1(d), nullptr, scr, kb, F.lane); continue; } r -= I_W1;
        if (r < I_W2) { const int kb = r / 32, d = 32 * (r % 32); transpose_item(inp(F, 5), 1024, 2048, WSP(bf16_t, WS_W2T), d, d, nullptr, scr, kb, F.lane); continue; } r -= I_W2;
        { const int kb = r / 32, d = 32 * (r % 32); transpose_item(inp(F, 9), 1024, 2048, WSP(bf16_t, WS_W4T), d, d, nullptr, scr, kb, F.lane); }
    }
    { const int gt = blockIdx.x * NTHR + F.tid;
      if (gt < 6144) { const int isc = gt >= 4096; const int e = isc ? gt - 4096 : gt; const int pos = e >> 5, i = e & 31;
          const float inv = powf(10000.f, -(float)i / 32.f); const float ang = (float)pos * inv;
          GAS float* tb = WSP(float, WS_ROPE) + (isc ? 8192 : 0); tb[e * 2] = cosf(ang); tb[e * 2 + 1] = sinf(ang); } }
    __syncthreads();
    LAS float* wg = (LAS float*)F.lds;
    { const GAS float* W = inp(F, 3); const GAS float* g0 = inp(F, 1);
      for (int idx = F.tid; idx < 16384; idx += NTHR) { const int k = idx >> 4, j = idx & 15; wg[k * 17 + j] = g0[k] * W[(size_t)k * EVEN_IN + 5120 + j]; } }
    __syncthreads();
    const GAS float* x = inp(F, 0); const GAS float* g0 = inp(F, 1); const GAS float* gb = inp(F, 4);
    GAS bf16_t* U0 = WSP(bf16_t, WS_U0); GAS float* rs0 = WSP(float, WS_RS0); GAS float* gates = WSP(float, WS_GATES);
    for (int task = F.wave * F.G + F.vcu; task < M / 16; task += NGW) {
        const int i = F.lane & 15, kk = F.lane >> 4; const int row = task * 16 + i;
        const GAS float* xr = x + (size_t)row * 1024 + 4 * kk; GAS bf16_t* ur = U0 + (size_t)row * 1024 + 4 * kk;
        f32x4 acc = {0.f, 0.f, 0.f, 0.f}; float ss = 0.f;
#pragma unroll 4
        for (int s = 0; s < 64; ++s) {
            const f32x4 xv = *(const GAS f32x4*)(xr + 16 * s); const f32x4 gv = *(const GAS f32x4*)(g0 + 16 * s + 4 * kk);
            ss += (xv[0] * xv[0] + xv[1] * xv[1]) + (xv[2] * xv[2] + xv[3] * xv[3]);
            u32x2 w; w.x = cvt_pk_bf16(xv[0] * gv[0], xv[1] * gv[1]); w.y = cvt_pk_bf16(xv[2] * gv[2], xv[3] * gv[3]); *(GAS u32x2*)(ur + 16 * s) = w;
#pragma unroll
            for (int e = 0; e < 4; ++e) { const float bv = wg[(16 * s + 4 * kk + e) * 17 + i]; acc = __builtin_amdgcn_mfma_f32_16x16x4f32(xv[e], bv, acc, 0, 0, 0); }
        }
        ss += __shfl_xor(ss, 16); ss += __shfl_xor(ss, 32);
        const float r = 1.0f / sqrtf(ss * (1.f / 1024.f) + RMS_EPS);
        if (kk == 0) rs0[row] = r;
        const int j = i, gi = j >> 2, hh = j & 3; const float bias = gb[j];
        f32x4 gv;
#pragma unroll
        for (int reg = 0; reg < 4; ++reg) { const float rr = __shfl(r, 4 * kk + reg); float g = acc[reg] * rr + bias; if (gi & 1) g = logsigmoidf_(g); gv[reg] = g; }
        const int row0 = task * 16 + 4 * kk; const int b = row0 >> 13, t = row0 & 8191;
        *(GAS f32x4*)(gates + ((size_t)((gi * 2 + b) * 4 + hh)) * 8192 + t) = gv;
    }
}

constexpr int L_TAB = 0, L_KIMG = 16384, L_VIMG = 50176, L_CIMG = 66560;
constexpr int T_IGF = 0, T_LFF = 256, T_IGB = 512, T_LFB = 768, T_BF = 1024, T_CB = 1280, T_X0 = 1536, T_X1 = 1792, T_X2 = 2048, T_X3 = 2304, T_AF2 = 3072, T_AB2 = 3328, T_NF = 3584, T_NB = 3840;
__device__ __forceinline__ void gate_tables(LAS float* T, const GAS float* gates, int b, int h, int c, int tid) {
    if (tid < 256) {
#pragma unroll
        for (int gi = 0; gi < 4; ++gi) T[gi * 256 + tid] = gates[((size_t)((gi * 2 + b) * 4 + h)) * 8192 + c * 256 + tid]; }
    __syncthreads();
    if (tid < 256) { float s = 0.f; for (int j = 0; j <= tid; ++j) s += T[T_LFF + j]; T[T_BF + tid] = s; }
    else { const int t = tid - 256; float s = 0.f; for (int j = 255; j >= t; --j) s += T[T_LFB + j]; T[T_CB + t] = s; }
    __syncthreads();
}
#define GLD8(base, boff) (*(const GAS bf16x8*)((const GAS char*)(base) + (size_t)(unsigned)(boff)))
#define GP16(base, boff) (*(GAS bf16_t*)((GAS char*)(base) + (size_t)(unsigned)(boff)))
#define GPC16(base, boff) (*(const GAS bf16_t*)((const GAS char*)(base) + (size_t)(unsigned)(boff)))
__device__ __forceinline__ void stage_k256(LAS unsigned char* L, const GAS bf16_t* src, int ld, unsigned kgo, unsigned klo) {
#pragma unroll
    for (int i = 0; i < 4; ++i) *(LAS bf16x8*)(L + L_KIMG + klo + i * (16 * 528)) = GLD8(src + (size_t)(16 * i) * ld, kgo);
}
__device__ __forceinline__ void x1_unit(Frame& F, const Args& A_, int unit) {
    const int bh = unit >> 5, c = unit & 31, b = bh >> 2, h = bh & 3;
    int tid = F.tid; asm volatile("" : "+v"(tid)); const int lane = tid & 63, wave = F.wave, r32 = lane & 31, hi = lane >> 5;
    LAS unsigned char* L = F.lds; LAS float* T = (LAS float*)(L + L_TAB);
    const size_t grow0 = (size_t)b * SEQ + c * 256;
    const GAS bf16_t* kb = WSP(bf16_t, WS_A1) + grow0 * 1024 + h * 256; const GAS bf16_t* vb = WSP(bf16_t, WS_A2) + grow0 * 1024 + h * 256;
    GAS bf16_t* states = (GAS bf16_t*)F.out; GAS float* nst = WSP(float, WS_NST); GAS float* chsc = WSP(float, WS_CHSC);
    LAUNDER_S(kb); LAUNDER_S(vb); LAUNDER_S(states); LAUNDER_S(nst);
    gate_tables(T, WSP(float, WS_GATES), b, h, c, tid);
    const float Gf = T[T_BF + 255], Gb = T[T_CB + 0];
    if (tid < 256) { T[T_X0 + tid] = Gf - T[T_BF + tid] + T[T_IGF + tid]; T[T_X1 + tid] = Gb - T[T_CB + tid] + T[T_IGB + tid]; }
    __syncthreads();
    float mlf = -1e30f, mlb = -1e30f;
    for (int j = 0; j < 256; ++j) { mlf = fmaxf(mlf, T[T_X0 + j]); mlb = fmaxf(mlb, T[T_X1 + j]); }
    __syncthreads();
    if (tid < 256) { T[T_X2 + tid] = expf(T[T_X0 + tid] - mlf); T[T_X3 + tid] = expf(T[T_X1 + tid] - mlb); }
    if (tid == 0) { GAS float* p = chsc + (size_t)((0 * 8 + bh) * 32 + c) * 4; p[0] = Gf; p[1] = mlf; GAS float* q = chsc + (size_t)((1 * 8 + bh) * 32 + c) * 4; q[0] = Gb; q[1] = mlb; }
    __syncthreads();
    const int sr = tid >> 4, sc8 = (tid & 15) * 8;
    const unsigned go = (unsigned)(sr * 1024 + sc8) * 2u; const unsigned lo0 = (unsigned)v_st(sr, sc8), lo1 = (unsigned)v_st(32 + sr, sc8);
    LAS unsigned char* rdk = L + L_KIMG + v_rd_base(lane); LAS unsigned char* rdv = L + L_VIMG + (wave >> 2) * 16384 + (wave & 3) * 512 + v_rd_base(lane);
#pragma unroll 1
    for (int dir = 0; dir < 2; ++dir) {
        f32x16 acc[8];
#pragma unroll
        for (int j = 0; j < 8; ++j) acc[j] = f32x16{};
        float dn = 0.f; const int wofs = dir ? T_X3 : T_X2;
#pragma unroll 1
        for (int t4 = 0; t4 < 4; ++t4) {
            const GAS bf16_t* kt = kb + (size_t)(t4 * 64) * 1024; const GAS bf16_t* vt = vb + (size_t)(t4 * 64) * 1024;
#pragma unroll
            for (int half = 0; half < 2; ++half)
#pragma unroll
                for (int q = 0; q < 2; ++q) {
                    const bf16x8 kv = GLD8(kt + (size_t)(32 * q) * 1024 + half * 128, go);
                    const bf16x8 vv = GLD8(vt + (size_t)(32 * q) * 1024 + half * 128, go);
                    const float w = T[wofs + t4 * 64 + sr + 32 * q];
                    u32x4 pv; pv.x = cvt_pk_bf16(bf2f(vv[0]) * w, bf2f(vv[1]) * w); pv.y = cvt_pk_bf16(bf2f(vv[2]) * w, bf2f(vv[3]) * w); pv.z = cvt_pk_bf16(bf2f(vv[4]) * w, bf2f(vv[5]) * w); pv.w = cvt_pk_bf16(bf2f(vv[6]) * w, bf2f(vv[7]) * w);
                    *(LAS bf16x8*)(L + L_KIMG + half * 16384 + (q ? lo1 : lo0)) = kv;
                    *(LAS u32x4*)(L + L_VIMG + half * 16384 + (q ? lo1 : lo0)) = pv; }
            __syncthreads();
#pragma unroll
            for (int ks = 0; ks < 4; ++ks) { const bf16x8 Af = tr_frag(rdv, 0, ks);
#pragma unroll
                for (int j = 0; j < 8; ++j) { const bf16x8 Bf = tr_frag(rdk + (j >> 2) * 16384, j & 3, ks); acc[j] = __builtin_amdgcn_mfma_f32_32x32x16_bf16(Af, Bf, acc[j], 0, 0, 0); } }
            if (tid < 256) { const int k = tid; LAS unsigned char* kp = L + L_KIMG + (k >> 7) * 16384 + (((k & 127) >> 5) * 512 + (k & 31) * 2);
#pragma unroll 8
                for (int key = 0; key < 64; ++key) { const int kk = (key & ~0xC) | ((key & 4) << 1) | ((key & 8) >> 1);
                    dn += T[wofs + t4 * 64 + key] * bf2f(*(LAS bf16_t*)(kp + (kk >> 3) * 2048 + (kk & 7) * 64)); } }
            __syncthreads();
        }
        GAS bf16_t* dst = states + (size_t)((dir * 8 + bh) * 32 + c) * 65536 + (size_t)(32 * wave) * 256;
        const unsigned so = (unsigned)(4 * hi * 256 + r32) * 2u;
#pragma unroll
        for (int r = 0; r < 16; ++r) {
#pragma unroll
            for (int j = 0; j < 8; ++j) GP16(dst, so + ((r & 3) + 8 * (r >> 2)) * 512 + 64 * j) = f2b(acc[j][r]);
            if ((r & 3) == 3) asm volatile("" ::: "memory"); }
        if (tid < 256) nst[(size_t)((dir * 8 + bh) * 32 + c) * 256 + tid] = dn;
    }
    __syncthreads();
}
__device__ __forceinline__ void x2_scan(Frame& F) {
    const int bid = F.vcu, tid = F.tid; LAS float* T = (LAS float*)(F.lds);
    GAS bf16_t* states = (GAS bf16_t*)F.out; GAS float* nst = WSP(float, WS_NST); GAS float* chsc = WSP(float, WS_CHSC);
#pragma unroll 1
    for (int blk = bid; blk < 256; blk += F.G) {
        const int chain = blk >> 4, dir = chain >> 3; const bool first = (blk & 15) == 0;
        if (tid == 0) { float m = -1e30f;
            for (int i = 0; i < 32; ++i) { const int c = dir ? 31 - i : i; GAS float* p = chsc + (size_t)(chain * 32 + c) * 4; const float G = p[0], ml = p[1];
                if (first) p[2] = m; const float mo = fmaxf(G + m, ml); T[i] = expf(G + m - mo); T[32 + i] = expf(ml - mo); m = mo; } }
        __syncthreads();
        const unsigned e8 = (unsigned)((blk & 15) * 512 + tid) * 16u;
        float st[8];
#pragma unroll
        for (int j = 0; j < 8; ++j) st[j] = 0.f;
        GAS bf16_t* cb = states + (size_t)(chain * 32) * 65536;
#pragma unroll 4
        for (int i = 0; i < 32; ++i) { const int c = dir ? 31 - i : i; GAS bf16_t* p = (GAS bf16_t*)((GAS char*)(cb + (size_t)c * 65536) + (size_t)e8);
            const bf16x8 d = *(const GAS bf16x8*)p; const float so = T[i], sw = T[32 + i];
            u32x4 w; w.x = cvt_pk_bf16(st[0], st[1]); w.y = cvt_pk_bf16(st[2], st[3]); w.z = cvt_pk_bf16(st[4], st[5]); w.w = cvt_pk_bf16(st[6], st[7]); *(GAS u32x4*)p = w;
#pragma unroll
            for (int j = 0; j < 8; ++j) st[j] = so * st[j] + sw * bf2f(d[j]); }
        if (first && tid < 256) { float sn = 0.f;
            for (int i = 0; i < 32; ++i) { const int c = dir ? 31 - i : i; GAS float* p = nst + (size_t)(chain * 32 + c) * 256 + tid; const float d = *p; *p = sn; sn = T[i] * sn + T[32 + i] * d; } }
        __syncthreads();
    }
}
template <int NK> __device__ __forceinline__ void st_tile(f32x16& p0, f32x16& p1, LAS unsigned char* kp, const bf16x8* qr) {
    p0 = f32x16{}; p1 = f32x16{};
#pragma unroll
    for (int d0 = 0; d0 < NK; ++d0) { const bf16x8 b0 = *(const LAS bf16x8*)(kp + 32 * d0), b1 = *(const LAS bf16x8*)(kp + 32 * 528 + 32 * d0);
        p0 = __builtin_amdgcn_mfma_f32_32x32x16_bf16(b0, qr[d0], p0, 0, 0, 0); p1 = __builtin_amdgcn_mfma_f32_32x32x16_bf16(b1, qr[d0], p1, 0, 0, 0); }
}
__device__ __forceinline__ void x3_unit(Frame& F, const Args& A_, int unit) {
    const int bh = unit >> 5, c = unit & 31, b = bh >> 2, h = bh & 3;
    int tid = F.tid; asm volatile("" : "+v"(tid)); const int lane = tid & 63, wave = F.wave, r32 = lane & 31, hi = lane >> 5;
    LAS unsigned char* L = F.lds; LAS float* T = (LAS float*)(L + L_TAB);
    const size_t grow0 = (size_t)b * SEQ + c * 256;
    const GAS bf16_t* qb = WSP(bf16_t, WS_A0) + grow0 * 1024 + h * 256; const GAS bf16_t* kb = WSP(bf16_t, WS_A1) + grow0 * 1024 + h * 256;
    const GAS bf16_t* vb = WSP(bf16_t, WS_A2) + grow0 * 1024 + h * 256; const GAS bf16_t* gb = WSP(bf16_t, WS_A3) + (grow0 + 32 * wave) * 1024 + h * 256;
    const GAS bf16_t* states = (const GAS bf16_t*)F.out; const GAS float* nst = WSP(float, WS_NST); const GAS float* chsc = WSP(float, WS_CHSC);
    GAS bf16_t* mb0 = WSP(bf16_t, WS_MIX0) + (grow0 + 32 * wave) * 2048 + h * 256;
    const GAS float* ng = inp(F, 6) + h * 256;
    LAUNDER_S(qb); LAUNDER_S(kb); LAUNDER_S(vb); LAUNDER_S(gb); LAUNDER_S(mb0); LAUNDER_S(states);
    gate_tables(T, WSP(float, WS_GATES), b, h, c, tid);
    if (tid < 256) { T[T_X0 + tid] = T[T_IGF + tid] - T[T_BF + tid]; T[T_NF + tid] = nst[(size_t)((0 * 8 + bh) * 32 + c) * 256 + tid]; }
    else { const int t = tid - 256; T[T_X1 + t] = T[T_IGB + t] - T[T_CB + t]; T[T_NB + t] = nst[(size_t)((1 * 8 + bh) * 32 + c) * 256 + t]; }
    const float mf = chsc[(size_t)((0 * 8 + bh) * 32 + c) * 4 + 2], mb = chsc[(size_t)((1 * 8 + bh) * 32 + c) * 4 + 2];
    __syncthreads();
    if (tid < 256) { float m = mf; for (int j = 0; j <= tid; ++j) m = fmaxf(m, T[T_X0 + j]); T[T_X2 + tid] = m; }
    else { const int t = tid - 256; float m = mb; for (int j = 255; j >= t; --j) m = fmaxf(m, T[T_X1 + j]); T[T_X3 + t] = m; }
    __syncthreads();
    const int tq = 32 * wave + r32;
    bf16x8 qr[16];
    { const unsigned qo = (unsigned)(tq * 1024 + 8 * hi) * 2u;
#pragma unroll
      for (int d0 = 0; d0 < 16; ++d0) qr[d0] = GLD8(qb + 16 * d0, qo); }
    const float Rf = T[T_X2 + tq], Rb = T[T_X3 + tq];
    float denf = 0.f, denb = 0.f;
#pragma unroll 1
    for (int j = 0; j < 4; ++j) {
        int t_ = tid; asm volatile("" : "+v"(t_));
        const unsigned kgo = (unsigned)((t_ >> 5) * 1024 + (t_ & 31) * 8) * 2u, klo = (unsigned)((t_ >> 5) * 528 + (t_ & 31) * 16);
        LAS unsigned char* kp = L + L_KIMG + (t_ & 31) * 528 + 16 * ((t_ >> 5) & 1);
        stage_k256(L, kb + (size_t)(64 * j) * 1024, 1024, kgo, klo);
        __syncthreads();
        f32x16 p0, p1; st_tile<16>(p0, p1, kp, qr);
        LAS float* tf = T + T_X0 + 64 * j + 4 * hi; LAS float* tb = T + T_X1 + 64 * j + 4 * hi; const int sb0 = 64 * j + 4 * hi;
#pragma unroll
        for (int r = 0; r < 16; ++r) { const int cr = (r & 3) + 8 * (r >> 2);
            const float uf0 = tf[cr], uf1 = tf[cr + 32], ub0 = tb[cr], ub1 = tb[cr + 32];
            const float ef0 = fexp(uf0 - Rf), ef1 = fexp(uf1 - Rf), eb0 = fexp(ub0 - Rb), eb1 = fexp(ub1 - Rb);
            const int s0 = sb0 + cr, s1 = s0 + 32;
            denf += ((s0 <= tq) ? ef0 : 0.f) * p0[r] + ((s1 <= tq) ? ef1 : 0.f) * p1[r];
            denb += ((s0 >= tq) ? eb0 : 0.f) * p0[r] + ((s1 >= tq) ? eb1 : 0.f) * p1[r];
            if ((r & 3) == 3) asm volatile("" ::: "memory"); }
        __syncthreads();
    }
    denf = swap_add(denf); denb = swap_add(denb);
    float nqf = 0.f, nqb = 0.f;
#pragma unroll
    for (int d0 = 0; d0 < 16; ++d0) {
#pragma unroll
        for (int jj = 0; jj < 8; ++jj) { const float qv = bf2f(qr[d0][jj]); nqf += qv * T[T_NF + 16 * d0 + 8 * hi + jj]; nqb += qv * T[T_NB + 16 * d0 + 8 * hi + jj]; }
        asm volatile("" ::: "memory"); }
    nqf = swap_add(nqf); nqb = swap_add(nqb);
    float sf, sb;
    { const float ef = fexp(mf - Rf), eb = fexp(mb - Rb);
      const float dtf = ef * nqf + denf, dtb = eb * nqb + denb;
      sf = 1.f / fmaxf(fabsf(dtf), expf(-T[T_BF + tq] - Rf)); sb = 1.f / fmaxf(fabsf(dtb), expf(-T[T_CB + tq] - Rb));
      if (hi == 0) { T[T_AF2 + tq] = ef * sf; T[T_AB2 + tq] = eb * sb; } }
    __syncthreads();
#pragma unroll 1
    for (int dvh = 0; dvh < 2; ++dvh) {
        int t_ = tid; asm volatile("" : "+v"(t_));
        const unsigned kgo = (unsigned)((t_ >> 5) * 1024 + (t_ & 31) * 8) * 2u, klo = (unsigned)((t_ >> 5) * 528 + (t_ & 31) * 16);
        LAS unsigned char* kp = L + L_KIMG + (t_ & 31) * 528 + 16 * ((t_ >> 5) & 1);
        LAS unsigned char* rdv = L + L_VIMG + v_rd_base(t_ & 63);
        LAS unsigned char* cp = L + L_CIMG + (t_ & 31) * 528 + 16 * ((t_ >> 5) & 1);
        const unsigned vgo = (unsigned)((t_ >> 4) * 1024 + (t_ & 15) * 8) * 2u, vlo0 = (unsigned)v_st(t_ >> 4, (t_ & 15) * 8), vlo1 = (unsigned)v_st(32 + (t_ >> 4), (t_ & 15) * 8);
        const unsigned cgo = (unsigned)((t_ >> 5) * 256 + (t_ & 31) * 8) * 2u;
        f32x16 o[4];
#pragma unroll
        for (int d = 0; d < 4; ++d) o[d] = f32x16{};
#pragma unroll 1
        for (int dir = 0; dir < 2; ++dir) {
            const GAS bf16_t* cs = states + (size_t)((dir * 8 + bh) * 32 + c) * 65536 + (size_t)(128 * dvh) * 256;
#pragma unroll
            for (int i = 0; i < 8; ++i) *(LAS bf16x8*)(L + L_CIMG + klo + i * (16 * 528)) = GLD8(cs + (size_t)(16 * i) * 256, cgo);
            __syncthreads();
            LAS float* ta = T + (dir ? T_AB2 : T_AF2) + 32 * wave + 4 * hi;
#pragma unroll
            for (int d = 0; d < 4; ++d) { f32x16 tmp = f32x16{};
#pragma unroll
                for (int d0 = 0; d0 < 16; ++d0) { const bf16x8 Bf = *(const LAS bf16x8*)(cp + d * (32 * 528) + 32 * d0); tmp = __builtin_amdgcn_mfma_f32_32x32x16_bf16(qr[d0], Bf, tmp, 0, 0, 0); }
#pragma unroll
                for (int r = 0; r < 16; ++r) o[d][r] += tmp[r] * ta[(r & 3) + 8 * (r >> 2)]; }
            __syncthreads();
        }
#pragma unroll 1
        for (int j = 0; j < 4; ++j) {
            stage_k256(L, kb + (size_t)(64 * j) * 1024, 1024, kgo, klo);
            { const GAS bf16_t* vt = vb + (size_t)(64 * j) * 1024 + 128 * dvh;
              *(LAS bf16x8*)(L + L_VIMG + vlo0) = GLD8(vt, vgo); *(LAS bf16x8*)(L + L_VIMG + vlo1) = GLD8(vt + (size_t)32 * 1024, vgo); }
            __syncthreads();
            f32x16 p0, p1; st_tile<16>(p0, p1, kp, qr);
            LAS float* tf = T + T_X0 + 64 * j + 4 * hi; LAS float* tb = T + T_X1 + 64 * j + 4 * hi; const int sb0 = 64 * j + 4 * hi;
#pragma unroll
            for (int r = 0; r < 16; ++r) { const int cr = (r & 3) + 8 * (r >> 2);
                const float uf0 = tf[cr], uf1 = tf[cr + 32], ub0 = tb[cr], ub1 = tb[cr + 32];
                const float ef0 = fexp(uf0 - Rf) * sf, ef1 = fexp(uf1 - Rf) * sf, eb0 = fexp(ub0 - Rb) * sb, eb1 = fexp(ub1 - Rb) * sb;
                const int s0 = sb0 + cr, s1 = s0 + 32;
                p0[r] *= ((s0 <= tq) ? ef0 : 0.f) + ((s0 >= tq) ? eb0 : 0.f);
                p1[r] *= ((s1 <= tq) ? ef1 : 0.f) + ((s1 >= tq) ? eb1 : 0.f);
                if ((r & 3) == 3) asm volatile("" ::: "memory"); }
            bf16x8 pa0, pa1, pa2, pa3;
            PK4(p0, 0, pa0); PK4(p0, 8, pa1); PK4(p1, 0, pa2); PK4(p1, 8, pa3);
#pragma unroll
            for (int d = 0; d < 4; ++d) {
                o[d] = __builtin_amdgcn_mfma_f32_32x32x16_bf16(pa0, tr_frag(rdv, d, 0), o[d], 0, 0, 0);
                o[d] = __builtin_amdgcn_mfma_f32_32x32x16_bf16(pa1, tr_frag(rdv, d, 1), o[d], 0, 0, 0);
                o[d] = __builtin_amdgcn_mfma_f32_32x32x16_bf16(pa2, tr_frag(rdv, d, 2), o[d], 0, 0, 0);
                o[d] = __builtin_amdgcn_mfma_f32_32x32x16_bf16(pa3, tr_frag(rdv, d, 3), o[d], 0, 0, 0); }
            __syncthreads();
        }
        int l_ = lane; asm volatile("" : "+v"(l_));
        const unsigned oo = (unsigned)(4 * (l_ >> 5) * 2048 + (l_ & 31)) * 2u, go_ = (unsigned)(4 * (l_ >> 5) * 1024 + (l_ & 31)) * 2u;
        if (dvh == 0) {
#pragma unroll
            for (int r = 0; r < 16; ++r) { unsigned ro = oo + ((r & 3) + 8 * (r >> 2)) * 4096; asm volatile("" : "+v"(ro));
#pragma unroll
                for (int d = 0; d < 4; ++d) GP16(mb0, ro + 64 * d) = f2b(o[d][r]);
                if ((r & 3) == 3) asm volatile("" ::: "memory"); }
        } else {
            asm volatile("s_waitcnt vmcnt(0)" ::: "memory");
#pragma unroll
            for (int r = 0; r < 16; ++r) { unsigned ro = oo + ((r & 3) + 8 * (r >> 2)) * 4096, rg = go_ + ((r & 3) + 8 * (r >> 2)) * 2048; asm volatile("" : "+v"(ro), "+v"(rg));
                float h0[4]; float s = (o[0][r] * o[0][r] + o[1][r] * o[1][r]) + (o[2][r] * o[2][r] + o[3][r] * o[3][r]);
#pragma unroll
                for (int d = 0; d < 4; ++d) { h0[d] = bf2f(GP16(mb0, ro + 64 * d)); s += h0[d] * h0[d]; }
                s += __shfl_xor(s, 1); s += __shfl_xor(s, 2); s += __shfl_xor(s, 4); s += __shfl_xor(s, 8); s += __shfl_xor(s, 16);
                const float rinv = 1.0f / sqrtf(s * (1.f / 256.f) + RMS_EPS);
#pragma unroll
                for (int d = 0; d < 4; ++d) {
                    GP16(mb0, ro + 256 + 64 * d) = f2b(o[d][r] * rinv * ng[128 + 32 * d + r32] * bf2f(GPC16(gb, rg + 256 + 64 * d)));
                    GP16(mb0, ro + 64 * d) = f2b(h0[d] * rinv * ng[32 * d + r32] * bf2f(GPC16(gb, rg + 64 * d))); }
                asm volatile("" ::: "memory"); }
        }
    }
    __syncthreads();
}

constexpr int L_RPB = 83968;
__device__ __forceinline__ void na_phase(Frame& F, const Args& A_) {
    const int cu = F.vcu; if (cu >= 256) return;
    const int b = cu >> 7, r = cu & 127;
    int tid = F.tid; asm volatile("" : "+v"(tid)); const int lane = tid & 63, wave = F.wave, r32 = lane & 31, hi = lane >> 5;
    LAS unsigned char* L = F.lds; LAS float* RP = (LAS float*)(L + L_RPB); LAS float* wsf = (LAS float*)(L + 8192) + wave * 64;
    { const GAS float* rpb = inp(F, 7); for (int idx = tid; idx < 7440; idx += NTHR) RP[idx] = rpb[idx]; }
    const int hd = wave >> 1, qb = wave & 1, cq = 32 * qb + r32;
    const int c0 = min(max(cq - 8, 0), 48), r0 = min(max(r - 4, 0), 120);
    const size_t rowq = (size_t)b * SEQ + r * 64;
    const GAS bf16_t* qbp = WSP(bf16_t, WS_A0) + (rowq + 32 * qb) * 1024 + hd * 64;
    const GAS bf16_t* zbp = WSP(bf16_t, WS_A3) + (rowq + 32 * qb) * 1024 + hd * 64;
    GAS bf16_t* obp = WSP(bf16_t, WS_MIX0) + (rowq + 32 * qb) * 2048 + 1024 + hd * 64;
    const GAS bf16_t* kbp = WSP(bf16_t, WS_A1) + ((size_t)b * SEQ + (size_t)r0 * 64) * 1024;
    const GAS bf16_t* vbp = WSP(bf16_t, WS_A2) + ((size_t)b * SEQ + (size_t)r0 * 64) * 1024;
    LAUNDER_S(qbp); LAUNDER_S(zbp); LAUNDER_S(obp); LAUNDER_S(kbp); LAUNDER_S(vbp);
    LAS unsigned char* rdv = L + L_VIMG + (hd >> 1) * 16384 + (2 * (hd & 1)) * 512 + v_rd_base(lane);
    LAS unsigned char* kp = L + L_KIMG + r32 * 528 + 128 * hd + 16 * hi;
    const unsigned kgo = (unsigned)((tid >> 5) * 1024 + (tid & 31) * 8) * 2u, klo = (unsigned)((tid >> 5) * 528 + (tid & 31) * 16);
    unsigned vlo[4];
#pragma unroll
    for (int q = 0; q < 4; ++q) { const int key = (tid >> 5) + 16 * q, col8 = (tid & 31) * 8; vlo[q] = (unsigned)((col8 >> 7) * 16384 + v_st(key, col8 & 127)); }
    bf16x8 kst[4], vst[4];
#define NA_FETCH(s_) do { const int hg_ = (s_) >> 3, t_ = (s_) & 7; const GAS bf16_t* kt_ = kbp + (size_t)(64 * t_) * 1024 + 256 * hg_; const GAS bf16_t* vt_ = vbp + (size_t)(64 * t_) * 1024 + 256 * hg_; \
        _Pragma("unroll") for (int q = 0; q < 4; ++q) { kst[q] = GLD8(kt_ + (size_t)(16 * q) * 1024, kgo); vst[q] = GLD8(vt_ + (size_t)(16 * q) * 1024, kgo); } } while (0)
#define NA_WRITE() do { _Pragma("unroll") for (int q = 0; q < 4; ++q) { *(LAS bf16x8*)(L + L_KIMG + klo + q * (16 * 528)) = kst[q]; *(LAS bf16x8*)(L + L_VIMG + vlo[q]) = vst[q]; } } while (0)
    NA_FETCH(0);
    __syncthreads();
    NA_WRITE();
    __syncthreads();
    bf16x8 qr[4]; float m = -1e30f, l = 0.f; f32x16 o[2]; o[0] = f32x16{}; o[1] = f32x16{};
#pragma unroll 1
    for (int s = 0; s < 32; ++s) {
        const int hg = s >> 3, i = s & 7;
        if (i == 0) { const unsigned qo = (unsigned)(r32 * 1024 + 8 * hi) * 2u;
#pragma unroll
            for (int d0 = 0; d0 < 4; ++d0) qr[d0] = GLD8(qbp + 256 * hg + 16 * d0, qo);
            m = -1e30f; l = 0.f; o[0] = f32x16{}; o[1] = f32x16{}; }
        if (s + 1 < 32) NA_FETCH(s + 1);
        f32x16 p0, p1; st_tile<4>(p0, p1, kp, qr);
        const int dr = r0 + i - r + 7; const LAS float* brow = RP + (4 * hg + hd) * 465 + dr * 31 + (15 - cq);
        float pmax = -1e30f;
#pragma unroll
        for (int rr = 0; rr < 16; ++rr) { const int ck0 = crow(rr, hi), ck1 = ck0 + 32;
            const bool v0 = (unsigned)(ck0 - c0) < 16u, v1 = (unsigned)(ck1 - c0) < 16u;
            const float b0 = brow[min(max(ck0, cq - 15), cq + 15)], b1 = brow[min(max(ck1, cq - 15), cq + 15)];
            p0[rr] = v0 ? p0[rr] + b0 : -1e30f; p1[rr] = v1 ? p1[rr] + b1 : -1e30f; pmax = fmaxf(pmax, fmaxf(p0[rr], p1[rr])); }
        pmax = swap_max(pmax);
        const float mn = fmaxf(m, pmax), alpha = fexp(m - mn); m = mn;
        float ps = 0.f;
#pragma unroll
        for (int rr = 0; rr < 16; ++rr) { const float e0 = fexp(p0[rr] - mn), e1 = fexp(p1[rr] - mn); p0[rr] = (p0[rr] > -1e29f) ? e0 : 0.f; p1[rr] = (p1[rr] > -1e29f) ? e1 : 0.f; ps += p0[rr] + p1[rr]; }
        ps = swap_add(ps); l = l * alpha + ps;
        if (hi == 0) wsf[r32] = alpha;
#pragma unroll
        for (int d = 0; d < 2; ++d)
#pragma unroll
            for (int rr = 0; rr < 16; ++rr) o[d][rr] *= wsf[crow(rr, hi)];
        bf16x8 pa0, pa1, pa2, pa3;
        PK4(p0, 0, pa0); PK4(p0, 8, pa1); PK4(p1, 0, pa2); PK4(p1, 8, pa3);
#pragma unroll
        for (int d = 0; d < 2; ++d) {
            o[d] = __builtin_amdgcn_mfma_f32_32x32x16_bf16(pa0, tr_frag(rdv, d, 0), o[d], 0, 0, 0);
            o[d] = __builtin_amdgcn_mfma_f32_32x32x16_bf16(pa1, tr_frag(rdv, d, 1), o[d], 0, 0, 0);
            o[d] = __builtin_amdgcn_mfma_f32_32x32x16_bf16(pa2, tr_frag(rdv, d, 2), o[d], 0, 0, 0);
            o[d] = __builtin_amdgcn_mfma_f32_32x32x16_bf16(pa3, tr_frag(rdv, d, 3), o[d], 0, 0, 0); }
        if (i == 7) {
            if (hi == 0) wsf[32 + r32] = l;
            const unsigned zo = (unsigned)(4 * hi * 1024 + r32) * 2u + 512u * hg, oo = (unsigned)(4 * hi * 2048 + r32) * 2u + 512u * hg;
#pragma unroll
            for (int rr = 0; rr < 16; ++rr) { const float rli = 1.f / wsf[32 + crow(rr, hi)]; const int cr = (rr & 3) + 8 * (rr >> 2);
#pragma unroll
                for (int d = 0; d < 2; ++d) GP16(obp, oo + cr * 4096 + 64 * d) = f2b(o[d][rr] * rli * bf2f(GPC16(zbp, zo + cr * 2048 + 64 * d)));
                if ((rr & 3) == 3) asm volatile("" ::: "memory"); }
        }
        __syncthreads();
        if (s + 1 < 32) NA_WRITE();
        __syncthreads();
    }
#undef NA_FETCH
#undef NA_WRITE
}

__device__ __forceinline__ void p9_krope_conv(Frame& F, const Args& A_) {
    const int gw = F.vcu * NWAVES + F.wave, NGW = F.G * NWAVES, lane = F.lane;
    GAS bf16_t* gk = WSP(bf16_t, WS_GK); const GAS float* kng = inp(F, 11); const GAS float* ropeR = WSP(float, WS_ROPE); const GAS float* ropeC = ropeR + 8192;
    for (int row = gw; row < M; row += NGW) {
        const int hd = lane >> 5, i = lane & 31; GAS bf16_t* p = gk + (size_t)row * 256 + hd * 128 + i;
        float x[4]; float ss = 0.f;
#pragma unroll
        for (int e = 0; e < 4; ++e) { x[e] = bf2f(p[32 * e]); ss += x[e] * x[e]; }
        ss += __shfl_xor(ss, 1); ss += __shfl_xor(ss, 2); ss += __shfl_xor(ss, 4); ss += __shfl_xor(ss, 8); ss += __shfl_xor(ss, 16);
        const float rr = 1.0f / sqrtf(ss * (1.f / 128.f) + RMS_EPS);
#pragma unroll
        for (int e = 0; e < 4; ++e) x[e] = x[e] * rr * kng[32 * e + i];
        const int t = row & 8191, pr = t >> 6, pc = t & 63;
        const float cr = ropeR[(pr * 32 + i) * 2], sr = ropeR[(pr * 32 + i) * 2 + 1], cc = ropeC[(pc * 32 + i) * 2], sc = ropeC[(pc * 32 + i) * 2 + 1];
        p[0] = f2b(x[0] * cr - x[1] * sr); p[32] = f2b(x[0] * sr + x[1] * cr); p[64] = f2b(x[2] * cc - x[3] * sc); p[96] = f2b(x[2] * sc + x[3] * cc);
    }
    const GAS bf16_t* xc = WSP(bf16_t, WS_XC); const GAS bf16_t* cg = WSP(bf16_t, WS_CG); GAS bf16_t* mix1 = WSP(bf16_t, WS_MIX1); const GAS float* cw = inp(F, 12); const GAS float* cbv = inp(F, 13);
    const int gt = F.vcu * NTHR + F.tid, NGT = F.G * NTHR;
    for (int it = gt; it < M * 128; it += NGT) {
        const int row = it >> 7, c8 = (it & 127) * 8, t = row & 8191;
        const bf16x8 z8 = {0, 0, 0, 0, 0, 0, 0, 0};
        const bf16x8 x0 = *(const GAS bf16x8*)(xc + (size_t)row * 1024 + c8);
        const bf16x8 xm = t > 0 ? *(const GAS bf16x8*)(xc + (size_t)(row - 1) * 1024 + c8) : z8;
        const bf16x8 xp = t < SEQ - 1 ? *(const GAS bf16x8*)(xc + (size_t)(row + 1) * 1024 + c8) : z8;
        const bf16x8 g8 = *(const GAS bf16x8*)(cg + (size_t)row * 1024 + c8);
        float y[8];
#pragma unroll
        for (int j = 0; j < 8; ++j) y[j] = bf2f(g8[j]) * (bf2f(xm[j]) * cw[c8 + j] + bf2f(x0[j]) * cw[1024 + c8 + j] + bf2f(xp[j]) * cw[2048 + c8 + j] + cbv[c8 + j]);
        u32x4 w; w.x = cvt_pk_bf16(y[0], y[1]); w.y = cvt_pk_bf16(y[2], y[3]); w.z = cvt_pk_bf16(y[4], y[5]); w.w = cvt_pk_bf16(y[6], y[7]);
        *(GAS u32x4*)(mix1 + (size_t)row * 2048 + 1024 + c8) = w;
    }
}

namespace gqa {
constexpr int D = 128, NW = 8, QBLK = 32, KVBLK = 64, LDQ = 1024, LDK = 256;
constexpr float SCALE = 0.088388347648318440f;
constexpr float THR = 8.f;
constexpr size_t SHM_V = KVBLK * D * 2, SHM_K = KVBLK * D * 2;
#define KSWZ(row, colB) ((row) * 256 + ((colB) ^ (((row) & 7) << 4)))
#define SBAR() __builtin_amdgcn_sched_barrier(0)
__device__ __forceinline__ unsigned cvtpk(float lo, float hi) { unsigned r; asm volatile("v_cvt_pk_bf16_f32 %0, %1, %2" : "=v"(r) : "v"(lo), "v"(hi)); return r; }
__device__ __forceinline__ void partialSM(f32x16& p0, f32x16& p1, float& m_reg, float& mn, float& alpha) {
  constexpr float C = SCALE * 1.4426950408889634f;
  float pmax = p0[0]; for (int r = 1; r < 16; ++r) pmax = fmaxf(pmax, p0[r]); for (int r = 0; r < 16; ++r) pmax = fmaxf(pmax, p1[r]);
  { auto rr = __builtin_amdgcn_permlane32_swap(__float_as_uint(pmax), __float_as_uint(pmax), false, false);
    pmax = fmaxf(__uint_as_float(rr[0]), __uint_as_float(rr[1])); }
  if (__builtin_expect(__all(pmax - m_reg <= THR / SCALE), 1)) { mn = m_reg; alpha = 1.f; }
  else { mn = fmaxf(m_reg, pmax); alpha = __builtin_amdgcn_exp2f((m_reg - mn) * C); m_reg = mn; }
  float mnC = -mn * C;
  for (int r = 0; r < 16; ++r) p0[r] = fmaf(p0[r], C, mnC); for (int r = 0; r < 16; ++r) p1[r] = fmaf(p1[r], C, mnC);
  for (int r = 0; r < 16; ++r) p0[r] = __builtin_amdgcn_exp2f(p0[r]);
}
__device__ __forceinline__ void finishSM(f32x16& p0, f32x16& p1, float alpha, float& l_reg, bf16x8& pa0, bf16x8& pa1, bf16x8& pa2, bf16x8& pa3) {
  for (int r = 0; r < 16; ++r) p1[r] = __builtin_amdgcn_exp2f(p1[r]);
  float ps = 0; for (int r = 0; r < 16; ++r) ps += p0[r]; for (int r = 0; r < 16; ++r) ps += p1[r];
  { auto rr = __builtin_amdgcn_permlane32_swap(__float_as_uint(ps), __float_as_uint(ps), false, false);
    ps = __uint_as_float(rr[0]) + __uint_as_float(rr[1]); }
  l_reg = l_reg * alpha + ps;
#define GPK4(P, BASE, OUT) do { unsigned a0 = cvtpk(P[BASE + 0], P[BASE + 1]), a1 = cvtpk(P[BASE + 2], P[BASE + 3]);   \
    unsigned b0 = cvtpk(P[BASE + 4], P[BASE + 5]), b1 = cvtpk(P[BASE + 6], P[BASE + 7]);                              \
    auto r0 = __builtin_amdgcn_permlane32_swap(a0, b0, false, false); auto r1 = __builtin_amdgcn_permlane32_swap(a1, b1, false, false); \
    u32x4 w = {r0[0], r1[0], r0[1], r1[1]}; OUT = *reinterpret_cast<bf16x8*>(&w); } while (0)
  GPK4(p0, 0, pa0); GPK4(p0, 8, pa1); GPK4(p1, 0, pa2); GPK4(p1, 8, pa3);
#undef GPK4
}
__device__ __forceinline__ void qkt(f32x16& p0, f32x16& p1, const LAS bf16_t* Ks, const bf16x8* qr, int r32, int hi) {
  p0 = f32x16{}; p1 = f32x16{};
  for (int d0 = 0; d0 < 8; ++d0) { int cb = (d0 * 16 + hi * 8) * 2;
    bf16x8 b0 = *(const LAS bf16x8*)((const LAS char*)Ks + KSWZ(r32, cb));
    bf16x8 b1 = *(const LAS bf16x8*)((const LAS char*)Ks + KSWZ(32 + r32, cb));
    p0 = __builtin_amdgcn_mfma_f32_32x32x16_bf16(b0, qr[d0], p0, 0, 0, 0);
    p1 = __builtin_amdgcn_mfma_f32_32x32x16_bf16(b1, qr[d0], p1, 0, 0, 0); }
}
constexpr int v_rd_off(int d0, int ks, int half) { return d0 * 512 + ks * 4096 + half * 2048; }
template <int OFF> __device__ __forceinline__ s16x4 tr_read(int vb) {
  s16x4 r; asm volatile("ds_read_b64_tr_b16 %0, %1 offset:%2" : "=&v"(r) : "v"(vb), "i"(OFF) : "memory"); return r;
}
template <int D0> __device__ __forceinline__ void pv_one(f32x16& od, int vb, bf16x8 pa0, bf16x8 pa1, bf16x8 pa2, bf16x8 pa3) {
  const s16x4 l0 = tr_read<v_rd_off(D0, 0, 0)>(vb), h0 = tr_read<v_rd_off(D0, 0, 1)>(vb), l1 = tr_read<v_rd_off(D0, 1, 0)>(vb), h1 = tr_read<v_rd_off(D0, 1, 1)>(vb);
  const s16x4 l2 = tr_read<v_rd_off(D0, 2, 0)>(vb), h2 = tr_read<v_rd_off(D0, 2, 1)>(vb), l3 = tr_read<v_rd_off(D0, 3, 0)>(vb), h3 = tr_read<v_rd_off(D0, 3, 1)>(vb);
  asm volatile("s_waitcnt lgkmcnt(0)" ::: "memory"); SBAR();
#define PK(L, H) (bf16x8){L[0], L[1], L[2], L[3], H[0], H[1], H[2], H[3]}
  od = __builtin_amdgcn_mfma_f32_32x32x16_bf16(pa0, PK(l0, h0), od, 0, 0, 0);
  od = __builtin_amdgcn_mfma_f32_32x32x16_bf16(pa1, PK(l1, h1), od, 0, 0, 0);
  od = __builtin_amdgcn_mfma_f32_32x32x16_bf16(pa2, PK(l2, h2), od, 0, 0, 0);
  od = __builtin_amdgcn_mfma_f32_32x32x16_bf16(pa3, PK(l3, h3), od, 0, 0, 0);
#undef PK
}
__device__ __forceinline__ void pv_d0(f32x16* o, int vb, bf16x8 pa0, bf16x8 pa1, bf16x8 pa2, bf16x8 pa3) {
  pv_one<0>(o[0], vb, pa0, pa1, pa2, pa3); pv_one<1>(o[1], vb, pa0, pa1, pa2, pa3); pv_one<2>(o[2], vb, pa0, pa1, pa2, pa3); pv_one<3>(o[3], vb, pa0, pa1, pa2, pa3);
}
__device__ __forceinline__ void unit(const GAS bf16_t* __restrict__ GQ, const GAS bf16_t* __restrict__ Kh, const GAS bf16_t* __restrict__ Vh, const GAS bf16_t* __restrict__ GZ, GAS bf16_t* __restrict__ MIX,
                                     const GAS float* __restrict__ qng, const GAS float* __restrict__ ropeR, const GAS float* __restrict__ ropeC, int qrow0, int head, int seq, LAS char* lds, int tid_in) {
  int tid = tid_in; asm volatile("" : "+v"(tid)); const int wid = __builtin_amdgcn_readfirstlane(tid >> 6), lane = tid & 63, r32 = lane & 31, hi = lane >> 5;
  LAUNDER_S(Kh); LAUNDER_S(Vh); LAUNDER_S(GQ); LAUNDER_S(GZ); LAUNDER_S(MIX);
  LAS bf16_t* V_lds = (LAS bf16_t*)lds; LAS bf16_t* K_lds = (LAS bf16_t*)(lds + 2 * SHM_V);
  LAS float* ws = (LAS float*)(lds + 2 * SHM_V + 2 * SHM_K) + wid * 64; LAS float* li_l = ws; LAS float* al_l = ws + 32;
  float m_reg = -1e30f, l_reg = 0; f32x16 o[4] = {}; bf16x8 qr[8];
  {
    const int row = qrow0 + wid * QBLK + r32; const GAS bf16_t* qp_ = GQ + (size_t)(qrow0 + wid * QBLK) * LDQ + head * D; const unsigned qo_ = (unsigned)(r32 * LDQ + hi * 8) * 2u;
    bf16x8 v[8]; float ss = 0.f;
#pragma unroll
    for (int d0 = 0; d0 < 8; ++d0) { v[d0] = GLD8(qp_ + d0 * 16, qo_);
#pragma unroll
      for (int j = 0; j < 8; ++j) { const float f = bf2f(v[d0][j]); ss += f * f; } }
    ss = swap_add(ss);
    const float rq = 1.0f / sqrtf(ss * (1.f / 128.f) + RMS_EPS);
    const int t = row & 8191, pr = t >> 6, pc = t & 63;
#pragma unroll
    for (int ax = 0; ax < 2; ++ax)
#pragma unroll
      for (int dd = 0; dd < 2; ++dd) { const int da = 4 * ax + dd, db = da + 2; const GAS float* tb = ax ? ropeC + (size_t)pc * 64 : ropeR + (size_t)pr * 64;
        float o1[8], o2[8];
#pragma unroll
        for (int j = 0; j < 8; ++j) { const int i = 16 * dd + 8 * hi + j; const float c = tb[i * 2], s = tb[i * 2 + 1];
          const float x1 = bf2f(v[da][j]) * rq * qng[16 * da + 8 * hi + j], x2 = bf2f(v[db][j]) * rq * qng[16 * db + 8 * hi + j];
          o1[j] = x1 * c - x2 * s; o2[j] = x1 * s + x2 * c; }
        { u32x4 w = {cvt_pk_bf16(o1[0], o1[1]), cvt_pk_bf16(o1[2], o1[3]), cvt_pk_bf16(o1[4], o1[5]), cvt_pk_bf16(o1[6], o1[7])}; qr[da] = __builtin_bit_cast(bf16x8, w); }
        { u32x4 w = {cvt_pk_bf16(o2[0], o2[1]), cvt_pk_bf16(o2[2], o2[3]), cvt_pk_bf16(o2[4], o2[5]), cvt_pk_bf16(o2[6], o2[7])}; qr[db] = __builtin_bit_cast(bf16x8, w); }
        asm volatile("" ::: "memory"); }
  }
  const int sr = tid >> 4, sc = (tid & 15) * 8, vst0 = v_st(sr, sc), vst1 = v_st(32 + sr, sc);
  const int vb0 = (int)(unsigned)(uintptr_t)V_lds + v_rd_base(lane);
  struct { bf16x8 vs0, vs1, ks0, ks1; } sr_[1];
  const unsigned so0 = (unsigned)(sr * LDK + sc) * 2u, so1 = (unsigned)((32 + sr) * LDK + sc) * 2u;
#define SLOAD(i, k0) do { const GAS bf16_t* vt_ = Vh + (size_t)(k0) * LDK; const GAS bf16_t* kt_ = Kh + (size_t)(k0) * LDK; \
    sr_[i].vs0 = GLD8(vt_, so0); sr_[i].vs1 = GLD8(vt_, so1); sr_[i].ks0 = GLD8(kt_, so0); sr_[i].ks1 = GLD8(kt_, so1); } while (0)
#define SWRITE(b, i) do { *(LAS bf16x8*)((LAS char*)V_lds + (b) * SHM_V + vst0) = sr_[i].vs0;          \
    *(LAS bf16x8*)((LAS char*)V_lds + (b) * SHM_V + vst1) = sr_[i].vs1; int kc = sc * 2;               \
    *(LAS bf16x8*)((LAS char*)K_lds + (b) * SHM_K + KSWZ(sr, kc)) = sr_[i].ks0;                       \
    *(LAS bf16x8*)((LAS char*)K_lds + (b) * SHM_K + KSWZ(32 + sr, kc)) = sr_[i].ks1; } while (0)
#define SWAIT() asm volatile("s_waitcnt vmcnt(0)" ::: "memory")
#define RESC(a) do { if (__any((a) < 1.f)) { if (hi == 0) al_l[r32] = (a); asm volatile("s_waitcnt lgkmcnt(0)" ::: "memory"); \
    for (int d = 0; d < 4; ++d) for (int r = 0; r < 16; ++r) o[d][r] *= al_l[crow(r, hi)]; } } while (0)
  f32x16 pA0, pA1, pB0, pB1; float mnA, mnB, alA, alB; bf16x8 pa0, pa1, pa2, pa3; const int NT = seq / KVBLK;
  constexpr int SE = 0, SO = 0;
  SLOAD(SE, 0); asm volatile("s_waitcnt vmcnt(0)" ::: "memory"); SWRITE(0, SE); __syncthreads();
  qkt(pA0, pA1, K_lds, qr, r32, hi); partialSM(pA0, pA1, m_reg, mnA, alA);
  SLOAD(SO, KVBLK);
  SWAIT(); SWRITE(1, SO); __syncthreads();
  for (int j = 1; j + 1 < NT; j += 2) {
    SBAR(); qkt(pB0, pB1, (LAS bf16_t*)((LAS char*)K_lds + SHM_K), qr, r32, hi);
    finishSM(pA0, pA1, alA, l_reg, pa0, pa1, pa2, pa3); SBAR();
    SLOAD(SO, (j + 1) * KVBLK); SBAR();
    pv_d0(o, vb0, pa0, pa1, pa2, pa3); partialSM(pB0, pB1, m_reg, mnB, alB);
    __syncthreads(); SWAIT(); SWRITE(0, SE);
    RESC(alB); __syncthreads();
    SBAR(); qkt(pA0, pA1, K_lds, qr, r32, hi);
    finishSM(pB0, pB1, alB, l_reg, pa0, pa1, pa2, pa3); SBAR();
    SLOAD(SE, (j + 2) * KVBLK); SBAR();
    pv_d0(o, vb0 + (int)SHM_V, pa0, pa1, pa2, pa3); partialSM(pA0, pA1, m_reg, mnA, alA);
    __syncthreads(); SWAIT(); SWRITE(1, SO);
    RESC(alA); __syncthreads();
  }
  SBAR(); qkt(pB0, pB1, (LAS bf16_t*)((LAS char*)K_lds + SHM_K), qr, r32, hi);
  finishSM(pA0, pA1, alA, l_reg, pa0, pa1, pa2, pa3); SBAR();
  pv_d0(o, vb0, pa0, pa1, pa2, pa3); partialSM(pB0, pB1, m_reg, mnB, alB);
  __syncthreads(); RESC(alB);
  finishSM(pB0, pB1, alB, l_reg, pa0, pa1, pa2, pa3); SBAR();
  pv_d0(o, vb0 + (int)SHM_V, pa0, pa1, pa2, pa3);
  if (hi == 0) li_l[r32] = l_reg; asm volatile("s_waitcnt lgkmcnt(0)" ::: "memory");
  const GAS bf16_t* zb_ = GZ + (size_t)(qrow0 + wid * QBLK) * 1024 + head * D; GAS bf16_t* ob_ = MIX + (size_t)(qrow0 + wid * QBLK) * 2048 + head * D;
  const unsigned zo_ = (unsigned)(4 * hi * 1024 + r32) * 2u, oo_ = (unsigned)(4 * hi * 2048 + r32) * 2u;
#pragma unroll
  for (int r = 0; r < 16; ++r) { const float rli = __builtin_amdgcn_rcpf(li_l[crow(r, hi)]); const int cr = (r & 3) + 8 * (r >> 2);
#pragma unroll
    for (int d0 = 0; d0 < 4; ++d0) GP16(ob_, oo_ + cr * 4096 + 64 * d0) = f2b(o[d0][r] * rli * bf2f(GPC16(zb_, zo_ + cr * 2048 + 64 * d0)));
    if ((r & 3) == 3) asm volatile("" ::: "memory"); }
  __syncthreads();
#undef SLOAD
#undef SWRITE
#undef SWAIT
#undef RESC
}
#undef KSWZ
#undef SBAR
}

__device__ __forceinline__ void p12_final(Frame& F, const Args& A_) {
    const int gw = F.vcu * NWAVES + F.wave, NGW = F.G * NWAVES; const GAS float* fg = inp(F, 2);
    for (int row = gw; row < M; row += NGW) {
        GAS f32x4* p = (GAS f32x4*)(F.out + (size_t)row * 1024) + F.lane; f32x4 v[4]; float s = 0.f;
#pragma unroll
        for (int j = 0; j < 4; ++j) { v[j] = p[64 * j]; s += (v[j][0] * v[j][0] + v[j][1] * v[j][1]) + (v[j][2] * v[j][2] + v[j][3] * v[j][3]); }
#pragma unroll
        for (int o = 1; o < 64; o <<= 1) s += __shfl_xor(s, o);
        const float r = 1.0f / sqrtf(s * (1.f / 1024.f) + RMS_EPS);
#pragma unroll
        for (int j = 0; j < 4; ++j) { const f32x4 g = *((const GAS f32x4*)fg + F.lane + 64 * j); p[64 * j] = v[j] * r * g; }
    }
}

__global__ void __launch_bounds__(NTHR, 2) mega_fwd(Args args) {
    extern __shared__ __attribute__((aligned(16))) unsigned char lds[];
    Frame F;
    F.lds = (LAS unsigned char*)lds; F.MISC = (volatile LAS unsigned*)(F.lds + MISC_OFF);
    F.tid = threadIdx.x; F.lane = F.tid & 63; F.wave = __builtin_amdgcn_readfirstlane(F.tid >> 6);
    F.G = gridDim.x; { const int bx = blockIdx.x; F.vcu = (F.G % 8 == 0) ? (bx % 8) * (F.G / 8) + bx / 8 : bx; }
    F.ws = (GAS unsigned char*)args.ws; F.out = (GAS float*)args.out; F.ctl = (gu32*)(args.ws + WS_CTL);
    for (int u = F.tid; u < (LDS_BYTES - LDSCTL_OFF) / 4; u += NTHR) ((LAS unsigned*)(F.lds + LDSCTL_OFF))[u] = 0u;
    __syncthreads();
    if (F.tid == 0) { volatile LAS unsigned long long* t = (volatile LAS unsigned long long*)(F.lds + LDSCTL_OFF + 1024);
#pragma unroll
        for (int i = 0; i < 14; ++i) t[i] = (unsigned long long)args.in[i]; }
    __syncthreads();
    XcdBarrier bar = xcd_barrier_post((unsigned*)(F.ctl + CW_BAR), F.MISC + 8);
    const int lo = args.ph_lo, hi = args.ph_hi;
#ifndef PHMASK
#define PHMASK 0x1fff
#endif
#define IN(k) (((PHMASK >> (k)) & 1) && lo <= (k) && (k) < hi && phase_enter(F))
#ifdef DIAG_A
#define STAMP(k) do { if (blockIdx.x == 0 && F.tid == 0) __hip_atomic_store((unsigned*)(F.ctl + 12288 + (k)), (unsigned)__builtin_amdgcn_s_memrealtime(), __ATOMIC_RELAXED, __HIP_MEMORY_SCOPE_AGENT); } while (0)
#else
#define STAMP(k) do { } while (0)
#endif
#define SEAM(k) do { if (IN(k) && IN((k) + 1)) xcd_barrier(bar); STAMP((k) + 1); } while (0)

    STAMP(0);
    if (IN(0)) { p0_prologue(F, args); } SEAM(0);
    if (IN(1)) {
        pg8::Gemm g{(const bf16_t*)WSP(bf16_t, WS_U0), (const bf16_t*)WSP(bf16_t, WS_W1T), M, 5120, 1024}; pg8::StaticOrder S; S.init(M, 5120, F.G, (int)blockIdx.x);
        pg8::EpiAct E{0, WSP(bf16_t, WS_A0), WSP(bf16_t, WS_A1), WSP(bf16_t, WS_A2), WSP(bf16_t, WS_A3), nullptr, nullptr, WSP(float, WS_RS0), 1};
        pg8::gemm_phase<pg8::EpiAct, pg8::StaticOrder, true, true>(F.lds, g, S, E);
    } SEAM(1);
    if (IN(2)) { for (int u = F.vcu; u < 256; u += F.G) x1_unit(F, args, u); } SEAM(2);
    if (IN(3)) { x2_scan(F); } SEAM(3);
    if (IN(4)) { for (int u = F.vcu; u < 256; u += F.G) x3_unit(F, args, u); } SEAM(4);
    if (IN(5)) {
        pg8::Gemm g{(const bf16_t*)WSP(bf16_t, WS_U0), (const bf16_t*)(WSP(bf16_t, WS_W1T) + (size_t)5120 * 1024), M, 4096, 1024}; pg8::StaticOrder S; S.init(M, 4096, F.G, (int)blockIdx.x);
        pg8::EpiAct E{1, WSP(bf16_t, WS_A0), WSP(bf16_t, WS_A1), WSP(bf16_t, WS_A2), WSP(bf16_t, WS_A3), nullptr, nullptr, WSP(float, WS_RS0), 1};
        pg8::gemm_phase<pg8::EpiAct, pg8::StaticOrder, true, true>(F.lds, g, S, E);
    } SEAM(5);
    if (IN(6)) {
        { LAS float* scr = (LAS float*)(F.lds + F.wave * 16384); const int gw = F.vcu * NWAVES + F.wave, NGW = F.G * NWAVES;
          for (int it = gw; it < 16 * 208; it += NGW) { const int kb = it / 208, d = 32 * (it % 208); transpose_item(inp(F, 8), ODD_IN, 1024, WSP(bf16_t, WS_W3T), d, map_w3(d), inp(F, 1) + 1024, scr, kb, F.lane); }
          __syncthreads(); }
        STAMP(14);
        na_phase(F, args);
    } SEAM(6);
    if (IN(7)) {
        pg8::Gemm g{(const bf16_t*)WSP(bf16_t, WS_MIX0), (const bf16_t*)WSP(bf16_t, WS_W2T), M, 1024, 2048}; pg8::StaticOrder S; S.init(M, 1024, F.G, (int)blockIdx.x);
        pg8::EpiResid E{inp(F, 0), F.out, WSP(bf16_t, WS_H1B), WSP(float, WS_PART)};
        pg8::gemm_phase<pg8::EpiResid, pg8::StaticOrder, false, true>(F.lds, g, S, E);
    } SEAM(7);
    if (IN(8)) {
        pg8::Gemm g{(const bf16_t*)WSP(bf16_t, WS_H1B), (const bf16_t*)WSP(bf16_t, WS_W3T), M, 6656, 1024}; pg8::StaticOrder S; S.init(M, 6656, F.G, (int)blockIdx.x);
        pg8::EpiAct E{2, WSP(bf16_t, WS_GQ), WSP(bf16_t, WS_GK), WSP(bf16_t, WS_GV), WSP(bf16_t, WS_GZ), WSP(bf16_t, WS_XC), WSP(bf16_t, WS_CG), WSP(float, WS_PART), 2};
        pg8::gemm_phase<pg8::EpiAct, pg8::StaticOrder, true, true>(F.lds, g, S, E);
    } SEAM(8);
    if (IN(9)) { p9_krope_conv(F, args); } SEAM(9);
    if (IN(10)) {
        const int combo = F.vcu >> 6, b = combo >> 1, kvh = combo & 1, idx = F.vcu & 63;
        if (F.vcu < 256)
#pragma unroll 1
        for (int i = 0; i < 2; ++i) { const int uu = idx * 2 + i, head = 4 * kvh + (uu >> 5), qblk = uu & 31;
            gqa::unit(WSP(bf16_t, WS_GQ), WSP(bf16_t, WS_GK) + (size_t)b * SEQ * 256 + kvh * 128, WSP(bf16_t, WS_GV) + (size_t)b * SEQ * 256 + kvh * 128, WSP(bf16_t, WS_GZ), WSP(bf16_t, WS_MIX1),
                      inp(F, 10), WSP(float, WS_ROPE), WSP(float, WS_ROPE) + 8192, b * SEQ + 256 * qblk, head, SEQ, (LAS char*)F.lds, F.tid); }
    } SEAM(10);
    if (IN(11)) {
        pg8::Gemm g{(const bf16_t*)WSP(bf16_t, WS_MIX1), (const bf16_t*)WSP(bf16_t, WS_W4T), M, 1024, 2048}; pg8::StaticOrder S; S.init(M, 1024, F.G, (int)blockIdx.x);
        pg8::EpiResid E{F.out, F.out, nullptr, nullptr};
        pg8::gemm_phase<pg8::EpiResid, pg8::StaticOrder, false, true>(F.lds, g, S, E);
    } SEAM(11);
    if (IN(12)) { p12_final(F, args); }
#ifdef DIAG_A
    __syncthreads(); STAMP(13); xcd_barrier(bar);
    if (blockIdx.x == 0) { unsigned* ts = (unsigned*)(F.ctl + 12288);
        asm volatile("s_waitcnt vmcnt(0)" ::: "memory");
        const unsigned a0 = __hip_atomic_load(ts + DIAG_A, __ATOMIC_RELAXED, __HIP_MEMORY_SCOPE_AGENT), a1 = __hip_atomic_load(ts + DIAG_B, __ATOMIC_RELAXED, __HIP_MEMORY_SCOPE_AGENT);
        const unsigned b0 = a0, b1 = a1;
        const float da = (float)(a1 - a0) * 0.0001f, db = (float)(b1 - b0) * 0.0001f;
        if (F.tid == 0) F.out[0] += da;
        for (int i = F.tid; i < DIAG_NB; i += NTHR) F.out[1024 + i] += db; }
#endif
#undef IN
#undef SEAM
}

extern "C" void kernel_launch(void* const* d_in, const int* in_sizes, int n_in, void* d_out, int out_size, void* d_ws, size_t ws_size, hipStream_t stream) {
    static int grid = 0;
    if (grid == 0) {
        if (n_in != 14 || in_sizes[0] != M * DM || out_size != M * DM || ws_size < WS_END) { fprintf(stderr, "kernel_launch: unexpected shapes/workspace: n_in %d in0 %d out %d ws %zu\n", n_in, n_in > 0 ? in_sizes[0] : -1, out_size, ws_size); grid = -1; return; }
        int dev = 0, cus = 0, per_cu = 0;
        if (hipGetDevice(&dev) != hipSuccess || hipDeviceGetAttribute(&cus, hipDeviceAttributeMultiprocessorCount, dev) != hipSuccess) { grid = -1; return; }
        if (hipFuncSetAttribute((const void*)mega_fwd, hipFuncAttributeMaxDynamicSharedMemorySize, LDS_BYTES) != hipSuccess) { fprintf(stderr, "kernel_launch: hipFuncSetAttribute failed\n"); grid = -1; return; }
        if (hipOccupancyMaxActiveBlocksPerMultiprocessor(&per_cu, (const void*)mega_fwd, NTHR, LDS_BYTES) != hipSuccess || per_cu < 1) { fprintf(stderr, "kernel_launch: occupancy query reports %d\n", per_cu); per_cu = 1; }
        (void)hipGetLastError();
        grid = cus;
    }
    if (grid < 0) return;
    if (hipMemsetAsync((char*)d_ws + WS_CTL, 0, CTL_ZERO_BYTES, stream) != hipSuccess) return;
    Args a{};
    for (int i = 0; i < 14; ++i) a.in[i] = (const float*)d_in[i];
    a.out = (float*)d_out; a.ws = (unsigned char*)d_ws;
#ifdef MK_SPLIT
    for (int p = 0; p < NPHASE; ++p) { a.ph_lo = p; a.ph_hi = p + 1; hipLaunchKernelGGL(mega_fwd, dim3(grid), dim3(NTHR), LDS_BYTES, stream, a); }
#else
    a.ph_lo = 0; a.ph_hi = NPHASE;
    hipLaunchKernelGGL(mega_fwd, dim3(grid), dim3(NTHR), LDS_BYTES, stream, a);
#endif
}
```

```cpp
#include <hip/hip_runtime.h>
#include <cstdio>
#include <cstdint>
#include <cmath>
namespace pg8 {
#define PG8_LAS __attribute__((address_space(3)))
typedef unsigned short bf16_t;
typedef short bf16x8 __attribute__((ext_vector_type(8)));
typedef float f32x4 __attribute__((ext_vector_type(4)));
typedef unsigned u32x4 __attribute__((ext_vector_type(4)));
constexpr int BM = 256, BK = 64, HALF = 128, HTB = HALF * BK * 2  , STAGE_BYTES = 8 * HTB, NXCD = 8, WGM = 8;

__host__ __device__ __forceinline__ int lds_byte(int r, int c) { const int st = (r >> 4) * 2 + (c >> 5), rr = r & 15, cc = c & 31, ob = rr * 64 + cc * 2; return st * 1024 + (ob ^ (((ob >> 9) & 1) << 5)); }
__host__ __device__ __forceinline__ void stage_rc(int b, int& R, int& C) { const int st = b / 1024, sb = b % 1024, swz = sb ^ (((sb >> 9) & 1) << 5); R = (st >> 1) * 16 + swz / 64; C = (st & 1) * 32 + (swz % 64) / 2; }
__host__ __device__ __forceinline__ int perm32(int rho) { const int n = rho >> 4, i = rho & 15; return 8 * (i >> 2) + 4 * n + (i & 3); }

struct Unit { int pm, pn; };
struct Gemm { const bf16_t* A; const bf16_t* Bt; int M, N, K; };

struct StaticOrder {
    int nM, nN, nwg, G, c;
    __host__ __device__ void init(int M, int N, int G_, int c_) { nM = M / BM; nN = N / BM; nwg = nM * nN; G = G_; c = c_; }
    __host__ __device__ bool next(int i, Unit& u) const {
        const long L = (long)i * G + c; if (L >= nwg) return false;
        int wgid = (int)L; { const int q = nwg / NXCD, r = nwg % NXCD, xcd = wgid % NXCD, off = wgid / NXCD; wgid = (xcd < r ? xcd * (q + 1) : r * (q + 1) + (xcd - r) * q) + off; }
        const int nig = WGM * nN, gid = wgid / nig, fm = gid * WGM, gsz = (nM - fm) < WGM ? (nM - fm) : WGM;
        u.pm = fm + ((wgid % nig) % gsz); u.pn = (wgid % nig) / gsz; return true;
    }
    __device__ __forceinline__ void a_ready(const Unit&) const {}
    __device__ __forceinline__ void done(const Unit&) const {}
};

typedef float f32x2 __attribute__((ext_vector_type(2)));
typedef __bf16 bf16x2_t __attribute__((ext_vector_type(2)));
__device__ __forceinline__ unsigned cvt_pk_bf16(float lo, float hi) { f32x2 v = {lo, hi}; bf16x2_t b = __builtin_convertvector(v, bf16x2_t); return __builtin_bit_cast(unsigned, b); }
__device__ __forceinline__ float fexp(float x) { return __builtin_amdgcn_exp2f(x * 1.4426950408889634f); }
__device__ __forceinline__ float sigm(float x) { return __builtin_amdgcn_rcpf(1.f + fexp(-x)); }
__device__ __forceinline__ float silu(float x) { return x * sigm(x); }

#define PG8_GAS __attribute__((address_space(1)))
struct TileOut { PG8_GAS bf16_t* dst; int ldc; int col0; int mode; float scale; int hstride; };
constexpr size_t PM_ = 16384;
struct EpiAct {
    static constexpr bool PERM = true, AFTER_DRAIN = false;
    int gid;
    PG8_GAS bf16_t *T0, *T1, *T2, *T3, *T4, *T5;
    const PG8_GAS float* rs; int rs_mode;
    __device__ __forceinline__ TileOut tile(int pn) const {
        TileOut t;
        if (gid == 0) {
            if (pn < 4)       t = TileOut{T0 + (size_t)pn * (PM_ * 256), 256, 0, 0, 1.f, 128};
            else if (pn < 8)  t = TileOut{T1 + (size_t)(pn - 4) * (PM_ * 256), 256, 0, 0, 0.0625f, 128};
            else if (pn < 12) t = TileOut{T2 + (size_t)(pn - 8) * (PM_ * 256), 256, 0, 0, 1.f, 128};
            else              t = TileOut{T3 + (size_t)((pn - 12) >> 1) * (PM_ * 256), 256, 128 * ((pn - 12) & 1), 2, 1.f, 128};
        } else if (gid == 1) {
            if (pn < 4)       t = TileOut{T0 + (size_t)pn * (PM_ * 256), 256, 0, 0, 0.125f, 128};
            else if (pn < 8)  t = TileOut{T1 + (size_t)(pn - 4) * (PM_ * 256), 256, 0, 0, 1.f, 128};
            else if (pn < 12) t = TileOut{T2 + (size_t)(pn - 8) * (PM_ * 256), 256, 0, 0, 1.f, 128};
            else              t = TileOut{T3 + (size_t)(pn - 12) * (PM_ * 256), 256, 0, 1, 1.f, 128};
        } else {
            if (pn < 4)        t = TileOut{T0, 1024, 256 * pn, 0, 1.f, 128};
            else if (pn == 4)  t = TileOut{T1, 128, 0, 0, 1.f, (int)(PM_ * 128)};
            else if (pn == 5)  t = TileOut{T2, 128, 0, 0, 1.f, (int)(PM_ * 128)};
            else if (pn < 10)  t = TileOut{T3, 1024, 256 * (pn - 6), 1, 1.f, 128};
            else if (pn < 18)  t = TileOut{T4, 1024, 128 * (pn - 10), 3, 1.f, 128};
            else               t = TileOut{T5, 1024, 128 * (pn - 18), 4, 1.f, 128};
        }
        return t;
    }
    __device__ __forceinline__ void operator()(const f32x4 (&acc)[2][2][4][2], const Unit& u, int wr, int wc, int fr, int fq) const {
        const TileOut t = tile(u.pn);
        const int rbase = u.pm * BM + wr * 64 + fr, cl = wc * 32 + 8 * fq;
#pragma unroll
        for (int ai = 0; ai < 2; ++ai)
#pragma unroll
            for (int m = 0; m < 4; ++m) {
                const int row = rbase + ai * HALF + m * 16;
                float r = t.scale;
                if (rs_mode == 1) r *= rs[row];
                else if (rs_mode == 2) { const PG8_GAS f32x4* pp = (const PG8_GAS f32x4*)(rs + (size_t)row * 16); const f32x4 a = pp[0], b = pp[1], c = pp[2], d = pp[3];
                    const float s = ((a[0] + a[1]) + (a[2] + a[3])) + ((b[0] + b[1]) + (b[2] + b[3])) + ((c[0] + c[1]) + (c[2] + c[3])) + ((d[0] + d[1]) + (d[2] + d[3]));
                    r *= __builtin_amdgcn_rsqf(s * (1.f / 1024.f) + 1e-6f); }
                PG8_GAS bf16_t* rowp = t.dst + (size_t)row * t.ldc + t.col0 + cl;
                if (t.mode <= 1) {
#pragma unroll
                    for (int bj = 0; bj < 2; ++bj) { f32x4 v0 = acc[ai][bj][m][0] * r, v1 = acc[ai][bj][m][1] * r;
                        if (t.mode == 1) {
#pragma unroll
                            for (int j = 0; j < 4; ++j) { v0[j] = silu(v0[j]); v1[j] = silu(v1[j]); } }
                        u32x4 w; w.x = cvt_pk_bf16(v0[0], v0[1]); w.y = cvt_pk_bf16(v0[2], v0[3]); w.z = cvt_pk_bf16(v1[0], v1[1]); w.w = cvt_pk_bf16(v1[2], v1[3]);
                        *(PG8_GAS u32x4*)(rowp + (size_t)bj * t.hstride) = w; }
                } else {
                    f32x4 o[2];
#pragma unroll
                    for (int n = 0; n < 2; ++n) { const f32x4 a = acc[ai][0][m][n] * r, b = acc[ai][1][m][n] * r;
#pragma unroll
                        for (int j = 0; j < 4; ++j) o[n][j] = (t.mode == 2) ? sigm(a[j]) * silu(b[j]) : (t.mode == 3) ? a[j] * b[j] : a[j] * silu(b[j]); }
                    u32x4 w; w.x = cvt_pk_bf16(o[0][0], o[0][1]); w.y = cvt_pk_bf16(o[0][2], o[0][3]); w.z = cvt_pk_bf16(o[1][0], o[1][1]); w.w = cvt_pk_bf16(o[1][2], o[1][3]);
                    *(PG8_GAS u32x4*)rowp = w;
                }
            }
    }
};
struct EpiResid {
    static constexpr bool PERM = false, AFTER_DRAIN = false;
    const PG8_GAS float* base; PG8_GAS float* out; PG8_GAS bf16_t* outb; PG8_GAS float* part;
    __device__ __forceinline__ void operator()(const f32x4 (&acc)[2][2][4][2], const Unit& u, int wr, int wc, int fr, int fq) const {
        typedef unsigned u32x2v __attribute__((ext_vector_type(2)));
        const int col0 = u.pn * BM + wc * 32 + 4 * fq;
#pragma unroll
        for (int ai = 0; ai < 2; ++ai)
#pragma unroll
            for (int m = 0; m < 4; ++m) { const int row = u.pm * BM + ai * HALF + wr * 64 + m * 16 + fr; const size_t off = (size_t)row * 1024 + col0; float ss = 0.f;
#pragma unroll
                for (int bj = 0; bj < 2; ++bj)
#pragma unroll
                    for (int n = 0; n < 2; ++n) { const f32x4 bs = *(const PG8_GAS f32x4*)(base + off + bj * HALF + n * 16); const f32x4 o = bs + acc[ai][bj][m][n];
                        *(PG8_GAS f32x4*)(out + off + bj * HALF + n * 16) = o; ss += (o[0] * o[0] + o[1] * o[1]) + (o[2] * o[2] + o[3] * o[3]);
                        if (outb) { u32x2v w; w.x = cvt_pk_bf16(o[0], o[1]); w.y = cvt_pk_bf16(o[2], o[3]); *(PG8_GAS u32x2v*)(outb + off + bj * HALF + n * 16) = w; } }
                ss += __shfl_xor(ss, 16); ss += __shfl_xor(ss, 32);
                if (part && fq == 0) part[(size_t)row * 16 + u.pn * 4 + wc] = ss;
                if (m & 1) asm volatile("" ::: "memory"); }
    }
};

template <class Epi, class Sched, bool ALIGN_EPI = false, bool SP2 = false>
__device__ __forceinline__ void gemm_phase(PG8_LAS unsigned char* lds, const Gemm g, const Sched& S, const Epi& E) {
    const int tid = threadIdx.x, wid = __builtin_amdgcn_readfirstlane(tid >> 6), lane = tid & 63, wr = wid >> 2, wc = wid & 3, fr = lane & 15, fq = lane >> 4;
    const int K = g.K, nt = K / BK;
    unsigned voffA[2], voffB[2];
#pragma unroll
    for (int i = 0; i < 2; ++i) { int R, C; stage_rc(tid * 16 + i * 8192, R, C); const int Rb = Epi::PERM ? ((R & ~31) + perm32(R & 31)) : R;
        voffA[i] = (unsigned)(R * K + C) * 2u; voffB[i] = (unsigned)(Rb * K + C) * 2u; }
    const size_t kstep = (size_t)(BK * 2);
    const size_t hstep = (size_t)HALF * K * 2;
    const size_t tstep = 2 * hstep;
    const unsigned ldsw = (unsigned)wid * 1024u;
    const int aoff = lds_byte(wr * 64 + fr, fq * 8), boff = lds_byte(wc * 32 + fr, fq * 8);
#define PG8_SA(b, h) (((b) * 2 + (h)) * HTB)
#define PG8_SB(b, h) ((4 + (b) * 2 + (h)) * HTB)
#define PG8_STAGE(bufoff, gbase, voff) do { _Pragma("unroll") for (int _i = 0; _i < 2; ++_i) \
        __builtin_amdgcn_global_load_lds((const unsigned*)((const char*)(gbase) + (voff)[_i]), (PG8_LAS unsigned*)(lds + (bufoff) + ldsw + _i * 8192), 16, 0, 0); } while (0)
#define PG8_LDA(dst, b, h) do { _Pragma("unroll") for (int m = 0; m < 4; ++m) _Pragma("unroll") for (int k = 0; k < 2; ++k) dst[m][k] = *(const PG8_LAS bf16x8*)(lds + PG8_SA(b, h) + aoff + m * 2048 + k * 1024); } while (0)
#define PG8_LDB(dst, b, h) do { _Pragma("unroll") for (int n = 0; n < 2; ++n) _Pragma("unroll") for (int k = 0; k < 2; ++k) dst[n][k] = *(const PG8_LAS bf16x8*)(lds + PG8_SB(b, h) + boff + n * 2048 + k * 1024); } while (0)
#define PG8_MMA(ai, bj, At, Bt) do { __builtin_amdgcn_s_setprio(1); _Pragma("unroll") for (int m = 0; m < 4; ++m) _Pragma("unroll") for (int n = 0; n < 2; ++n) _Pragma("unroll") for (int k = 0; k < 2; ++k) \
        acc[ai][bj][m][n] = __builtin_amdgcn_mfma_f32_16x16x32_bf16(Bt[n][k], At[m][k], acc[ai][bj][m][n], 0, 0, 0); __builtin_amdgcn_s_setprio(0); } while (0)
#define PG8_WAIT_V(n) asm volatile("s_waitcnt vmcnt(" #n ")" ::: "memory")
#define PG8_WAIT_L(n) asm volatile("s_waitcnt lgkmcnt(" #n ")" ::: "memory")
#define PG8_BAR __builtin_amdgcn_s_barrier()
#define PG8_SCHED __builtin_amdgcn_sched_barrier(0)
    Unit cur, nxt; int ui = 0;
    if (!S.next(0, cur)) return;
    f32x4 acc[2][2][4][2];
#pragma unroll
    for (int a = 0; a < 2; ++a)
#pragma unroll
        for (int b = 0; b < 2; ++b)
#pragma unroll
            for (int m = 0; m < 4; ++m)
#pragma unroll
                for (int n = 0; n < 2; ++n) acc[a][b][m][n] = (f32x4){0.f, 0.f, 0.f, 0.f};
    bf16x8 At[4][2], B0[2][2], B1[2][2];
    const char* cA = (const char*)g.A + (size_t)cur.pm * tstep; const char* cB = (const char*)g.Bt + (size_t)cur.pn * tstep;
    S.a_ready(cur);
    if constexpr (SP2) {
        PG8_STAGE(PG8_SB(0, 0), cB, voffB); PG8_STAGE(PG8_SB(0, 1), cB + hstep, voffB); PG8_STAGE(PG8_SA(0, 0), cA, voffA); PG8_STAGE(PG8_SA(0, 1), cA + hstep, voffA);
        if (wr == 1) PG8_BAR;
        PG8_WAIT_V(2); PG8_BAR;
        PG8_STAGE(PG8_SB(1, 0), cB + kstep, voffB); PG8_STAGE(PG8_SA(1, 0), cA + kstep, voffA); PG8_STAGE(PG8_SB(1, 1), cB + hstep + kstep, voffB);
        PG8_WAIT_V(6); PG8_BAR;
    } else {
        PG8_STAGE(PG8_SB(0, 0), cB, voffB); PG8_STAGE(PG8_SA(0, 0), cA, voffA); PG8_STAGE(PG8_SB(0, 1), cB + hstep, voffB); PG8_STAGE(PG8_SA(0, 1), cA + hstep, voffA);
        if (wr == 1) PG8_BAR;
        PG8_WAIT_V(4); PG8_BAR;
        PG8_STAGE(PG8_SB(1, 0), cB + kstep, voffB); PG8_STAGE(PG8_SA(1, 0), cA + kstep, voffA); PG8_STAGE(PG8_SB(1, 1), cB + hstep + kstep, voffB);
        PG8_WAIT_V(6); PG8_BAR;
    }
    for (;;) {
        const bool has_next = S.next(ui + 1, nxt);
        const char* nA = has_next ? (const char*)g.A + (size_t)nxt.pm * tstep : cA; const char* nB = has_next ? (const char*)g.Bt + (size_t)nxt.pn * tstep : cB;
        for (int t = 0; t < nt; t += 2) {
            const bool last = (t == nt - 2);
            const char* a1 = cA + (size_t)(t + 1) * kstep;
            const char* a2 = last ? nA : cA + (size_t)(t + 2) * kstep; const char* b2 = last ? nB : cB + (size_t)(t + 2) * kstep;
            const char* a3 = a2 + kstep; const char* b3 = b2 + kstep;
            if (last && has_next) S.a_ready(nxt);
            if constexpr (SP2) {
            PG8_LDB(B0, 0, 0); PG8_LDB(B1, 0, 1); PG8_SCHED; PG8_LDA(At, 0, 0); PG8_STAGE(PG8_SA(1, 1), a1 + hstep, voffA);
            PG8_WAIT_V(8); PG8_WAIT_L(0); PG8_BAR; PG8_MMA(0, 0, At, B0); PG8_MMA(0, 1, At, B1); PG8_BAR; PG8_SCHED;
            PG8_LDA(At, 0, 1); PG8_STAGE(PG8_SB(0, 0), b2, voffB); PG8_STAGE(PG8_SB(0, 1), b2 + hstep, voffB); PG8_STAGE(PG8_SA(0, 0), a2, voffA);
            PG8_WAIT_V(8); PG8_WAIT_L(0); PG8_BAR; PG8_MMA(1, 0, At, B0); PG8_MMA(1, 1, At, B1); PG8_BAR; PG8_SCHED;
            PG8_LDB(B0, 1, 0); PG8_LDB(B1, 1, 1); PG8_SCHED; PG8_LDA(At, 1, 0); PG8_STAGE(PG8_SA(0, 1), a2 + hstep, voffA);
            PG8_WAIT_V(8); PG8_WAIT_L(0); PG8_BAR; PG8_MMA(0, 0, At, B0); PG8_MMA(0, 1, At, B1); PG8_BAR; PG8_SCHED;
            PG8_LDA(At, 1, 1); PG8_STAGE(PG8_SB(1, 0), b3, voffB); PG8_STAGE(PG8_SB(1, 1), b3 + hstep, voffB); PG8_STAGE(PG8_SA(1, 0), a3, voffA);
            PG8_WAIT_V(8); PG8_WAIT_L(0); PG8_BAR; PG8_MMA(1, 0, At, B0); PG8_MMA(1, 1, At, B1); PG8_BAR; PG8_SCHED;
            } else {
            PG8_LDB(B0, 0, 0); PG8_SCHED; PG8_LDA(At, 0, 0); PG8_STAGE(PG8_SA(1, 1), a1 + hstep, voffA);
            PG8_WAIT_L(8); PG8_BAR; PG8_WAIT_L(0); PG8_MMA(0, 0, At, B0); PG8_BAR; PG8_SCHED;
            PG8_LDB(B1, 0, 1); PG8_STAGE(PG8_SB(0, 0), b2, voffB);
            PG8_BAR; PG8_WAIT_L(0); PG8_MMA(0, 1, At, B1); PG8_BAR;
            PG8_LDA(At, 0, 1); PG8_STAGE(PG8_SA(0, 0), a2, voffA);
            PG8_BAR; PG8_WAIT_L(0); PG8_MMA(1, 0, At, B0); PG8_BAR; PG8_SCHED;
            PG8_STAGE(PG8_SB(0, 1), b2 + hstep, voffB);
            PG8_WAIT_V(6); PG8_BAR; PG8_MMA(1, 1, At, B1); PG8_BAR;
            PG8_LDB(B0, 1, 0); PG8_SCHED; PG8_LDA(At, 1, 0); PG8_STAGE(PG8_SA(0, 1), a2 + hstep, voffA);
            PG8_WAIT_L(8); PG8_BAR; PG8_WAIT_L(0); PG8_MMA(0, 0, At, B0); PG8_BAR; PG8_SCHED;
            PG8_LDB(B1, 1, 1); PG8_STAGE(PG8_SB(1, 0), b3, voffB);
            PG8_BAR; PG8_WAIT_L(0); PG8_MMA(0, 1, At, B1); PG8_BAR;
            PG8_LDA(At, 1, 1); PG8_STAGE(PG8_SA(1, 0), a3, voffA);
            PG8_BAR; PG8_WAIT_L(0); PG8_MMA(1, 0, At, B0); PG8_BAR; PG8_SCHED;
            PG8_STAGE(PG8_SB(1, 1), b3 + hstep, voffB);
            PG8_WAIT_V(6); PG8_BAR; PG8_MMA(1, 1, At, B1); PG8_BAR;
            }
        }
        if constexpr (ALIGN_EPI) { if (wr == 0) PG8_BAR; }
        if constexpr (!Epi::AFTER_DRAIN) { E(acc, cur, wr, wc, fr, fq); S.done(cur); }
        if (!has_next) break;
#pragma unroll
        for (int a = 0; a < 2; ++a)
#pragma unroll
            for (int b = 0; b < 2; ++b)
#pragma unroll
                for (int m = 0; m < 4; ++m)
#pragma unroll
                    for (int n = 0; n < 2; ++n) acc[a][b][m][n] = (f32x4){0.f, 0.f, 0.f, 0.f};
        cur = nxt; cA = nA; cB = nB; ++ui;
        if constexpr (ALIGN_EPI) { if (wr == 1) PG8_BAR; }
    }
    PG8_WAIT_V(0);
    if constexpr (!ALIGN_EPI) { if (wr == 0) PG8_BAR; }
    PG8_BAR;
    if constexpr (Epi::AFTER_DRAIN) { E.fused(acc, cur, wr, wc, fr, fq, lds, wid, lane); S.done(cur); }
#undef PG8_SA
#undef PG8_SB
#undef PG8_STAGE
#undef PG8_LDA
#undef PG8_LDB
#undef PG8_MMA
#undef PG8_WAIT_V
#undef PG8_WAIT_L
#undef PG8_BAR
#undef PG8_SCHED
}
}
#define GAS __attribute__((address_space(1)))
#define LAS __attribute__((address_space(3)))
typedef unsigned short bf16;
typedef unsigned v4u __attribute__((ext_vector_type(4)));
typedef float f32x4 __attribute__((ext_vector_type(4)));
typedef short bf16x8 __attribute__((ext_vector_type(8)));
typedef GAS unsigned gu32;
typedef GAS unsigned long long gu64;
#define RLX_AGENT __ATOMIC_RELAXED, __HIP_MEMORY_SCOPE_AGENT
#define LDS_WAIT() asm volatile("s_waitcnt lgkmcnt(0)" ::: "memory")
#define VM_WAIT() asm volatile("s_waitcnt vmcnt(0)" ::: "memory")
__device__ __forceinline__ unsigned long long rt() { return __builtin_amdgcn_s_memrealtime(); }
__device__ __forceinline__ unsigned f2bf(float f) { unsigned u = __builtin_bit_cast(unsigned, f); return (u + 0x7fffu + ((u >> 16) & 1u)) >> 16; }
__device__ __forceinline__ unsigned pk2(float lo, float hi) { return f2bf(lo) | (f2bf(hi) << 16); }

#define XB_TMO      128
#define XB_XCNT(j)  (256  + 64 * (j))
#define XB_XSUB(j)  (1280 + 64 * (j))
#define XB_XGEN(j)  (2304 + 64 * (j))
#define XB_TOP      3328
#define XB_TOPGEN   3392
#define XCD_BAR_WORDS 3456
#define XB_SPIN_CAP (1u << 18)

__device__ __forceinline__ unsigned xb_ld(unsigned* p)              { return __hip_atomic_load(p, __ATOMIC_RELAXED, __HIP_MEMORY_SCOPE_AGENT); }
__device__ __forceinline__ unsigned xb_add(unsigned* p, unsigned v) { return __hip_atomic_fetch_add(p, v, __ATOMIC_RELAXED, __HIP_MEMORY_SCOPE_AGENT); }
__device__ __forceinline__ unsigned xb_xcc_id() { return (unsigned)__builtin_amdgcn_s_getreg((3 << 11) | 20) & 0xFu; }
#define XB_SPIN(cond, bar) do { unsigned _sp = 0; while (cond) { __builtin_amdgcn_s_sleep(1); \
    if ((++_sp & 255u) == 0u) { if (xb_ld(&(bar)[XB_TMO])) break; if (_sp > XB_SPIN_CAP) { atomicAdd(&(bar)[XB_TMO], 1u); break; } } } } while (0)

struct XcdBarrier {
    unsigned* bar; unsigned x;
    volatile LAS unsigned* st;
};

__device__ __forceinline__ XcdBarrier xcd_barrier_post(unsigned* bar, volatile LAS unsigned* st) {
    XcdBarrier b; b.bar = bar; b.x = xb_xcc_id(); b.st = st;
    if (threadIdx.x == 0) (void)xb_add(&bar[XB_XCNT(b.x)], 1u);
    return b;
}
__device__ __forceinline__ void xcd_barrier_complete(unsigned* bar, unsigned x, unsigned& nloc, unsigned& nx) {
    const unsigned G = gridDim.x * gridDim.y * gridDim.z;
    unsigned sum, cnt, mine, sp = 0u;
    for (;;) {
        sum = 0u; cnt = 0u; mine = 0u;
#pragma unroll
        for (unsigned j = 0; j < 16; ++j) { const unsigned c = xb_ld(&bar[XB_XCNT(j)]); sum += c; cnt += (c > 0u) ? 1u : 0u; mine = (j == x) ? c : mine; }
        if (sum == G) break;
        __builtin_amdgcn_s_sleep(1);
        if ((++sp & 255u) == 0u) { if (xb_ld(&bar[XB_TMO])) break; if (sp > XB_SPIN_CAP) { atomicAdd(&bar[XB_TMO], 1u); break; } }
    }
    nloc = mine > 0u ? mine : 1u; nx = cnt > 0u ? cnt : 1u;
}

__device__ __forceinline__ void xcd_barrier(const XcdBarrier& b) {
    asm volatile("s_waitcnt vmcnt(0)" ::: "memory");
    __syncthreads();
    if (threadIdx.x == 0) {
        unsigned* bar = b.bar;
        __builtin_amdgcn_s_waitcnt(0);
        unsigned nloc = b.st[0], nx = b.st[1];
        if (nloc == 0u) { xcd_barrier_complete(bar, b.x, nloc, nx); b.st[0] = nloc; b.st[1] = nx; }
        const unsigned old = xb_add(&bar[XB_XSUB(b.x)], 1u);
        const unsigned gen = old / nloc;
        if (old + 1u == (gen + 1u) * nloc) {
            __builtin_amdgcn_fence(__ATOMIC_RELEASE, "agent");
            asm volatile("s_waitcnt vmcnt(0)" ::: "memory");
            const unsigned og = xb_add(&bar[XB_TOP], 1u);
            const unsigned tg = og / nx;
            if (og + 1u == (tg + 1u) * nx) xb_add(&bar[XB_TOPGEN], 1u);
            else XB_SPIN(xb_ld(&bar[XB_TOPGEN]) == tg, bar);
            __builtin_amdgcn_fence(__ATOMIC_ACQUIRE, "agent");
            xb_add(&bar[XB_XGEN(b.x)], 1u);
            asm volatile("s_waitcnt vmcnt(0)" ::: "memory");
        } else {
            XB_SPIN(xb_ld(&bar[XB_XGEN(b.x)]) == gen, bar);
            __builtin_amdgcn_fence(__ATOMIC_ACQUIRE, "agent");
            asm volatile("s_waitcnt vmcnt(0)" ::: "memory");
        }
    }
    __syncthreads();
}
typedef unsigned u32x4 __attribute__((ext_vector_type(4)));
constexpr int NWAVES = 8, NTHR = 512;
constexpr int BATCH = 2, SEQ = 8192, DM = 1024, M = BATCH * SEQ;
constexpr int EVEN_IN = 9232, ODD_IN = 6656;
constexpr float RMS_EPS = 1e-6f;
constexpr int NPHASE = 13;

constexpr size_t MiB = 1u << 20;
constexpr size_t WS_CTL = 0, CTL_ZERO_BYTES = 64 * 1024;
constexpr size_t WS_GATES = 1 * MiB;
constexpr size_t WS_PART = 2 * MiB;
constexpr size_t WS_RS0 = 3 * MiB;
constexpr size_t WS_ROPE = 3 * MiB + 64 * 1024;
constexpr size_t WS_NST = 3 * MiB + 128 * 1024;
constexpr size_t WS_CHSC = 3 * MiB + 640 * 1024;
constexpr size_t WS_W1T = 4 * MiB, WS_W2T = 22 * MiB, WS_U0 = 26 * MiB, WS_W3T = 26 * MiB;
constexpr size_t WS_A0 = 58 * MiB, WS_A1 = 90 * MiB, WS_A2 = 122 * MiB, WS_A3 = 154 * MiB, WS_MIX0 = 186 * MiB, WS_W4T = 250 * MiB;
constexpr size_t WS_H1B = WS_A0, WS_GQ = WS_A1, WS_GZ = WS_A2, WS_XC = WS_A3, WS_CG = 186 * MiB, WS_GK = 218 * MiB, WS_GV = 226 * MiB, WS_MIX1 = 4 * MiB;
constexpr size_t WS_END = 256 * MiB;
constexpr int CW_BAR = 4096;
constexpr int RING_BYTES = 131072, LDSCTL_OFF = 143360, MISC_OFF = LDSCTL_OFF + 320, LDS_BYTES = 147456;
static_assert(66560 + 128 * 528 <= LDSCTL_OFF, "LDS map");

typedef unsigned short bf16_t;
typedef short s16x4 __attribute__((ext_vector_type(4)));
typedef float f32x16 __attribute__((ext_vector_type(16)));
typedef unsigned u32x2 __attribute__((ext_vector_type(2)));
using pg8::cvt_pk_bf16; using pg8::fexp;

__device__ __forceinline__ float bf2f(unsigned short v) { return __uint_as_float((unsigned)v << 16); }
__device__ __forceinline__ bf16_t f2b(float x) { return (bf16_t)(cvt_pk_bf16(x, 0.f) & 0xffffu); }
__device__ __forceinline__ int crow(int r, int hi) { return (r & 3) + 8 * (r >> 2) + 4 * hi; }
__device__ __forceinline__ int v_st(int k, int c) { const int kk = (k & ~0xC) | ((k & 4) << 1) | ((k & 8) >> 1); return ((kk >> 3) * 4 + (c >> 5)) * 512 + ((kk & 7) * 32 + (c & 31)) * 2; }
__device__ __forceinline__ int v_rd_base(int lane) { return ((lane & 3) << 3) | (((lane >> 2) & 3) << 6) | (((lane >> 4) & 1) << 5) | (((lane >> 5) & 1) << 8); }
__device__ __forceinline__ int kswz512(int row, int colB) { return row * 528 + colB; }
__device__ __forceinline__ int kswz256(int row, int colB) { return row * 256 + (colB ^ ((row & 7) << 4)); }
typedef short v4i16_t __attribute__((ext_vector_type(4)));
__device__ __forceinline__ s16x4 vtr(LAS unsigned char* p) { return __builtin_bit_cast(s16x4, __builtin_amdgcn_ds_read_tr16_b64_v4i16((LAS v4i16_t*)p)); }
__device__ __forceinline__ bf16x8 tr_frag(LAS unsigned char* img_plus_rdbase, int d0, int ks) {
    LAS unsigned char* p = img_plus_rdbase + d0 * 512 + ks * 4096; const s16x4 lo = vtr(p), hi = vtr(p + 2048);
    return (bf16x8){lo[0], lo[1], lo[2], lo[3], hi[0], hi[1], hi[2], hi[3]};
}
__device__ __forceinline__ float swap_add(float v) { auto rr = __builtin_amdgcn_permlane32_swap(__float_as_uint(v), __float_as_uint(v), false, false); return __uint_as_float(rr[0]) + __uint_as_float(rr[1]); }
__device__ __forceinline__ float swap_max(float v) { auto rr = __builtin_amdgcn_permlane32_swap(__float_as_uint(v), __float_as_uint(v), false, false); return fmaxf(__uint_as_float(rr[0]), __uint_as_float(rr[1])); }
#define PK4(P, BASE, OUT) do { unsigned a0_ = cvt_pk_bf16(P[BASE + 0], P[BASE + 1]), a1_ = cvt_pk_bf16(P[BASE + 2], P[BASE + 3]);   \
    unsigned b0_ = cvt_pk_bf16(P[BASE + 4], P[BASE + 5]), b1_ = cvt_pk_bf16(P[BASE + 6], P[BASE + 7]);                              \
    auto r0_ = __builtin_amdgcn_permlane32_swap(a0_, b0_, false, false); auto r1_ = __builtin_amdgcn_permlane32_swap(a1_, b1_, false, false); \
    u32x4 w_ = {r0_[0], r1_[0], r0_[1], r1_[1]}; OUT = __builtin_bit_cast(bf16x8, w_); } while (0)

struct Args { const float* in[14]; float* out; unsigned char* ws; int ph_lo, ph_hi; };
#define LAUNDER_S(p) asm volatile("" : "+s"(p))
struct Frame {
    LAS unsigned char* lds; volatile LAS unsigned* MISC; gu32* ctl;
    int tid, lane, wave, vcu, G;
    GAS float* out; GAS unsigned char* ws;
};
#define WSP(T, off) ((GAS T*)(F.ws + (off)))
__device__ __forceinline__ const GAS float* inp(Frame& F, int k) {
    volatile LAS unsigned* t = (volatile LAS unsigned*)(F.lds + LDSCTL_OFF + 1024) + 2 * k;
    const unsigned lo = __builtin_amdgcn_readfirstlane(t[0]), hi = __builtin_amdgcn_readfirstlane(t[1]);
    return (const GAS float*)(((unsigned long long)hi << 32) | lo);
}
__device__ __forceinline__ bool phase_enter(Frame& F) { LAUNDER_S(F.ws); LAUNDER_S(F.out); asm volatile("" : "+v"(F.tid)); F.lane = F.tid & 63; F.wave = __builtin_amdgcn_readfirstlane(F.tid >> 6); return true; }

__device__ __forceinline__ int map_w1(int d) {
    const int tile = d >> 8, r = d & 255;
    if (tile < 12) return d;
    if (tile < 20) { const int t = tile - 12; return r < 128 ? 3072 + 128 * t + r : 4096 + 128 * t + (r - 128); }
    return 5136 + (d - 5120);
}
__device__ __forceinline__ int map_w3(int d) {
    const int tile = d >> 8, r = d & 255;
    if (tile < 10) return d;
    if (tile < 18) { const int t = tile - 10; return r < 128 ? 3584 + 128 * t + r : 4608 + 128 * t + (r - 128); }
    { const int t = tile - 18; return r < 128 ? 2560 + 128 * t + r : 5632 + 128 * t + (r - 128); }
}
__device__ __forceinline__ void transpose_item(const GAS float* W, int ldw, int K, GAS bf16_t* WT, int drow0, int scol0, const GAS float* gain, LAS float* scr, int kb, int lane) {
    const int k0 = 64 * kb;
#pragma unroll 8
    for (int i = 0; i < 32; ++i) { const int kk = 2 * i + (lane >> 5); const float gs = gain ? gain[k0 + kk] : 1.f; scr[kk * 33 + (lane & 31)] = W[(size_t)(k0 + kk) * ldw + scol0 + (lane & 31)] * gs; }
    LDS_WAIT(); asm volatile("" ::: "memory");
    const int c = lane & 7;
#pragma unroll
    for (int j = 0; j < 4; ++j) { const int n = (lane >> 3) + 8 * j; const LAS float* s = scr + (8 * c) * 33 + n;
        v4u o; o.x = cvt_pk_bf16(s[0 * 33], s[1 * 33]); o.y = cvt_pk_bf16(s[2 * 33], s[3 * 33]); o.z = cvt_pk_bf16(s[4 * 33], s[5 * 33]); o.w = cvt_pk_bf16(s[6 * 33], s[7 * 33]);
        *(GAS v4u*)(WT + (size_t)(drow0 + n) * K + k0 + 8 * c) = o; }
    LDS_WAIT(); asm volatile("" ::: "memory");
}
__device__ __forceinline__ float logsigmoidf_(float x) { return fminf(x, 0.f) - log1pf(expf(-fabsf(x))); }
__device__ __forceinline__ void p0_prologue(Frame& F, const Args& A_) {
    LAS float* scr = (LAS float*)(F.lds + F.wave * 16384);
    const int gw = F.vcu * NWAVES + F.wave, NGW = F.G * NWAVES;
    constexpr int I_W1 = 16 * 288, I_W2 = 32 * 32, I_W4 = 32 * 32;
    for (int it = gw; it < I_W1 + I_W2 + I_W4; it += NGW) {
        int r = it;
        if (r < I_W1) { const int kb = r / 288, d = 32 * (r % 288); transpose_item(inp(F, 3), EVEN_IN, 1024, WSP(bf16_t, WS_W1T), d, map_w1(d), nullptr, scr, kb, F.lane); continue; } r -= I_W1;
        if (r < I_W2) { const int kb = r / 32, d = 32 * (r % 32); transpose_item(inp(F, 5), 1024, 2048, WSP(bf16_t, WS_W2T), d, d, nullptr, scr, kb, F.lane); continue; } r -= I_W2;
        { const int kb = r / 32, d = 32 * (r % 32); transpose_item(inp(F, 9), 1024, 2048, WSP(bf16_t, WS_W4T), d, d, nullptr, scr, kb, F.lane); }
    }
    { const int gt = blockIdx.x * NTHR + F.tid;
      if (gt < 6144) { const int isc = gt >= 4096; const int e = isc ? gt - 4096 : gt; const int pos = e >> 5, i = e & 31;
          const float inv = powf(10000.f, -(float)i / 32.f); const float ang = (float)pos * inv;
          GAS float* tb = WSP(float, WS_ROPE) + (isc ? 8192 : 0); tb[e * 2] = cosf(ang); tb[e * 2 + 1] = sinf(ang); } }
    __syncthreads();
    LAS float* wg = (LAS float*)F.lds;
    { const GAS float* W = inp(F, 3); const GAS float* g0 = inp(F, 1);
      for (int idx = F.tid; idx < 16384; idx += NTHR) { const int k = idx >> 4, j = idx & 15; wg[k * 17 + j] = g0[k] * W[(size_t)k * EVEN_IN + 5120 + j]; } }
    __syncthreads();
    const GAS float* x = inp(F, 0); const GAS float* g0 = inp(F, 1); const GAS float* gb = inp(F, 4);
    GAS bf16_t* U0 = WSP(bf16_t, WS_U0); GAS float* rs0 = WSP(float, WS_RS0); GAS float* gates = WSP(float, WS_GATES);
    for (int task = F.wave * F.G + F.vcu; task < M / 16; task += NGW) {
        const int i = F.lane & 15, kk = F.lane >> 4; const int row = task * 16 + i;
        const GAS float* xr = x + (size_t)row * 1024 + 4 * kk; GAS bf16_t* ur = U0 + (size_t)row * 1024 + 4 * kk;
        f32x4 acc = {0.f, 0.f, 0.f, 0.f}; float ss = 0.f;
#pragma unroll 4
        for (int s = 0; s < 64; ++s) {
            const f32x4 xv = *(const GAS f32x4*)(xr + 16 * s); const f32x4 gv = *(const GAS f32x4*)(g0 + 16 * s + 4 * kk);
            ss += (xv[0] * xv[0] + xv[1] * xv[1]) + (xv[2] * xv[2] + xv[3] * xv[3]);
            u32x2 w; w.x = cvt_pk_bf16(xv[0] * gv[0], xv[1] * gv[1]); w.y = cvt_pk_bf16(xv[2] * gv[2], xv[3] * gv[3]); *(GAS u32x2*)(ur + 16 * s) = w;
#pragma unroll
            for (int e = 0; e < 4; ++e) { const float bv = wg[(16 * s + 4 * kk + e) * 17 + i]; acc = __builtin_amdgcn_mfma_f32_16x16x4f32(xv[e], bv, acc, 0, 0, 0); }
        }
        ss += __shfl_xor(ss, 16); ss += __shfl_xor(ss, 32);
        const float r = 1.0f / sqrtf(ss * (1.f / 1024.f) + RMS_EPS);
        if (kk == 0) rs0[row] = r;
        const int j = i, gi = j >> 2, hh = j & 3; const float bias = gb[j];
        f32x4 gv;
#pragma unroll
        for (int reg = 0; reg < 4; ++reg) { const float rr = __shfl(r, 4 * kk + reg); float g = acc[reg] * rr + bias; if (gi & 1) g = logsigmoidf_(g); gv[reg] = g; }
        const int row0 = task * 16 + 4 * kk; const int b = row0 >> 13, t = row0 & 8191;
        *(GAS f32x4*)(gates + ((size_t)((gi * 2 + b) * 4 + hh)) * 8192 + t) = gv;
    }
}

constexpr int L_TAB = 0, L_KIMG = 16384, L_VIMG = 50176, L_CIMG = 66560;
constexpr int T_IGF = 0, T_LFF = 256, T_IGB = 512, T_LFB = 768, T_BF = 1024, T_CB = 1280, T_X0 = 1536, T_X1 = 1792, T_X2 = 2048, T_X3 = 2304, T_AF2 = 3072, T_AB2 = 3328, T_NF = 3584, T_NB = 3840;
__device__ __forceinline__ void gate_tables(LAS float* T, const GAS float* gates, int b, int h, int c, int tid) {
    if (tid < 256) {
#pragma unroll
        for (int gi = 0; gi < 4; ++gi) T[gi * 256 + tid] = gates[((size_t)((gi * 2 + b) * 4 + h)) * 8192 + c * 256 + tid]; }
    __syncthreads();
    if (tid < 256) { float s = 0.f; for (int j = 0; j <= tid; ++j) s += T[T_LFF + j]; T[T_BF + tid] = s; }
    else { const int t = tid - 256; float s = 0.f; for (int j = 255; j >= t; --j) s += T[T_LFB + j]; T[T_CB + t] = s; }
    __syncthreads();
}
#define GLD8(base, boff) (*(const GAS bf16x8*)((const GAS char*)(base) + (size_t)(unsigned)(boff)))
#define GP16(base, boff) (*(GAS bf16_t*)((GAS char*)(base) + (size_t)(unsigned)(boff)))
#define GPC16(base, boff) (*(const GAS bf16_t*)((const GAS char*)(base) + (size_t)(unsigned)(boff)))
__device__ __forceinline__ void stage_k256(LAS unsigned char* L, const GAS bf16_t* src, int ld, unsigned kgo, unsigned klo) {
#pragma unroll
    for (int i = 0; i < 4; ++i) *(LAS bf16x8*)(L + L_KIMG + klo + i * (16 * 528)) = GLD8(src + (size_t)(16 * i) * ld, kgo);
}
__device__ __forceinline__ void x1_unit(Frame& F, const Args& A_, int unit) {
    const int bh = unit >> 5, c = unit & 31, b = bh >> 2, h = bh & 3;
    int tid = F.tid; asm volatile("" : "+v"(tid)); const int lane = tid & 63, wave = F.wave, r32 = lane & 31, hi = lane >> 5;
    LAS unsigned char* L = F.lds; LAS float* T = (LAS float*)(L + L_TAB);
    const size_t grow0 = (size_t)b * SEQ + c * 256;
    const GAS bf16_t* kb = WSP(bf16_t, WS_A1) + ((size_t)h * M + grow0) * 256; const GAS bf16_t* vb = WSP(bf16_t, WS_A2) + ((size_t)h * M + grow0) * 256;
    GAS bf16_t* states = (GAS bf16_t*)F.out; GAS float* nst = WSP(float, WS_NST); GAS float* chsc = WSP(float, WS_CHSC);
    LAUNDER_S(kb); LAUNDER_S(vb); LAUNDER_S(states); LAUNDER_S(nst);
    gate_tables(T, WSP(float, WS_GATES), b, h, c, tid);
    const float Gf = T[T_BF + 255], Gb = T[T_CB + 0];
    if (tid < 256) { T[T_X0 + tid] = Gf - T[T_BF + tid] + T[T_IGF + tid]; T[T_X1 + tid] = Gb - T[T_CB + tid] + T[T_IGB + tid]; }
    __syncthreads();
    float mlf = -1e30f, mlb = -1e30f;
    for (int j = 0; j < 256; ++j) { mlf = fmaxf(mlf, T[T_X0 + j]); mlb = fmaxf(mlb, T[T_X1 + j]); }
    __syncthreads();
    if (tid < 256) { T[T_X2 + tid] = expf(T[T_X0 + tid] - mlf); T[T_X3 + tid] = expf(T[T_X1 + tid] - mlb); }
    if (tid == 0) { GAS float* p = chsc + (size_t)((0 * 8 + bh) * 32 + c) * 4; p[0] = Gf; p[1] = mlf; GAS float* q = chsc + (size_t)((1 * 8 + bh) * 32 + c) * 4; q[0] = Gb; q[1] = mlb; }
    __syncthreads();
    const int sr = tid >> 4, sc8 = (tid & 15) * 8;
    const unsigned go = (unsigned)(sr * 256 + sc8) * 2u; const unsigned lo0 = (unsigned)v_st(sr, sc8), lo1 = (unsigned)v_st(32 + sr, sc8);
    LAS unsigned char* rdk = L + L_KIMG + v_rd_base(lane); LAS unsigned char* rdv = L + L_VIMG + (wave >> 2) * 16384 + (wave & 3) * 512 + v_rd_base(lane);
#pragma unroll 1
    for (int dir = 0; dir < 2; ++dir) {
        f32x16 acc[8];
#pragma unroll
        for (int j = 0; j < 8; ++j) acc[j] = f32x16{};
        float dn = 0.f; const int wofs = dir ? T_X3 : T_X2;
#pragma unroll 1
        for (int t4 = 0; t4 < 4; ++t4) {
            const GAS bf16_t* kt = kb + (size_t)(t4 * 64) * 256; const GAS bf16_t* vt = vb + (size_t)(t4 * 64) * 256;
#pragma unroll
            for (int half = 0; half < 2; ++half)
#pragma unroll
                for (int q = 0; q < 2; ++q) {
                    const bf16x8 kv = GLD8(kt + (size_t)(32 * q) * 256 + half * 128, go);
                    const bf16x8 vv = GLD8(vt + (size_t)(32 * q) * 256 + half * 128, go);
                    const float w = T[wofs + t4 * 64 + sr + 32 * q];
                    u32x4 pv; pv.x = cvt_pk_bf16(bf2f(vv[0]) * w, bf2f(vv[1]) * w); pv.y = cvt_pk_bf16(bf2f(vv[2]) * w, bf2f(vv[3]) * w); pv.z = cvt_pk_bf16(bf2f(vv[4]) * w, bf2f(vv[5]) * w); pv.w = cvt_pk_bf16(bf2f(vv[6]) * w, bf2f(vv[7]) * w);
                    *(LAS bf16x8*)(L + L_KIMG + half * 16384 + (q ? lo1 : lo0)) = kv;
                    *(LAS u32x4*)(L + L_VIMG + half * 16384 + (q ? lo1 : lo0)) = pv; }
            __syncthreads();
#pragma unroll
            for (int ks = 0; ks < 4; ++ks) { const bf16x8 Af = tr_frag(rdv, 0, ks);
#pragma unroll
                for (int j = 0; j < 8; ++j) { const bf16x8 Bf = tr_frag(rdk + (j >> 2) * 16384, j & 3, ks); acc[j] = __builtin_amdgcn_mfma_f32_32x32x16_bf16(Af, Bf, acc[j], 0, 0, 0); } }
            if (tid < 256) { const int k = tid; LAS unsigned char* kp = L + L_KIMG + (k >> 7) * 16384 + (((k & 127) >> 5) * 512 + (k & 31) * 2);
#pragma unroll 8
                for (int key = 0; key < 64; ++key) { const int kk = (key & ~0xC) | ((key & 4) << 1) | ((key & 8) >> 1);
                    dn += T[wofs + t4 * 64 + key] * bf2f(*(LAS bf16_t*)(kp + (kk >> 3) * 2048 + (kk & 7) * 64)); } }
            __syncthreads();
        }
        GAS bf16_t* dst = states + (size_t)((dir * 8 + bh) * 32 + c) * 65536 + (size_t)(32 * wave) * 256;
        const unsigned so = (unsigned)(4 * hi * 256 + r32) * 2u;
#pragma unroll
        for (int r = 0; r < 16; ++r) {
#pragma unroll
            for (int j = 0; j < 8; ++j) GP16(dst, so + ((r & 3) + 8 * (r >> 2)) * 512 + 64 * j) = f2b(acc[j][r]);
            if ((r & 3) == 3) asm volatile("" ::: "memory"); }
        if (tid < 256) nst[(size_t)((dir * 8 + bh) * 32 + c) * 256 + tid] = dn;
    }
    __syncthreads();
}
__device__ __forceinline__ void x2_scan(Frame& F) {
    const int bid = F.vcu, tid = F.tid; LAS float* T = (LAS float*)(F.lds);
    GAS bf16_t* states = (GAS bf16_t*)F.out; GAS float* nst = WSP(float, WS_NST); GAS float* chsc = WSP(float, WS_CHSC);
#pragma unroll 1
    for (int blk = bid; blk < 256; blk += F.G) {
        const int chain = blk >> 4, dir = chain >> 3; const bool first = (blk & 15) == 0;
        if (tid == 0) { float m = -1e30f;
            for (int i = 0; i < 32; ++i) { const int c = dir ? 31 - i : i; GAS float* p = chsc + (size_t)(chain * 32 + c) * 4; const float G = p[0], ml = p[1];
                if (first) p[2] = m; const float mo = fmaxf(G + m, ml); T[i] = expf(G + m - mo); T[32 + i] = expf(ml - mo); m = mo; } }
        __syncthreads();
        const unsigned e8 = (unsigned)((blk & 15) * 512 + tid) * 16u;
        float st[8];
#pragma unroll
        for (int j = 0; j < 8; ++j) st[j] = 0.f;
        GAS bf16_t* cb = states + (size_t)(chain * 32) * 65536;
#pragma unroll 4
        for (int i = 0; i < 32; ++i) { const int c = dir ? 31 - i : i; GAS bf16_t* p = (GAS bf16_t*)((GAS char*)(cb + (size_t)c * 65536) + (size_t)e8);
            const bf16x8 d = *(const GAS bf16x8*)p; const float so = T[i], sw = T[32 + i];
            u32x4 w; w.x = cvt_pk_bf16(st[0], st[1]); w.y = cvt_pk_bf16(st[2], st[3]); w.z = cvt_pk_bf16(st[4], st[5]); w.w = cvt_pk_bf16(st[6], st[7]); *(GAS u32x4*)p = w;
#pragma unroll
            for (int j = 0; j < 8; ++j) st[j] = so * st[j] + sw * bf2f(d[j]); }
        if (first && tid < 256) { float sn = 0.f;
            for (int i = 0; i < 32; ++i) { const int c = dir ? 31 - i : i; GAS float* p = nst + (size_t)(chain * 32 + c) * 256 + tid; const float d = *p; *p = sn; sn = T[i] * sn + T[32 + i] * d; } }
        __syncthreads();
    }
}
template <int NK> __device__ __forceinline__ void st_tile(f32x16& p0, f32x16& p1, LAS unsigned char* kp, const bf16x8* qr) {
    p0 = f32x16{}; p1 = f32x16{};
#pragma unroll
    for (int d0 = 0; d0 < NK; ++d0) { const bf16x8 b0 = *(const LAS bf16x8*)(kp + 32 * d0), b1 = *(const LAS bf16x8*)(kp + 32 * 528 + 32 * d0);
        p0 = __builtin_amdgcn_mfma_f32_32x32x16_bf16(b0, qr[d0], p0, 0, 0, 0); p1 = __builtin_amdgcn_mfma_f32_32x32x16_bf16(b1, qr[d0], p1, 0, 0, 0); }
}
__device__ __forceinline__ void x3_unit(Frame& F, const Args& A_, int unit) {
    const int bh = unit >> 5, c = unit & 31, b = bh >> 2, h = bh & 3;
    int tid = F.tid; asm volatile("" : "+v"(tid)); const int lane = tid & 63, wave = F.wave, r32 = lane & 31, hi = lane >> 5;
    LAS unsigned char* L = F.lds; LAS float* T = (LAS float*)(L + L_TAB);
    const size_t grow0 = (size_t)b * SEQ + c * 256;
    const GAS bf16_t* qb = WSP(bf16_t, WS_A0) + ((size_t)h * M + grow0) * 256; const GAS bf16_t* kb = WSP(bf16_t, WS_A1) + ((size_t)h * M + grow0) * 256;
    const GAS bf16_t* vb = WSP(bf16_t, WS_A2) + ((size_t)h * M + grow0) * 256; const GAS bf16_t* gb = WSP(bf16_t, WS_A3) + ((size_t)h * M + grow0 + 32 * wave) * 256;
    const GAS bf16_t* states = (const GAS bf16_t*)F.out; const GAS float* nst = WSP(float, WS_NST); const GAS float* chsc = WSP(float, WS_CHSC);
    GAS bf16_t* mb0 = WSP(bf16_t, WS_MIX0) + (grow0 + 32 * wave) * 2048 + h * 256;
    const GAS float* ng = inp(F, 6) + h * 256;
    LAUNDER_S(qb); LAUNDER_S(kb); LAUNDER_S(vb); LAUNDER_S(gb); LAUNDER_S(mb0); LAUNDER_S(states);
    gate_tables(T, WSP(float, WS_GATES), b, h, c, tid);
    if (tid < 256) { T[T_X0 + tid] = T[T_IGF + tid] - T[T_BF + tid]; T[T_NF + tid] = nst[(size_t)((0 * 8 + bh) * 32 + c) * 256 + tid]; }
    else { const int t = tid - 256; T[T_X1 + t] = T[T_IGB + t] - T[T_CB + t]; T[T_NB + t] = nst[(size_t)((1 * 8 + bh) * 32 + c) * 256 + t]; }
    const float mf = chsc[(size_t)((0 * 8 + bh) * 32 + c) * 4 + 2], mb = chsc[(size_t)((1 * 8 + bh) * 32 + c) * 4 + 2];
    __syncthreads();
    if (tid < 256) { float m = mf; for (int j = 0; j <= tid; ++j) m = fmaxf(m, T[T_X0 + j]); T[T_X2 + tid] = m; }
    else { const int t = tid - 256; float m = mb; for (int j = 255; j >= t; --j) m = fmaxf(m, T[T_X1 + j]); T[T_X3 + t] = m; }
    __syncthreads();
    const int tq = 32 * wave + r32;
    bf16x8 qr[16];
    { const unsigned qo = (unsigned)(tq * 256 + 8 * hi) * 2u;
#pragma unroll
      for (int d0 = 0; d0 < 16; ++d0) qr[d0] = GLD8(qb + 16 * d0, qo); }
    const float Rf = T[T_X2 + tq], Rb = T[T_X3 + tq];
    float denf = 0.f, denb = 0.f;
#pragma unroll 1
    for (int j = 0; j < 4; ++j) {
        int t_ = tid; asm volatile("" : "+v"(t_));
        const unsigned kgo = (unsigned)((t_ >> 5) * 256 + (t_ & 31) * 8) * 2u, klo = (unsigned)((t_ >> 5) * 528 + (t_ & 31) * 16);
        LAS unsigned char* kp = L + L_KIMG + (t_ & 31) * 528 + 16 * ((t_ >> 5) & 1);
        stage_k256(L, kb + (size_t)(64 * j) * 256, 256, kgo, klo);
        __syncthreads();
        f32x16 p0, p1; st_tile<16>(p0, p1, kp, qr);
        LAS float* tf = T + T_X0 + 64 * j + 4 * hi; LAS float* tb = T + T_X1 + 64 * j + 4 * hi; const int sb0 = 64 * j + 4 * hi;
#pragma unroll
        for (int r = 0; r < 16; ++r) { const int cr = (r & 3) + 8 * (r >> 2);
            const float uf0 = tf[cr], uf1 = tf[cr + 32], ub0 = tb[cr], ub1 = tb[cr + 32];
            const float ef0 = fexp(uf0 - Rf), ef1 = fexp(uf1 - Rf), eb0 = fexp(ub0 - Rb), eb1 = fexp(ub1 - Rb);
            const int s0 = sb0 + cr, s1 = s0 + 32;
            denf += ((s0 <= tq) ? ef0 : 0.f) * p0[r] + ((s1 <= tq) ? ef1 : 0.f) * p1[r];
            denb += ((s0 >= tq) ? eb0 : 0.f) * p0[r] + ((s1 >= tq) ? eb1 : 0.f) * p1[r];
            if ((r & 3) == 3) asm volatile("" ::: "memory"); }
        __syncthreads();
    }
    denf = swap_add(denf); denb = swap_add(denb);
    float nqf = 0.f, nqb = 0.f;
#pragma unroll
    for (int d0 = 0; d0 < 16; ++d0) {
#pragma unroll
        for (int jj = 0; jj < 8; ++jj) { const float qv = bf2f(qr[d0][jj]); nqf += qv * T[T_NF + 16 * d0 + 8 * hi + jj]; nqb += qv * T[T_NB + 16 * d0 + 8 * hi + jj]; }
        asm volatile("" ::: "memory"); }
    nqf = swap_add(nqf); nqb = swap_add(nqb);
    float sf, sb;
    { const float ef = fexp(mf - Rf), eb = fexp(mb - Rb);
      const float dtf = ef * nqf + denf, dtb = eb * nqb + denb;
      sf = 1.f / fmaxf(fabsf(dtf), expf(-T[T_BF + tq] - Rf)); sb = 1.f / fmaxf(fabsf(dtb), expf(-T[T_CB + tq] - Rb));
      if (hi == 0) { T[T_AF2 + tq] = ef * sf; T[T_AB2 + tq] = eb * sb; } }
    __syncthreads();
#pragma unroll 1
    for (int dvh = 0; dvh < 2; ++dvh) {
        int t_ = tid; asm volatile("" : "+v"(t_));
        const unsigned kgo = (unsigned)((t_ >> 5) * 256 + (t_ & 31) * 8) * 2u, klo = (unsigned)((t_ >> 5) * 528 + (t_ & 31) * 16);
        LAS unsigned char* kp = L + L_KIMG + (t_ & 31) * 528 + 16 * ((t_ >> 5) & 1);
        LAS unsigned char* rdv = L + L_VIMG + v_rd_base(t_ & 63);
        LAS unsigned char* cp = L + L_CIMG + (t_ & 31) * 528 + 16 * ((t_ >> 5) & 1);
        const unsigned vgo = (unsigned)((t_ >> 4) * 256 + (t_ & 15) * 8) * 2u, vlo0 = (unsigned)v_st(t_ >> 4, (t_ & 15) * 8), vlo1 = (unsigned)v_st(32 + (t_ >> 4), (t_ & 15) * 8);
        const unsigned cgo = (unsigned)((t_ >> 5) * 256 + (t_ & 31) * 8) * 2u;
        f32x16 o[4];
#pragma unroll
        for (int d = 0; d < 4; ++d) o[d] = f32x16{};
#pragma unroll 1
        for (int dir = 0; dir < 2; ++dir) {
            const GAS bf16_t* cs = states + (size_t)((dir * 8 + bh) * 32 + c) * 65536 + (size_t)(128 * dvh) * 256;
#pragma unroll
            for (int i = 0; i < 8; ++i) *(LAS bf16x8*)(L + L_CIMG + klo + i * (16 * 528)) = GLD8(cs + (size_t)(16 * i) * 256, cgo);
            __syncthreads();
            LAS float* ta = T + (dir ? T_AB2 : T_AF2) + 32 * wave + 4 * hi;
#pragma unroll
            for (int d = 0; d < 4; ++d) { f32x16 tmp = f32x16{};
#pragma unroll
                for (int d0 = 0; d0 < 16; ++d0) { const bf16x8 Bf = *(const LAS bf16x8*)(cp + d * (32 * 528) + 32 * d0); tmp = __builtin_amdgcn_mfma_f32_32x32x16_bf16(qr[d0], Bf, tmp, 0, 0, 0); }
#pragma unroll
                for (int r = 0; r < 16; ++r) o[d][r] += tmp[r] * ta[(r & 3) + 8 * (r >> 2)]; }
            __syncthreads();
        }
#pragma unroll 1
        for (int j = 0; j < 4; ++j) {
            stage_k256(L, kb + (size_t)(64 * j) * 256, 256, kgo, klo);
            { const GAS bf16_t* vt = vb + (size_t)(64 * j) * 256 + 128 * dvh;
              *(LAS bf16x8*)(L + L_VIMG + vlo0) = GLD8(vt, vgo); *(LAS bf16x8*)(L + L_VIMG + vlo1) = GLD8(vt + (size_t)32 * 256, vgo); }
            __syncthreads();
            f32x16 p0, p1; st_tile<16>(p0, p1, kp, qr);
            LAS float* tf = T + T_X0 + 64 * j + 4 * hi; LAS float* tb = T + T_X1 + 64 * j + 4 * hi; const int sb0 = 64 * j + 4 * hi;
#pragma unroll
            for (int r = 0; r < 16; ++r) { const int cr = (r & 3) + 8 * (r >> 2);
                const float uf0 = tf[cr], uf1 = tf[cr + 32], ub0 = tb[cr], ub1 = tb[cr + 32];
                const float ef0 = fexp(uf0 - Rf) * sf, ef1 = fexp(uf1 - Rf) * sf, eb0 = fexp(ub0 - Rb) * sb, eb1 = fexp(ub1 - Rb) * sb;
                const int s0 = sb0 + cr, s1 = s0 + 32;
                p0[r] *= ((s0 <= tq) ? ef0 : 0.f) + ((s0 >= tq) ? eb0 : 0.f);
                p1[r] *= ((s1 <= tq) ? ef1 : 0.f) + ((s1 >= tq) ? eb1 : 0.f);
                if ((r & 3) == 3) asm volatile("" ::: "memory"); }
            bf16x8 pa0, pa1, pa2, pa3;
            PK4(p0, 0, pa0); PK4(p0, 8, pa1); PK4(p1, 0, pa2); PK4(p1, 8, pa3);
#pragma unroll
            for (int d = 0; d < 4; ++d) {
                o[d] = __builtin_amdgcn_mfma_f32_32x32x16_bf16(pa0, tr_frag(rdv, d, 0), o[d], 0, 0, 0);
                o[d] = __builtin_amdgcn_mfma_f32_32x32x16_bf16(pa1, tr_frag(rdv, d, 1), o[d], 0, 0, 0);
                o[d] = __builtin_amdgcn_mfma_f32_32x32x16_bf16(pa2, tr_frag(rdv, d, 2), o[d], 0, 0, 0);
                o[d] = __builtin_amdgcn_mfma_f32_32x32x16_bf16(pa3, tr_frag(rdv, d, 3), o[d], 0, 0, 0); }
            __syncthreads();
        }
        int l_ = lane; asm volatile("" : "+v"(l_));
        const unsigned oo = (unsigned)(4 * (l_ >> 5) * 2048 + (l_ & 31)) * 2u, go_ = (unsigned)(4 * (l_ >> 5) * 256 + (l_ & 31)) * 2u;
        if (dvh == 0) {
#pragma unroll
            for (int r = 0; r < 16; ++r) { unsigned ro = oo + ((r & 3) + 8 * (r >> 2)) * 4096; asm volatile("" : "+v"(ro));
#pragma unroll
                for (int d = 0; d < 4; ++d) GP16(mb0, ro + 64 * d) = f2b(o[d][r]);
                if ((r & 3) == 3) asm volatile("" ::: "memory"); }
        } else {
            asm volatile("s_waitcnt vmcnt(0)" ::: "memory");
#pragma unroll
            for (int r = 0; r < 16; ++r) { unsigned ro = oo + ((r & 3) + 8 * (r >> 2)) * 4096, rg = go_ + ((r & 3) + 8 * (r >> 2)) * 512; asm volatile("" : "+v"(ro), "+v"(rg));
                float h0[4]; float s = (o[0][r] * o[0][r] + o[1][r] * o[1][r]) + (o[2][r] * o[2][r] + o[3][r] * o[3][r]);
#pragma unroll
                for (int d = 0; d < 4; ++d) { h0[d] = bf2f(GP16(mb0, ro + 64 * d)); s += h0[d] * h0[d]; }
                s += __shfl_xor(s, 1); s += __shfl_xor(s, 2); s += __shfl_xor(s, 4); s += __shfl_xor(s, 8); s += __shfl_xor(s, 16);
                const float rinv = 1.0f / sqrtf(s * (1.f / 256.f) + RMS_EPS);
#pragma unroll
                for (int d = 0; d < 4; ++d) {
                    GP16(mb0, ro + 256 + 64 * d) = f2b(o[d][r] * rinv * ng[128 + 32 * d + r32] * bf2f(GPC16(gb, rg + 256 + 64 * d)));
                    GP16(mb0, ro + 64 * d) = f2b(h0[d] * rinv * ng[32 * d + r32] * bf2f(GPC16(gb, rg + 64 * d))); }
                asm volatile("" ::: "memory"); }
        }
    }
    __syncthreads();
}

constexpr int L_BT = 83968, L_MT = L_BT + 4 * 15 * 128 * 4;
template <int QB> __device__ __forceinline__ void na_scores(f32x16& p0, f32x16& p1, LAS unsigned char* bt, LAS unsigned char* mt, float& m, float& l, float& alpha, bool first) {
    float pmax = -1e30f;
#pragma unroll
    for (int rr = 0; rr < 16; ++rr) { const int cr = (rr & 3) + 8 * (rr >> 2);
        if (QB == 1 && rr < 8) { } else { p0[rr] = (p0[rr] + *(LAS float*)(bt + 4 * cr)) + *(LAS float*)(mt + 4 * cr); pmax = fmaxf(pmax, p0[rr]); }
        if (QB == 0 && rr >= 8) { } else { p1[rr] = (p1[rr] + *(LAS float*)(bt + 4 * (cr + 32))) + *(LAS float*)(mt + 4 * (cr + 32)); pmax = fmaxf(pmax, p1[rr]); } }
    pmax = swap_max(pmax);
    if (first) { m = pmax; alpha = 1.f; }
    else if (__builtin_expect(__all(pmax - m <= 8.f), 1)) { alpha = 1.f; }
    else { const float mn = fmaxf(m, pmax); alpha = fexp(m - mn); m = mn; }
    const float nm = -m * 1.4426950408889634f;
    float ps = 0.f;
#pragma unroll
    for (int rr = 0; rr < 16; ++rr) {
        if (QB == 1 && rr < 8) { } else { p0[rr] = __builtin_amdgcn_exp2f(fmaf(p0[rr], 1.4426950408889634f, nm)); ps += p0[rr]; }
        if (QB == 0 && rr >= 8) { } else { p1[rr] = __builtin_amdgcn_exp2f(fmaf(p1[rr], 1.4426950408889634f, nm)); ps += p1[rr]; } }
    ps = swap_add(ps); l = l * alpha + ps;
}
template <bool LOADS, bool STORE> __device__ __forceinline__ void na_phase(Frame& F, const Args& A_) {
#ifdef PROBE_NAMAP
    const int cu = blockIdx.x;
#else
    const int cu = F.vcu;
#endif
    if (cu >= 256) return;
    const int b = cu >> 7, r = cu & 127;
    int tid = F.tid; asm volatile("" : "+v"(tid)); const int lane = tid & 63, wave = F.wave, r32 = lane & 31, hi = lane >> 5;
    LAS unsigned char* L = F.lds; LAS float* wsf = (LAS float*)(L + 8192) + wave * 64;
    const GAS float* rpb = inp(F, 7);
    const int hd = wave >> 1, qb = wave & 1, cq = 32 * qb + r32;
    const int c0 = min(max(cq - 8, 0), 48), r0 = min(max(r - 4, 0), 120);
    const size_t rowq = (size_t)b * SEQ + r * 64;
    const GAS bf16_t* qbp = WSP(bf16_t, WS_A0) + (rowq + 32 * qb) * 256 + hd * 64;
    const GAS bf16_t* zbp = WSP(bf16_t, WS_A3) + (rowq + 32 * qb) * 256 + hd * 64;
    GAS bf16_t* obp = WSP(bf16_t, WS_MIX0) + (rowq + 32 * qb) * 2048 + 1024 + hd * 64;
    const GAS bf16_t* kbp = WSP(bf16_t, WS_A1) + ((size_t)b * SEQ + (size_t)r0 * 64) * 256;
    const GAS bf16_t* vbp = WSP(bf16_t, WS_A2) + ((size_t)b * SEQ + (size_t)r0 * 64) * 256;
    LAUNDER_S(qbp); LAUNDER_S(zbp); LAUNDER_S(obp); LAUNDER_S(kbp); LAUNDER_S(vbp);
    LAS unsigned char* rdv = L + L_VIMG + (hd >> 1) * 16384 + (2 * (hd & 1)) * 512 + v_rd_base(lane);
    LAS unsigned char* kp = L + L_KIMG + r32 * 528 + 128 * hd + 16 * hi;
    LAS unsigned char* bt0 = L + L_BT + (hd * 15 * 128 + 63 - cq + 4 * hi) * 4;
    LAS unsigned char* mt = L + L_MT + (48 - c0 + 4 * hi) * 4;
    const unsigned kgo = (unsigned)((tid >> 5) * 256 + (tid & 31) * 8) * 2u, klo = (unsigned)((tid >> 5) * 528 + (tid & 31) * 16);
    unsigned vlo[4];
#pragma unroll
    for (int q = 0; q < 4; ++q) { const int key = (tid >> 5) + 16 * q, col8 = (tid & 31) * 8; vlo[q] = (unsigned)((col8 >> 7) * 16384 + v_st(key, col8 & 127)); }
    bf16x8 kst[4], vst[4];
#define NA_FETCH(s_) do { const int hg_ = (s_) >> 3, t_ = (s_) & 7; const GAS bf16_t* kt_ = kbp + (size_t)hg_ * ((size_t)M * 256) + (size_t)(64 * t_) * 256; const GAS bf16_t* vt_ = vbp + (size_t)hg_ * ((size_t)M * 256) + (size_t)(64 * t_) * 256; \
        _Pragma("unroll") for (int q = 0; q < 4; ++q) { kst[q] = GLD8(kt_ + (size_t)(16 * q) * 256, kgo); vst[q] = GLD8(vt_ + (size_t)(16 * q) * 256, kgo); } } while (0)
#define NA_WRITE() do { _Pragma("unroll") for (int q = 0; q < 4; ++q) { *(LAS bf16x8*)(L + L_KIMG + klo + q * (16 * 528)) = kst[q]; *(LAS bf16x8*)(L + L_VIMG + vlo[q]) = vst[q]; } } while (0)
#define NA_BIAS(hg_) do { for (int idx = tid; idx < 4 * 15 * 128; idx += NTHR) { const int x = idx & 127, hr = idx >> 7; \
        ((LAS float*)(L + L_BT))[idx] = ((unsigned)(x - 48) < 31u) ? rpb[(size_t)((hg_) * 60 + hr) * 31 + (x - 48)] : 0.f; } } while (0)
    NA_FETCH(0);
    if (tid < 128) ((LAS float*)(L + L_MT))[tid] = ((unsigned)(tid - 48) < 16u) ? 0.f : -1e30f;
    NA_BIAS(0);
    __syncthreads();
    NA_WRITE();
    __syncthreads();
    bf16x8 qr[4]; float m = -1e30f, l = 0.f; f32x16 o[2]; o[0] = f32x16{}; o[1] = f32x16{};
#pragma unroll 1
    for (int s = 0; s < 32; ++s) {
        const int hg = s >> 3, i = s & 7;
        if (i == 0) { const unsigned qo = (unsigned)(r32 * 256 + 8 * hi) * 2u;
#pragma unroll
            for (int d0 = 0; d0 < 4; ++d0) qr[d0] = GLD8(qbp + (size_t)hg * ((size_t)M * 256) + 16 * d0, qo);
            l = 0.f; o[0] = f32x16{}; o[1] = f32x16{}; }
        if (LOADS && s + 1 < 32) NA_FETCH(s + 1);
        f32x16 p0, p1; st_tile<4>(p0, p1, kp, qr);
        const int dr = r0 + i - r + 7; LAS unsigned char* bt = bt0 + dr * 512;
        float alpha; bf16x8 pa0, pa1, pa2, pa3;
        if (qb == 0) { na_scores<0>(p0, p1, bt, mt, m, l, alpha, i == 0); PK4(p0, 0, pa0); PK4(p0, 8, pa1); PK4(p1, 0, pa2); }
        else         { na_scores<1>(p0, p1, bt, mt, m, l, alpha, i == 0); PK4(p0, 8, pa1); PK4(p1, 0, pa2); PK4(p1, 8, pa3); }
        if (__any(alpha < 1.f)) { if (hi == 0) wsf[r32] = alpha;
#pragma unroll
            for (int d = 0; d < 2; ++d)
#pragma unroll
                for (int rr = 0; rr < 16; ++rr) o[d][rr] *= wsf[crow(rr, hi)]; }
#pragma unroll
        for (int d = 0; d < 2; ++d) {
            if (qb == 1) { } else o[d] = __builtin_amdgcn_mfma_f32_32x32x16_bf16(pa0, tr_frag(rdv, d, 0), o[d], 0, 0, 0);
            o[d] = __builtin_amdgcn_mfma_f32_32x32x16_bf16(pa1, tr_frag(rdv, d, 1), o[d], 0, 0, 0);
            o[d] = __builtin_amdgcn_mfma_f32_32x32x16_bf16(pa2, tr_frag(rdv, d, 2), o[d], 0, 0, 0);
            if (qb == 0) { } else o[d] = __builtin_amdgcn_mfma_f32_32x32x16_bf16(pa3, tr_frag(rdv, d, 3), o[d], 0, 0, 0); }
        if (STORE && i == 7) {
            if (hi == 0) wsf[32 + r32] = l;
            const unsigned zo = (unsigned)(4 * hi * 256 + r32) * 2u, oo = (unsigned)(4 * hi * 2048 + r32) * 2u + 512u * hg; const GAS bf16_t* zh = zbp + (size_t)hg * ((size_t)M * 256);
#pragma unroll
            for (int rr = 0; rr < 16; ++rr) { const float rli = __builtin_amdgcn_rcpf(wsf[32 + crow(rr, hi)]); const int cr = (rr & 3) + 8 * (rr >> 2);
#pragma unroll
                for (int d = 0; d < 2; ++d) GP16(obp, oo + cr * 4096 + 64 * d) = f2b(o[d][rr] * rli * bf2f(GPC16(zh, zo + cr * 512 + 64 * d)));
                if ((rr & 3) == 3) asm volatile("" ::: "memory"); }
        }
        __syncthreads();
        if (LOADS && s + 1 < 32) { NA_WRITE(); if (i == 7) NA_BIAS(hg + 1); }
        __syncthreads();
    }
#undef NA_FETCH
#undef NA_WRITE
#undef NA_BIAS
}

__device__ __forceinline__ void p9_krope_conv(Frame& F, const Args& A_) {
    const int gw = F.vcu * NWAVES + F.wave, NGW = F.G * NWAVES, lane = F.lane;
    GAS bf16_t* gk = WSP(bf16_t, WS_GK); const GAS float* kng = inp(F, 11); const GAS float* ropeR = WSP(float, WS_ROPE); const GAS float* ropeC = ropeR + 8192;
    for (int row = gw; row < M; row += NGW) {
        const int hd = lane >> 5, i = lane & 31; GAS bf16_t* p = gk + ((size_t)hd * M + row) * 128 + i;
        float x[4]; float ss = 0.f;
#pragma unroll
        for (int e = 0; e < 4; ++e) { x[e] = bf2f(p[32 * e]); ss += x[e] * x[e]; }
        ss += __shfl_xor(ss, 1); ss += __shfl_xor(ss, 2); ss += __shfl_xor(ss, 4); ss += __shfl_xor(ss, 8); ss += __shfl_xor(ss, 16);
        const float rr = 1.0f / sqrtf(ss * (1.f / 128.f) + RMS_EPS);
#pragma unroll
        for (int e = 0; e < 4; ++e) x[e] = x[e] * rr * kng[32 * e + i];
        const int t = row & 8191, pr = t >> 6, pc = t & 63;
        const float cr = ropeR[(pr * 32 + i) * 2], sr = ropeR[(pr * 32 + i) * 2 + 1], cc = ropeC[(pc * 32 + i) * 2], sc = ropeC[(pc * 32 + i) * 2 + 1];
        p[0] = f2b(x[0] * cr - x[1] * sr); p[32] = f2b(x[0] * sr + x[1] * cr); p[64] = f2b(x[2] * cc - x[3] * sc); p[96] = f2b(x[2] * sc + x[3] * cc);
    }
    const GAS bf16_t* xc = WSP(bf16_t, WS_XC); const GAS bf16_t* cg = WSP(bf16_t, WS_CG); GAS bf16_t* mix1 = WSP(bf16_t, WS_MIX1); const GAS float* cw = inp(F, 12); const GAS float* cbv = inp(F, 13);
    const int gt = F.vcu * NTHR + F.tid, NGT = F.G * NTHR;
    for (int it = gt; it < M * 128; it += NGT) {
        const int row = it >> 7, c8 = (it & 127) * 8, t = row & 8191;
        const bf16x8 z8 = {0, 0, 0, 0, 0, 0, 0, 0};
        const bf16x8 x0 = *(const GAS bf16x8*)(xc + (size_t)row * 1024 + c8);
        const bf16x8 xm = t > 0 ? *(const GAS bf16x8*)(xc + (size_t)(row - 1) * 1024 + c8) : z8;
        const bf16x8 xp = t < SEQ - 1 ? *(const GAS bf16x8*)(xc + (size_t)(row + 1) * 1024 + c8) : z8;
        const bf16x8 g8 = *(const GAS bf16x8*)(cg + (size_t)row * 1024 + c8);
        float y[8];
#pragma unroll
        for (int j = 0; j < 8; ++j) y[j] = bf2f(g8[j]) * (bf2f(xm[j]) * cw[c8 + j] + bf2f(x0[j]) * cw[1024 + c8 + j] + bf2f(xp[j]) * cw[2048 + c8 + j] + cbv[c8 + j]);
        u32x4 w; w.x = cvt_pk_bf16(y[0], y[1]); w.y = cvt_pk_bf16(y[2], y[3]); w.z = cvt_pk_bf16(y[4], y[5]); w.w = cvt_pk_bf16(y[6], y[7]);
        *(GAS u32x4*)(mix1 + (size_t)row * 2048 + 1024 + c8) = w;
    }
}

namespace gqa {
constexpr int D = 128, NW = 8, QBLK = 32, KVBLK = 64, LDQ = 1024, LDK = 128;
constexpr float SCALE = 0.088388347648318440f;
constexpr float THR = 8.f;
constexpr size_t SHM_V = KVBLK * D * 2, SHM_K = KVBLK * D * 2;
#define KSWZ(row, colB) ((row) * 256 + ((colB) ^ (((row) & 7) << 4)))
#define SBAR() __builtin_amdgcn_sched_barrier(0)
__device__ __forceinline__ unsigned cvtpk(float lo, float hi) { unsigned r; asm volatile("v_cvt_pk_bf16_f32 %0, %1, %2" : "=v"(r) : "v"(lo), "v"(hi)); return r; }
__device__ __forceinline__ void partialSM(f32x16& p0, f32x16& p1, float& m_reg, float& mn, float& alpha) {
  constexpr float C = SCALE * 1.4426950408889634f;
  float pmax = p0[0]; for (int r = 1; r < 16; ++r) pmax = fmaxf(pmax, p0[r]); for (int r = 0; r < 16; ++r) pmax = fmaxf(pmax, p1[r]);
  { auto rr = __builtin_amdgcn_permlane32_swap(__float_as_uint(pmax), __float_as_uint(pmax), false, false);
    pmax = fmaxf(__uint_as_float(rr[0]), __uint_as_float(rr[1])); }
  if (__builtin_expect(__all(pmax - m_reg <= THR / SCALE), 1)) { mn = m_reg; alpha = 1.f; }
  else { mn = fmaxf(m_reg, pmax); alpha = __builtin_amdgcn_exp2f((m_reg - mn) * C); m_reg = mn; }
  float mnC = -mn * C;
  for (int r = 0; r < 16; ++r) p0[r] = fmaf(p0[r], C, mnC); for (int r = 0; r < 16; ++r) p1[r] = fmaf(p1[r], C, mnC);
  for (int r = 0; r < 16; ++r) p0[r] = __builtin_amdgcn_exp2f(p0[r]);
}
__device__ __forceinline__ void finishSM(f32x16& p0, f32x16& p1, float alpha, float& l_reg, bf16x8& pa0, bf16x8& pa1, bf16x8& pa2, bf16x8& pa3) {
  for (int r = 0; r < 16; ++r) p1[r] = __builtin_amdgcn_exp2f(p1[r]);
  float ps = 0; for (int r = 0; r < 16; ++r) ps += p0[r]; for (int r = 0; r < 16; ++r) ps += p1[r];
  { auto rr = __builtin_amdgcn_permlane32_swap(__float_as_uint(ps), __float_as_uint(ps), false, false);
    ps = __uint_as_float(rr[0]) + __uint_as_float(rr[1]); }
  l_reg = l_reg * alpha + ps;
#define GPK4(P, BASE, OUT) do { unsigned a0 = cvtpk(P[BASE + 0], P[BASE + 1]), a1 = cvtpk(P[BASE + 2], P[BASE + 3]);   \
    unsigned b0 = cvtpk(P[BASE + 4], P[BASE + 5]), b1 = cvtpk(P[BASE + 6], P[BASE + 7]);                              \
    auto r0 = __builtin_amdgcn_permlane32_swap(a0, b0, false, false); auto r1 = __builtin_amdgcn_permlane32_swap(a1, b1, false, false); \
    u32x4 w = {r0[0], r1[0], r0[1], r1[1]}; OUT = *reinterpret_cast<bf16x8*>(&w); } while (0)
  GPK4(p0, 0, pa0); GPK4(p0, 8, pa1); GPK4(p1, 0, pa2); GPK4(p1, 8, pa3);
#undef GPK4
}
__device__ __forceinline__ void qkt(f32x16& p0, f32x16& p1, const LAS bf16_t* Ks, const bf16x8* qr, int r32, int hi) {
  p0 = f32x16{}; p1 = f32x16{};
  for (int d0 = 0; d0 < 8; ++d0) { int cb = (d0 * 16 + hi * 8) * 2;
    bf16x8 b0 = *(const LAS bf16x8*)((const LAS char*)Ks + KSWZ(r32, cb));
    bf16x8 b1 = *(const LAS bf16x8*)((const LAS char*)Ks + KSWZ(32 + r32, cb));
    p0 = __builtin_amdgcn_mfma_f32_32x32x16_bf16(b0, qr[d0], p0, 0, 0, 0);
    p1 = __builtin_amdgcn_mfma_f32_32x32x16_bf16(b1, qr[d0], p1, 0, 0, 0); }
}
constexpr int v_rd_off(int d0, int ks, int half) { return d0 * 512 + ks * 4096 + half * 2048; }
template <int OFF> __device__ __forceinline__ s16x4 tr_read(int vb) {
  s16x4 r; asm volatile("ds_read_b64_tr_b16 %0, %1 offset:%2" : "=&v"(r) : "v"(vb), "i"(OFF) : "memory"); return r;
}
template <int D0> __device__ __forceinline__ void pv_one(f32x16& od, int vb, bf16x8 pa0, bf16x8 pa1, bf16x8 pa2, bf16x8 pa3) {
  const s16x4 l0 = tr_read<v_rd_off(D0, 0, 0)>(vb), h0 = tr_read<v_rd_off(D0, 0, 1)>(vb), l1 = tr_read<v_rd_off(D0, 1, 0)>(vb), h1 = tr_read<v_rd_off(D0, 1, 1)>(vb);
  const s16x4 l2 = tr_read<v_rd_off(D0, 2, 0)>(vb), h2 = tr_read<v_rd_off(D0, 2, 1)>(vb), l3 = tr_read<v_rd_off(D0, 3, 0)>(vb), h3 = tr_read<v_rd_off(D0, 3, 1)>(vb);
  asm volatile("s_waitcnt lgkmcnt(0)" ::: "memory"); SBAR();
#define PK(L, H) (bf16x8){L[0], L[1], L[2], L[3], H[0], H[1], H[2], H[3]}
  od = __builtin_amdgcn_mfma_f32_32x32x16_bf16(pa0, PK(l0, h0), od, 0, 0, 0);
  od = __builtin_amdgcn_mfma_f32_32x32x16_bf16(pa1, PK(l1, h1), od, 0, 0, 0);
  od = __builtin_amdgcn_mfma_f32_32x32x16_bf16(pa2, PK(l2, h2), od, 0, 0, 0);
  od = __builtin_amdgcn_mfma_f32_32x32x16_bf16(pa3, PK(l3, h3), od, 0, 0, 0);
#undef PK
}
__device__ __forceinline__ void pv_d0(f32x16* o, int vb, bf16x8 pa0, bf16x8 pa1, bf16x8 pa2, bf16x8 pa3) {
  pv_one<0>(o[0], vb, pa0, pa1, pa2, pa3); pv_one<1>(o[1], vb, pa0, pa1, pa2, pa3); pv_one<2>(o[2], vb, pa0, pa1, pa2, pa3); pv_one<3>(o[3], vb, pa0, pa1, pa2, pa3);
}
__device__ __forceinline__ void unit(const GAS bf16_t* __restrict__ GQ, const GAS bf16_t* __restrict__ Kh, const GAS bf16_t* __restrict__ Vh, const GAS bf16_t* __restrict__ GZ, GAS bf16_t* __restrict__ MIX,
                                     const GAS float* __restrict__ qng, const GAS float* __restrict__ ropeR, const GAS float* __restrict__ ropeC, int qrow0, int head, int seq, LAS char* lds, int tid_in) {
  int tid = tid_in; asm volatile("" : "+v"(tid)); const int wid = __builtin_amdgcn_readfirstlane(tid >> 6), lane = tid & 63, r32 = lane & 31, hi = lane >> 5;
  LAUNDER_S(Kh); LAUNDER_S(Vh); LAUNDER_S(GQ); LAUNDER_S(GZ); LAUNDER_S(MIX);
  LAS bf16_t* V_lds = (LAS bf16_t*)lds; LAS bf16_t* K_lds = (LAS bf16_t*)(lds + 2 * SHM_V);
  LAS float* ws = (LAS float*)(lds + 2 * SHM_V + 2 * SHM_K) + wid * 64; LAS float* li_l = ws; LAS float* al_l = ws + 32;
  float m_reg = -1e30f, l_reg = 0; f32x16 o[4] = {}; bf16x8 qr[8];
  {
    const int row = qrow0 + wid * QBLK + r32; const GAS bf16_t* qp_ = GQ + (size_t)(qrow0 + wid * QBLK) * LDQ + head * D; const unsigned qo_ = (unsigned)(r32 * LDQ + hi * 8) * 2u;
    bf16x8 v[8]; float ss = 0.f;
#pragma unroll
    for (int d0 = 0; d0 < 8; ++d0) { v[d0] = GLD8(qp_ + d0 * 16, qo_);
#pragma unroll
      for (int j = 0; j < 8; ++j) { const float f = bf2f(v[d0][j]); ss += f * f; } }
    ss = swap_add(ss);
    const float rq = 1.0f / sqrtf(ss * (1.f / 128.f) + RMS_EPS);
    const int t = row & 8191, pr = t >> 6, pc = t & 63;
#pragma unroll
    for (int ax = 0; ax < 2; ++ax)
#pragma unroll
      for (int dd = 0; dd < 2; ++dd) { const int da = 4 * ax + dd, db = da + 2; const GAS float* tb = ax ? ropeC + (size_t)pc * 64 : ropeR + (size_t)pr * 64;
        float o1[8], o2[8];
#pragma unroll
        for (int j = 0; j < 8; ++j) { const int i = 16 * dd + 8 * hi + j; const float c = tb[i * 2], s = tb[i * 2 + 1];
          const float x1 = bf2f(v[da][j]) * rq * qng[16 * da + 8 * hi + j], x2 = bf2f(v[db][j]) * rq * qng[16 * db + 8 * hi + j];
          o1[j] = x1 * c - x2 * s; o2[j] = x1 * s + x2 * c; }
        { u32x4 w = {cvt_pk_bf16(o1[0], o1[1]), cvt_pk_bf16(o1[2], o1[3]), cvt_pk_bf16(o1[4], o1[5]), cvt_pk_bf16(o1[6], o1[7])}; qr[da] = __builtin_bit_cast(bf16x8, w); }
        { u32x4 w = {cvt_pk_bf16(o2[0], o2[1]), cvt_pk_bf16(o2[2], o2[3]), cvt_pk_bf16(o2[4], o2[5]), cvt_pk_bf16(o2[6], o2[7])}; qr[db] = __builtin_bit_cast(bf16x8, w); }
        asm volatile("" ::: "memory"); }
  }
  const int sr = tid >> 4, sc = (tid & 15) * 8, vst0 = v_st(sr, sc), vst1 = v_st(32 + sr, sc);
  const int vb0 = (int)(unsigned)(uintptr_t)V_lds + v_rd_base(lane);
  struct { bf16x8 vs0, vs1, ks0, ks1; } sr_[1];
  const unsigned so0 = (unsigned)(sr * LDK + sc) * 2u, so1 = (unsigned)((32 + sr) * LDK + sc) * 2u;
#define SLOAD(i, k0) do { const GAS bf16_t* vt_ = Vh + (size_t)(k0) * LDK; const GAS bf16_t* kt_ = Kh + (size_t)(k0) * LDK; \
    sr_[i].vs0 = GLD8(vt_, so0); sr_[i].vs1 = GLD8(vt_, so1); sr_[i].ks0 = GLD8(kt_, so0); sr_[i].ks1 = GLD8(kt_, so1); } while (0)
#define SWRITE(b, i) do { *(LAS bf16x8*)((LAS char*)V_lds + (b) * SHM_V + vst0) = sr_[i].vs0;          \
    *(LAS bf16x8*)((LAS char*)V_lds + (b) * SHM_V + vst1) = sr_[i].vs1; int kc = sc * 2;               \
    *(LAS bf16x8*)((LAS char*)K_lds + (b) * SHM_K + KSWZ(sr, kc)) = sr_[i].ks0;                       \
    *(LAS bf16x8*)((LAS char*)K_lds + (b) * SHM_K + KSWZ(32 + sr, kc)) = sr_[i].ks1; } while (0)
#define SWAIT() asm volatile("s_waitcnt vmcnt(0)" ::: "memory")
#define RESC(a) do { if (__any((a) < 1.f)) { if (hi == 0) al_l[r32] = (a); asm volatile("s_waitcnt lgkmcnt(0)" ::: "memory"); \
    for (int d = 0; d < 4; ++d) for (int r = 0; r < 16; ++r) o[d][r] *= al_l[crow(r, hi)]; } } while (0)
  f32x16 pA0, pA1, pB0, pB1; float mnA, mnB, alA, alB; bf16x8 pa0, pa1, pa2, pa3; const int NT = seq / KVBLK;
  constexpr int SE = 0, SO = 0;
  SLOAD(SE, 0); asm volatile("s_waitcnt vmcnt(0)" ::: "memory"); SWRITE(0, SE); __syncthreads();
  qkt(pA0, pA1, K_lds, qr, r32, hi); partialSM(pA0, pA1, m_reg, mnA, alA);
  SLOAD(SO, KVBLK);
  SWAIT(); SWRITE(1, SO); __syncthreads();
  for (int j = 1; j + 1 < NT; j += 2) {
    SBAR(); qkt(pB0, pB1, (LAS bf16_t*)((LAS char*)K_lds + SHM_K), qr, r32, hi);
    finishSM(pA0, pA1, alA, l_reg, pa0, pa1, pa2, pa3); SBAR();
    SLOAD(SO, (j + 1) * KVBLK); SBAR();
    pv_d0(o, vb0, pa0, pa1, pa2, pa3); partialSM(pB0, pB1, m_reg, mnB, alB);
    __syncthreads(); SWAIT(); SWRITE(0, SE);
    RESC(alB); __syncthreads();
    SBAR(); qkt(pA0, pA1, K_lds, qr, r32, hi);
    finishSM(pB0, pB1, alB, l_reg, pa0, pa1, pa2, pa3); SBAR();
    SLOAD(SE, (j + 2) * KVBLK); SBAR();
    pv_d0(o, vb0 + (int)SHM_V, pa0, pa1, pa2, pa3); partialSM(pA0, pA1, m_reg, mnA, alA);
    __syncthreads(); SWAIT(); SWRITE(1, SO);
    RESC(alA); __syncthreads();
  }
  SBAR(); qkt(pB0, pB1, (LAS bf16_t*)((LAS char*)K_lds + SHM_K), qr, r32, hi);
  finishSM(pA0, pA1, alA, l_reg, pa0, pa1, pa2, pa3); SBAR();
  pv_d0(o, vb0, pa0, pa1, pa2, pa3); partialSM(pB0, pB1, m_reg, mnB, alB);
  __syncthreads(); RESC(alB);
  finishSM(pB0, pB1, alB, l_reg, pa0, pa1, pa2, pa3); SBAR();
  pv_d0(o, vb0 + (int)SHM_V, pa0, pa1, pa2, pa3);
  if (hi == 0) li_l[r32] = l_reg; asm volatile("s_waitcnt lgkmcnt(0)" ::: "memory");
  const GAS bf16_t* zb_ = GZ + (size_t)(qrow0 + wid * QBLK) * 1024 + head * D; GAS bf16_t* ob_ = MIX + (size_t)(qrow0 + wid * QBLK) * 2048 + head * D;
  const unsigned zo_ = (unsigned)(4 * hi * 1024 + r32) * 2u, oo_ = (unsigned)(4 * hi * 2048 + r32) * 2u;
#pragma unroll
  for (int r = 0; r < 16; ++r) { const float rli = __builtin_amdgcn_rcpf(li_l[crow(r, hi)]); const int cr = (r & 3) + 8 * (r >> 2);
#pragma unroll
    for (int d0 = 0; d0 < 4; ++d0) GP16(ob_, oo_ + cr * 4096 + 64 * d0) = f2b(o[d0][r] * rli * bf2f(GPC16(zb_, zo_ + cr * 2048 + 64 * d0)));
    if ((r & 3) == 3) asm volatile("" ::: "memory"); }
  __syncthreads();
#undef SLOAD
#undef SWRITE
#undef SWAIT
#undef RESC
}
#undef KSWZ
#undef SBAR
}

__device__ __forceinline__ void p12_final(Frame& F, const Args& A_) {
    const int gw = F.vcu * NWAVES + F.wave, NGW = F.G * NWAVES; const GAS float* fg = inp(F, 2);
    for (int row = gw; row < M; row += NGW) {
        GAS f32x4* p = (GAS f32x4*)(F.out + (size_t)row * 1024) + F.lane; f32x4 v[4]; float s = 0.f;
#pragma unroll
        for (int j = 0; j < 4; ++j) { v[j] = p[64 * j]; s += (v[j][0] * v[j][0] + v[j][1] * v[j][1]) + (v[j][2] * v[j][2] + v[j][3] * v[j][3]); }
#pragma unroll
        for (int o = 1; o < 64; o <<= 1) s += __shfl_xor(s, o);
        const float r = 1.0f / sqrtf(s * (1.f / 1024.f) + RMS_EPS);
#pragma unroll
        for (int j = 0; j < 4; ++j) { const f32x4 g = *((const GAS f32x4*)fg + F.lane + 64 * j); p[64 * j] = v[j] * r * g; }
    }
}

__global__ void __launch_bounds__(NTHR, 2) mega_fwd(Args args) {
    extern __shared__ __attribute__((aligned(16))) unsigned char lds[];
    Frame F;
    F.lds = (LAS unsigned char*)lds; F.MISC = (volatile LAS unsigned*)(F.lds + MISC_OFF);
    F.tid = threadIdx.x; F.lane = F.tid & 63; F.wave = __builtin_amdgcn_readfirstlane(F.tid >> 6);
    F.G = gridDim.x; { const int bx = blockIdx.x; F.vcu = (F.G % 8 == 0) ? (bx % 8) * (F.G / 8) + bx / 8 : bx; }
    F.ws = (GAS unsigned char*)args.ws; F.out = (GAS float*)args.out; F.ctl = (gu32*)(args.ws + WS_CTL);
    for (int u = F.tid; u < (LDS_BYTES - LDSCTL_OFF) / 4; u += NTHR) ((LAS unsigned*)(F.lds + LDSCTL_OFF))[u] = 0u;
    __syncthreads();
    if (F.tid == 0) { volatile LAS unsigned long long* t = (volatile LAS unsigned long long*)(F.lds + LDSCTL_OFF + 1024);
#pragma unroll
        for (int i = 0; i < 14; ++i) t[i] = (unsigned long long)args.in[i]; }
    __syncthreads();
    XcdBarrier bar = xcd_barrier_post((unsigned*)(F.ctl + CW_BAR), F.MISC + 8);
    const int lo = args.ph_lo, hi = args.ph_hi;
#ifndef PHMASK
#define PHMASK 0x1fff
#endif
#define IN(k) (((PHMASK >> (k)) & 1) && lo <= (k) && (k) < hi && phase_enter(F))
#ifdef DIAG_A
#define STAMP(k) do { if (blockIdx.x == 0 && F.tid == 0) __hip_atomic_store((unsigned*)(F.ctl + 12288 + (k)), (unsigned)__builtin_amdgcn_s_memrealtime(), __ATOMIC_RELAXED, __HIP_MEMORY_SCOPE_AGENT); } while (0)
#else
#define STAMP(k) do { } while (0)
#endif
#define SEAM(k) do { if (IN(k) && IN((k) + 1)) xcd_barrier(bar); STAMP((k) + 1); } while (0)

    STAMP(0);
    if (IN(0)) { p0_prologue(F, args); } SEAM(0);
    if (IN(1)) {
        pg8::Gemm g{(const bf16_t*)WSP(bf16_t, WS_U0), (const bf16_t*)WSP(bf16_t, WS_W1T), M, 5120, 1024}; pg8::StaticOrder S; S.init(M, 5120, F.G, (int)blockIdx.x);
        pg8::EpiAct E{0, WSP(bf16_t, WS_A0), WSP(bf16_t, WS_A1), WSP(bf16_t, WS_A2), WSP(bf16_t, WS_A3), nullptr, nullptr, WSP(float, WS_RS0), 1};
        pg8::gemm_phase<pg8::EpiAct, pg8::StaticOrder, true, true>(F.lds, g, S, E);
    } SEAM(1);
    if (IN(2)) { for (int u = F.vcu; u < 256; u += F.G) x1_unit(F, args, u); } SEAM(2);
    if (IN(3)) { x2_scan(F); } SEAM(3);
    if (IN(4)) { for (int u = F.vcu; u < 256; u += F.G) x3_unit(F, args, u); } SEAM(4);
    if (IN(5)) {
        pg8::Gemm g{(const bf16_t*)WSP(bf16_t, WS_U0), (const bf16_t*)(WSP(bf16_t, WS_W1T) + (size_t)5120 * 1024), M, 4096, 1024}; pg8::StaticOrder S; S.init(M, 4096, F.G, (int)blockIdx.x);
        pg8::EpiAct E{1, WSP(bf16_t, WS_A0), WSP(bf16_t, WS_A1), WSP(bf16_t, WS_A2), WSP(bf16_t, WS_A3), nullptr, nullptr, WSP(float, WS_RS0), 1};
        pg8::gemm_phase<pg8::EpiAct, pg8::StaticOrder, true, true>(F.lds, g, S, E);
    } SEAM(5);
    if (IN(6)) {
        { LAS float* scr = (LAS float*)(F.lds + F.wave * 16384); const int gw = F.vcu * NWAVES + F.wave, NGW = F.G * NWAVES;
          for (int it = gw; it < 16 * 208; it += NGW) { const int kb = it / 208, d = 32 * (it % 208); transpose_item(inp(F, 8), ODD_IN, 1024, WSP(bf16_t, WS_W3T), d, map_w3(d), inp(F, 1) + 1024, scr, kb, F.lane); }
          __syncthreads(); }
        STAMP(14);
        na_phase<true, true>(F, args);
#ifdef PROBE_NA
        __syncthreads(); STAMP(15); na_phase<false, false>(F, args); __syncthreads(); STAMP(16);
#endif
    } SEAM(6);
    if (IN(7)) {
        pg8::Gemm g{(const bf16_t*)WSP(bf16_t, WS_MIX0), (const bf16_t*)WSP(bf16_t, WS_W2T), M, 1024, 2048}; pg8::StaticOrder S; S.init(M, 1024, F.G, (int)blockIdx.x);
        pg8::EpiResid E{inp(F, 0), F.out, WSP(bf16_t, WS_H1B), WSP(float, WS_PART)};
        pg8::gemm_phase<pg8::EpiResid, pg8::StaticOrder, false, true>(F.lds, g, S, E);
    } SEAM(7);
    if (IN(8)) {
        pg8::Gemm g{(const bf16_t*)WSP(bf16_t, WS_H1B), (const bf16_t*)WSP(bf16_t, WS_W3T), M, 6656, 1024}; pg8::StaticOrder S; S.init(M, 6656, F.G, (int)blockIdx.x);
        pg8::EpiAct E{2, WSP(bf16_t, WS_GQ), WSP(bf16_t, WS_GK), WSP(bf16_t, WS_GV), WSP(bf16_t, WS_GZ), WSP(bf16_t, WS_XC), WSP(bf16_t, WS_CG), WSP(float, WS_PART), 2};
        pg8::gemm_phase<pg8::EpiAct, pg8::StaticOrder, true, true>(F.lds, g, S, E);
    } SEAM(8);
    if (IN(9)) { p9_krope_conv(F, args); } SEAM(9);
    if (IN(10)) {
        const int combo = F.vcu >> 6, b = combo >> 1, kvh = combo & 1, idx = F.vcu & 63;
        if (F.vcu < 256)
#pragma unroll 1
        for (int i = 0; i < 2; ++i) { const int uu = idx * 2 + i, head = 4 * kvh + (uu >> 5), qblk = uu & 31;
            gqa::unit(WSP(bf16_t, WS_GQ), WSP(bf16_t, WS_GK) + ((size_t)kvh * M + (size_t)b * SEQ) * 128, WSP(bf16_t, WS_GV) + ((size_t)kvh * M + (size_t)b * SEQ) * 128, WSP(bf16_t, WS_GZ), WSP(bf16_t, WS_MIX1),
                      inp(F, 10), WSP(float, WS_ROPE), WSP(float, WS_ROPE) + 8192, b * SEQ + 256 * qblk, head, SEQ, (LAS char*)F.lds, F.tid); }
    } SEAM(10);
    if (IN(11)) {
        pg8::Gemm g{(const bf16_t*)WSP(bf16_t, WS_MIX1), (const bf16_t*)WSP(bf16_t, WS_W4T), M, 1024, 2048}; pg8::StaticOrder S; S.init(M, 1024, F.G, (int)blockIdx.x);
        pg8::EpiResid E{F.out, F.out, nullptr, nullptr};
        pg8::gemm_phase<pg8::EpiResid, pg8::StaticOrder, false, true>(F.lds, g, S, E);
    } SEAM(11);
    if (IN(12)) { p12_final(F, args); }
#ifdef DIAG_A
    __syncthreads(); STAMP(13); xcd_barrier(bar);
    if (blockIdx.x == 0) { unsigned* ts = (unsigned*)(F.ctl + 12288);
        asm volatile("s_waitcnt vmcnt(0)" ::: "memory");
        const unsigned a0 = __hip_atomic_load(ts + DIAG_A, __ATOMIC_RELAXED, __HIP_MEMORY_SCOPE_AGENT), a1 = __hip_atomic_load(ts + DIAG_B, __ATOMIC_RELAXED, __HIP_MEMORY_SCOPE_AGENT);
        const unsigned b0 = a0, b1 = a1;
        const float da = (float)(a1 - a0) * 0.0001f, db = (float)(b1 - b0) * 0.0001f;
        if (F.tid == 0) F.out[0] += da;
        for (int i = F.tid; i < DIAG_NB; i += NTHR) F.out[1024 + i] += db; }
#endif
#undef IN
#undef SEAM
}

extern "C" void kernel_launch(void* const* d_in, const int* in_sizes, int n_in, void* d_out, int out_size, void* d_ws, size_t ws_size, hipStream_t stream) {
    static int grid = 0;
    if (grid == 0) {
        if (n_in != 14 || in_sizes[0] != M * DM || out_size != M * DM || ws_size < WS_END) { fprintf(stderr, "kernel_launch: unexpected shapes/workspace: n_in %d in0 %d out %d ws %zu\n", n_in, n_in > 0 ? in_sizes[0] : -1, out_size, ws_size); grid = -1; return; }
        int dev = 0, cus = 0, per_cu = 0;
        if (hipGetDevice(&dev) != hipSuccess || hipDeviceGetAttribute(&cus, hipDeviceAttributeMultiprocessorCount, dev) != hipSuccess) { grid = -1; return; }
        if (hipFuncSetAttribute((const void*)mega_fwd, hipFuncAttributeMaxDynamicSharedMemorySize, LDS_BYTES) != hipSuccess) { fprintf(stderr, "kernel_launch: hipFuncSetAttribute failed\n"); grid = -1; return; }
        if (hipOccupancyMaxActiveBlocksPerMultiprocessor(&per_cu, (const void*)mega_fwd, NTHR, LDS_BYTES) != hipSuccess || per_cu < 1) { fprintf(stderr, "kernel_launch: occupancy query reports %d\n", per_cu); per_cu = 1; }
        (void)hipGetLastError();
        grid = cus;
    }
    if (grid < 0) return;
    if (hipMemsetAsync((char*)d_ws + WS_CTL, 0, CTL_ZERO_BYTES, stream) != hipSuccess) return;
    Args a{};
    for (int i = 0; i < 14; ++i) a.in[i] = (const float*)d_in[i];
    a.out = (float*)d_out; a.ws = (unsigned char*)d_ws;
#ifdef MK_SPLIT
    for (int p = 0; p < NPHASE; ++p) { a.ph_lo = p; a.ph_hi = p + 1; hipLaunchKernelGGL(mega_fwd, dim3(grid), dim3(NTHR), LDS_BYTES, stream, a); }
#else
    a.ph_lo = 0; a.ph_hi = NPHASE;
    hipLaunchKernelGGL(mega_fwd, dim3(grid), dim3(NTHR), LDS_BYTES, stream, a);
#endif
}
```

```cpp
#include <hip/hip_runtime.h>
#include <cstdio>
#include <cstdint>
#include <cmath>
namespace pg8 {
#define PG8_LAS __attribute__((address_space(3)))
typedef unsigned short bf16_t;
typedef short bf16x8 __attribute__((ext_vector_type(8)));
typedef float f32x4 __attribute__((ext_vector_type(4)));
typedef unsigned u32x4 __attribute__((ext_vector_type(4)));
constexpr int BM = 256, BK = 64, HALF = 128, HTB = HALF * BK * 2  , STAGE_BYTES = 8 * HTB, NXCD = 8, WGM = 8;

__host__ __device__ __forceinline__ int lds_byte(int r, int c) { const int st = (r >> 4) * 2 + (c >> 5), rr = r & 15, cc = c & 31, ob = rr * 64 + cc * 2; return st * 1024 + (ob ^ (((ob >> 9) & 1) << 5)); }
__host__ __device__ __forceinline__ void stage_rc(int b, int& R, int& C) { const int st = b / 1024, sb = b % 1024, swz = sb ^ (((sb >> 9) & 1) << 5); R = (st >> 1) * 16 + swz / 64; C = (st & 1) * 32 + (swz % 64) / 2; }
__host__ __device__ __forceinline__ int perm32(int rho) { const int n = rho >> 4, i = rho & 15; return 8 * (i >> 2) + 4 * n + (i & 3); }

struct Unit { int pm, pn; };
struct Gemm { const bf16_t* A; const bf16_t* Bt; int M, N, K; };

struct StaticOrder {
    int nM, nN, nwg, G, c;
    __host__ __device__ void init(int M, int N, int G_, int c_) { nM = M / BM; nN = N / BM; nwg = nM * nN; G = G_; c = c_; }
    __host__ __device__ bool next(int i, Unit& u) const {
        const long L = (long)i * G + c; if (L >= nwg) return false;
        int wgid = (int)L; { const int q = nwg / NXCD, r = nwg % NXCD, xcd = wgid % NXCD, off = wgid / NXCD; wgid = (xcd < r ? xcd * (q + 1) : r * (q + 1) + (xcd - r) * q) + off; }
        const int nig = WGM * nN, gid = wgid / nig, fm = gid * WGM, gsz = (nM - fm) < WGM ? (nM - fm) : WGM;
        u.pm = fm + ((wgid % nig) % gsz); u.pn = (wgid % nig) / gsz; return true;
    }
    __device__ __forceinline__ void a_ready(const Unit&) const {}
    __device__ __forceinline__ void done(const Unit&) const {}
};

typedef float f32x2 __attribute__((ext_vector_type(2)));
typedef __bf16 bf16x2_t __attribute__((ext_vector_type(2)));
__device__ __forceinline__ unsigned cvt_pk_bf16(float lo, float hi) { f32x2 v = {lo, hi}; bf16x2_t b = __builtin_convertvector(v, bf16x2_t); return __builtin_bit_cast(unsigned, b); }
__device__ __forceinline__ float fexp(float x) { return __builtin_amdgcn_exp2f(x * 1.4426950408889634f); }
__device__ __forceinline__ float sigm(float x) { return __builtin_amdgcn_rcpf(1.f + fexp(-x)); }
__device__ __forceinline__ float silu(float x) { return x * sigm(x); }

#define PG8_GAS __attribute__((address_space(1)))
struct TileOut { PG8_GAS bf16_t* dst; int ldc; int col0; int mode; float scale; int hstride; };
constexpr size_t PM_ = 16384;
struct EpiAct {
    static constexpr bool PERM = true, AFTER_DRAIN = false;
    int gid;
    PG8_GAS bf16_t *T0, *T1, *T2, *T3, *T4, *T5;
    const PG8_GAS float* rs; int rs_mode;
    __device__ __forceinline__ TileOut tile(int pn) const {
        TileOut t;
        if (gid == 0) {
            if (pn < 4)       t = TileOut{T0 + (size_t)pn * (PM_ * 256), 256, 0, 0, 1.f, 128};
            else if (pn < 8)  t = TileOut{T1 + (size_t)(pn - 4) * (PM_ * 256), 256, 0, 0, 0.0625f, 128};
            else if (pn < 12) t = TileOut{T2 + (size_t)(pn - 8) * (PM_ * 256), 256, 0, 0, 1.f, 128};
            else              t = TileOut{T3 + (size_t)((pn - 12) >> 1) * (PM_ * 256), 256, 128 * ((pn - 12) & 1), 2, 1.f, 128};
        } else if (gid == 1) {
            if (pn < 4)       t = TileOut{T0 + (size_t)pn * (PM_ * 256), 256, 0, 0, 0.125f, 128};
            else if (pn < 8)  t = TileOut{T1 + (size_t)(pn - 4) * (PM_ * 256), 256, 0, 0, 1.f, 128};
            else if (pn < 12) t = TileOut{T2 + (size_t)(pn - 8) * (PM_ * 256), 256, 0, 0, 1.f, 128};
            else              t = TileOut{T3 + (size_t)(pn - 12) * (PM_ * 256), 256, 0, 1, 1.f, 128};
        } else {
            if (pn < 4)        t = TileOut{T0, 1024, 256 * pn, 0, 1.f, 128};
            else if (pn == 4)  t = TileOut{T1, 128, 0, 0, 1.f, (int)(PM_ * 128)};
            else if (pn == 5)  t = TileOut{T2, 128, 0, 0, 1.f, (int)(PM_ * 128)};
            else if (pn < 10)  t = TileOut{T3, 1024, 256 * (pn - 6), 1, 1.f, 128};
            else if (pn < 18)  t = TileOut{T4, 1024, 128 * (pn - 10), 3, 1.f, 128};
            else               t = TileOut{T5, 1024, 128 * (pn - 18), 4, 1.f, 128};
        }
        return t;
    }
    __device__ __forceinline__ void operator()(const f32x4 (&acc)[2][2][4][2], const Unit& u, int wr, int wc, int fr, int fq) const {
        const TileOut t = tile(u.pn);
        const int rbase = u.pm * BM + wr * 64 + fr, cl = wc * 32 + 8 * fq;
        float rsc[2][4];
#pragma unroll
        for (int ai = 0; ai < 2; ++ai)
#pragma unroll
            for (int m = 0; m < 4; ++m) rsc[ai][m] = rs[rbase + ai * HALF + m * 16];
        asm volatile("" ::: "memory");
#pragma unroll
        for (int ai = 0; ai < 2; ++ai)
#pragma unroll
            for (int m = 0; m < 4; ++m) {
                const int row = rbase + ai * HALF + m * 16;
                float r = t.scale;
                if (rs_mode == 1) r *= rsc[ai][m];
                else r *= __builtin_amdgcn_rsqf(rsc[ai][m] * (1.f / 1024.f) + 1e-6f);
                PG8_GAS bf16_t* rowp = t.dst + (size_t)row * t.ldc + t.col0 + cl;
                if (t.mode <= 1) {
#pragma unroll
                    for (int bj = 0; bj < 2; ++bj) { f32x4 v0 = acc[ai][bj][m][0] * r, v1 = acc[ai][bj][m][1] * r;
                        if (t.mode == 1) {
#pragma unroll
                            for (int j = 0; j < 4; ++j) { v0[j] = silu(v0[j]); v1[j] = silu(v1[j]); } }
                        u32x4 w; w.x = cvt_pk_bf16(v0[0], v0[1]); w.y = cvt_pk_bf16(v0[2], v0[3]); w.z = cvt_pk_bf16(v1[0], v1[1]); w.w = cvt_pk_bf16(v1[2], v1[3]);
                        *(PG8_GAS u32x4*)(rowp + (size_t)bj * t.hstride) = w; }
                } else {
                    f32x4 o[2];
#pragma unroll
                    for (int n = 0; n < 2; ++n) { const f32x4 a = acc[ai][0][m][n] * r, b = acc[ai][1][m][n] * r;
#pragma unroll
                        for (int j = 0; j < 4; ++j) o[n][j] = (t.mode == 2) ? sigm(a[j]) * silu(b[j]) : (t.mode == 3) ? a[j] * b[j] : a[j] * silu(b[j]); }
                    u32x4 w; w.x = cvt_pk_bf16(o[0][0], o[0][1]); w.y = cvt_pk_bf16(o[0][2], o[0][3]); w.z = cvt_pk_bf16(o[1][0], o[1][1]); w.w = cvt_pk_bf16(o[1][2], o[1][3]);
                    *(PG8_GAS u32x4*)rowp = w;
                }
            }
    }
};
struct EpiResid {
    static constexpr bool PERM = false, AFTER_DRAIN = false;
    const PG8_GAS float* base; PG8_GAS float* out; PG8_GAS bf16_t* outb; PG8_GAS float* rsum;
    __device__ __forceinline__ void operator()(const f32x4 (&acc)[2][2][4][2], const Unit& u, int wr, int wc, int fr, int fq) const {
        typedef unsigned u32x2v __attribute__((ext_vector_type(2)));
        const int col0 = u.pn * BM + wc * 32 + 4 * fq;
#pragma unroll
        for (int ai = 0; ai < 2; ++ai) {
            f32x4 bs[4][2][2];
#pragma unroll
            for (int m = 0; m < 4; ++m) { const int row = u.pm * BM + ai * HALF + wr * 64 + m * 16 + fr; const size_t off = (size_t)row * 1024 + col0;
#pragma unroll
                for (int bj = 0; bj < 2; ++bj)
#pragma unroll
                    for (int n = 0; n < 2; ++n) bs[m][bj][n] = *(const PG8_GAS f32x4*)(base + off + bj * HALF + n * 16); }
            asm volatile("" ::: "memory");
#pragma unroll
            for (int m = 0; m < 4; ++m) { const int row = u.pm * BM + ai * HALF + wr * 64 + m * 16 + fr; const size_t off = (size_t)row * 1024 + col0; float ss = 0.f;
#pragma unroll
                for (int bj = 0; bj < 2; ++bj)
#pragma unroll
                    for (int n = 0; n < 2; ++n) { const f32x4 o = bs[m][bj][n] + acc[ai][bj][m][n];
                        *(PG8_GAS f32x4*)(out + off + bj * HALF + n * 16) = o; ss += (o[0] * o[0] + o[1] * o[1]) + (o[2] * o[2] + o[3] * o[3]);
                        if (outb) { u32x2v w; w.x = cvt_pk_bf16(o[0], o[1]); w.y = cvt_pk_bf16(o[2], o[3]); *(PG8_GAS u32x2v*)(outb + off + bj * HALF + n * 16) = w; } }
                if (rsum) { ss += __shfl_xor(ss, 16); ss += __shfl_xor(ss, 32);
                    if (fq == 0) __hip_atomic_fetch_add(rsum + row, ss, __ATOMIC_RELAXED, __HIP_MEMORY_SCOPE_AGENT); } }
            asm volatile("" ::: "memory");
        }
    }
};

template <class Epi, class Sched, bool ALIGN_EPI = false, bool SP2 = false>
__device__ __forceinline__ void gemm_phase(PG8_LAS unsigned char* lds, const Gemm g, const Sched& S, const Epi& E) {
    const int tid = threadIdx.x, wid = __builtin_amdgcn_readfirstlane(tid >> 6), lane = tid & 63, wr = wid >> 2, wc = wid & 3, fr = lane & 15, fq = lane >> 4;
    const int K = g.K, nt = K / BK;
    unsigned voffA[2], voffB[2];
#pragma unroll
    for (int i = 0; i < 2; ++i) { int R, C; stage_rc(tid * 16 + i * 8192, R, C); const int Rb = Epi::PERM ? ((R & ~31) + perm32(R & 31)) : R;
        voffA[i] = (unsigned)(R * K + C) * 2u; voffB[i] = (unsigned)(Rb * K + C) * 2u; }
    const size_t kstep = (size_t)(BK * 2);
    const size_t hstep = (size_t)HALF * K * 2;
    const size_t tstep = 2 * hstep;
    const unsigned ldsw = (unsigned)wid * 1024u;
    const int aoff = lds_byte(wr * 64 + fr, fq * 8), boff = lds_byte(wc * 32 + fr, fq * 8);
#define PG8_SA(b, h) (((b) * 2 + (h)) * HTB)
#define PG8_SB(b, h) ((4 + (b) * 2 + (h)) * HTB)
#define PG8_STAGE(bufoff, gbase, voff) do { _Pragma("unroll") for (int _i = 0; _i < 2; ++_i) \
        __builtin_amdgcn_global_load_lds((const unsigned*)((const char*)(gbase) + (voff)[_i]), (PG8_LAS unsigned*)(lds + (bufoff) + ldsw + _i * 8192), 16, 0, 0); } while (0)
#define PG8_LDA(dst, b, h) do { _Pragma("unroll") for (int m = 0; m < 4; ++m) _Pragma("unroll") for (int k = 0; k < 2; ++k) dst[m][k] = *(const PG8_LAS bf16x8*)(lds + PG8_SA(b, h) + aoff + m * 2048 + k * 1024); } while (0)
#define PG8_LDB(dst, b, h) do { _Pragma("unroll") for (int n = 0; n < 2; ++n) _Pragma("unroll") for (int k = 0; k < 2; ++k) dst[n][k] = *(const PG8_LAS bf16x8*)(lds + PG8_SB(b, h) + boff + n * 2048 + k * 1024); } while (0)
#define PG8_MMA(ai, bj, At, Bt) do { __builtin_amdgcn_s_setprio(1); _Pragma("unroll") for (int m = 0; m < 4; ++m) _Pragma("unroll") for (int n = 0; n < 2; ++n) _Pragma("unroll") for (int k = 0; k < 2; ++k) \
        acc[ai][bj][m][n] = __builtin_amdgcn_mfma_f32_16x16x32_bf16(Bt[n][k], At[m][k], acc[ai][bj][m][n], 0, 0, 0); __builtin_amdgcn_s_setprio(0); } while (0)
#define PG8_WAIT_V(n) asm volatile("s_waitcnt vmcnt(" #n ")" ::: "memory")
#define PG8_WAIT_L(n) asm volatile("s_waitcnt lgkmcnt(" #n ")" ::: "memory")
#define PG8_BAR __builtin_amdgcn_s_barrier()
#define PG8_SCHED __builtin_amdgcn_sched_barrier(0)
    Unit cur, nxt; int ui = 0;
    if (!S.next(0, cur)) return;
    f32x4 acc[2][2][4][2];
#pragma unroll
    for (int a = 0; a < 2; ++a)
#pragma unroll
        for (int b = 0; b < 2; ++b)
#pragma unroll
            for (int m = 0; m < 4; ++m)
#pragma unroll
                for (int n = 0; n < 2; ++n) acc[a][b][m][n] = (f32x4){0.f, 0.f, 0.f, 0.f};
    bf16x8 At[4][2], B0[2][2], B1[2][2];
    const char* cA = (const char*)g.A + (size_t)cur.pm * tstep; const char* cB = (const char*)g.Bt + (size_t)cur.pn * tstep;
    S.a_ready(cur);
    if constexpr (SP2) {
        PG8_STAGE(PG8_SB(0, 0), cB, voffB); PG8_STAGE(PG8_SB(0, 1), cB + hstep, voffB); PG8_STAGE(PG8_SA(0, 0), cA, voffA); PG8_STAGE(PG8_SA(0, 1), cA + hstep, voffA);
        if (wr == 1) PG8_BAR;
        PG8_WAIT_V(2); PG8_BAR;
        PG8_STAGE(PG8_SB(1, 0), cB + kstep, voffB); PG8_STAGE(PG8_SA(1, 0), cA + kstep, voffA); PG8_STAGE(PG8_SB(1, 1), cB + hstep + kstep, voffB);
        PG8_WAIT_V(6); PG8_BAR;
    } else {
        PG8_STAGE(PG8_SB(0, 0), cB, voffB); PG8_STAGE(PG8_SA(0, 0), cA, voffA); PG8_STAGE(PG8_SB(0, 1), cB + hstep, voffB); PG8_STAGE(PG8_SA(0, 1), cA + hstep, voffA);
        if (wr == 1) PG8_BAR;
        PG8_WAIT_V(4); PG8_BAR;
        PG8_STAGE(PG8_SB(1, 0), cB + kstep, voffB); PG8_STAGE(PG8_SA(1, 0), cA + kstep, voffA); PG8_STAGE(PG8_SB(1, 1), cB + hstep + kstep, voffB);
        PG8_WAIT_V(6); PG8_BAR;
    }
    for (;;) {
        const bool has_next = S.next(ui + 1, nxt);
        const char* nA = has_next ? (const char*)g.A + (size_t)nxt.pm * tstep : cA; const char* nB = has_next ? (const char*)g.Bt + (size_t)nxt.pn * tstep : cB;
        for (int t = 0; t < nt; t += 2) {
            const bool last = (t == nt - 2);
            const char* a1 = cA + (size_t)(t + 1) * kstep;
            const char* a2 = last ? nA : cA + (size_t)(t + 2) * kstep; const char* b2 = last ? nB : cB + (size_t)(t + 2) * kstep;
            const char* a3 = a2 + kstep; const char* b3 = b2 + kstep;
            if (last && has_next) S.a_ready(nxt);
            if constexpr (SP2) {
            PG8_LDB(B0, 0, 0); PG8_LDB(B1, 0, 1); PG8_SCHED; PG8_LDA(At, 0, 0); PG8_STAGE(PG8_SA(1, 1), a1 + hstep, voffA);
            PG8_WAIT_V(8); PG8_WAIT_L(0); PG8_BAR; PG8_MMA(0, 0, At, B0); PG8_MMA(0, 1, At, B1); PG8_BAR; PG8_SCHED;
            PG8_LDA(At, 0, 1); PG8_STAGE(PG8_SB(0, 0), b2, voffB); PG8_STAGE(PG8_SB(0, 1), b2 + hstep, voffB); PG8_STAGE(PG8_SA(0, 0), a2, voffA);
            PG8_WAIT_V(8); PG8_WAIT_L(0); PG8_BAR; PG8_MMA(1, 0, At, B0); PG8_MMA(1, 1, At, B1); PG8_BAR; PG8_SCHED;
            PG8_LDB(B0, 1, 0); PG8_LDB(B1, 1, 1); PG8_SCHED; PG8_LDA(At, 1, 0); PG8_STAGE(PG8_SA(0, 1), a2 + hstep, voffA);
            PG8_WAIT_V(8); PG8_WAIT_L(0); PG8_BAR; PG8_MMA(0, 0, At, B0); PG8_MMA(0, 1, At, B1); PG8_BAR; PG8_SCHED;
            PG8_LDA(At, 1, 1); PG8_STAGE(PG8_SB(1, 0), b3, voffB); PG8_STAGE(PG8_SB(1, 1), b3 + hstep, voffB); PG8_STAGE(PG8_SA(1, 0), a3, voffA);
            PG8_WAIT_V(8); PG8_WAIT_L(0); PG8_BAR; PG8_MMA(1, 0, At, B0); PG8_MMA(1, 1, At, B1); PG8_BAR; PG8_SCHED;
            } else {
            PG8_LDB(B0, 0, 0); PG8_SCHED; PG8_LDA(At, 0, 0); PG8_STAGE(PG8_SA(1, 1), a1 + hstep, voffA);
            PG8_WAIT_L(8); PG8_BAR; PG8_WAIT_L(0); PG8_MMA(0, 0, At, B0); PG8_BAR; PG8_SCHED;
            PG8_LDB(B1, 0, 1); PG8_STAGE(PG8_SB(0, 0), b2, voffB);
            PG8_BAR; PG8_WAIT_L(0); PG8_MMA(0, 1, At, B1); PG8_BAR;
            PG8_LDA(At, 0, 1); PG8_STAGE(PG8_SA(0, 0), a2, voffA);
            PG8_BAR; PG8_WAIT_L(0); PG8_MMA(1, 0, At, B0); PG8_BAR; PG8_SCHED;
            PG8_STAGE(PG8_SB(0, 1), b2 + hstep, voffB);
            PG8_WAIT_V(6); PG8_BAR; PG8_MMA(1, 1, At, B1); PG8_BAR;
            PG8_LDB(B0, 1, 0); PG8_SCHED; PG8_LDA(At, 1, 0); PG8_STAGE(PG8_SA(0, 1), a2 + hstep, voffA);
            PG8_WAIT_L(8); PG8_BAR; PG8_WAIT_L(0); PG8_MMA(0, 0, At, B0); PG8_BAR; PG8_SCHED;
            PG8_LDB(B1, 1, 1); PG8_STAGE(PG8_SB(1, 0), b3, voffB);
            PG8_BAR; PG8_WAIT_L(0); PG8_MMA(0, 1, At, B1); PG8_BAR;
            PG8_LDA(At, 1, 1); PG8_STAGE(PG8_SA(1, 0), a3, voffA);
            PG8_BAR; PG8_WAIT_L(0); PG8_MMA(1, 0, At, B0); PG8_BAR; PG8_SCHED;
            PG8_STAGE(PG8_SB(1, 1), b3 + hstep, voffB);
            PG8_WAIT_V(6); PG8_BAR; PG8_MMA(1, 1, At, B1); PG8_BAR;
            }
        }
        if constexpr (ALIGN_EPI) { if (wr == 0) PG8_BAR; }
        if constexpr (!Epi::AFTER_DRAIN) { E(acc, cur, wr, wc, fr, fq); S.done(cur); }
        if (!has_next) break;
#pragma unroll
        for (int a = 0; a < 2; ++a)
#pragma unroll
            for (int b = 0; b < 2; ++b)
#pragma unroll
                for (int m = 0; m < 4; ++m)
#pragma unroll
                    for (int n = 0; n < 2; ++n) acc[a][b][m][n] = (f32x4){0.f, 0.f, 0.f, 0.f};
        cur = nxt; cA = nA; cB = nB; ++ui;
        if constexpr (ALIGN_EPI) { if (wr == 1) PG8_BAR; }
    }
    PG8_WAIT_V(0);
    if constexpr (!ALIGN_EPI) { if (wr == 0) PG8_BAR; }
    PG8_BAR;
    if constexpr (Epi::AFTER_DRAIN) { E.fused(acc, cur, wr, wc, fr, fq, lds, wid, lane); S.done(cur); }
#undef PG8_SA
#undef PG8_SB
#undef PG8_STAGE
#undef PG8_LDA
#undef PG8_LDB
#undef PG8_MMA
#undef PG8_WAIT_V
#undef PG8_WAIT_L
#undef PG8_BAR
#undef PG8_SCHED
}
}
#define GAS __attribute__((address_space(1)))
#define LAS __attribute__((address_space(3)))
typedef unsigned short bf16;
typedef unsigned v4u __attribute__((ext_vector_type(4)));
typedef float f32x4 __attribute__((ext_vector_type(4)));
typedef short bf16x8 __attribute__((ext_vector_type(8)));
typedef GAS unsigned gu32;
typedef GAS unsigned long long gu64;
#define RLX_AGENT __ATOMIC_RELAXED, __HIP_MEMORY_SCOPE_AGENT
#define LDS_WAIT() asm volatile("s_waitcnt lgkmcnt(0)" ::: "memory")
#define VM_WAIT() asm volatile("s_waitcnt vmcnt(0)" ::: "memory")
__device__ __forceinline__ unsigned long long rt() { return __builtin_amdgcn_s_memrealtime(); }
__device__ __forceinline__ unsigned f2bf(float f) { unsigned u = __builtin_bit_cast(unsigned, f); return (u + 0x7fffu + ((u >> 16) & 1u)) >> 16; }
__device__ __forceinline__ unsigned pk2(float lo, float hi) { return f2bf(lo) | (f2bf(hi) << 16); }

#define XB_TMO      128
#define XB_XCNT(j)  (256  + 64 * (j))
#define XB_XSUB(j)  (1280 + 64 * (j))
#define XB_XGEN(j)  (2304 + 64 * (j))
#define XB_TOP      3328
#define XB_TOPGEN   3392
#define XCD_BAR_WORDS 3456
#define XB_SPIN_CAP (1u << 18)

__device__ __forceinline__ unsigned xb_ld(unsigned* p)              { return __hip_atomic_load(p, __ATOMIC_RELAXED, __HIP_MEMORY_SCOPE_AGENT); }
__device__ __forceinline__ unsigned xb_add(unsigned* p, unsigned v) { return __hip_atomic_fetch_add(p, v, __ATOMIC_RELAXED, __HIP_MEMORY_SCOPE_AGENT); }
__device__ __forceinline__ unsigned xb_xcc_id() { return (unsigned)__builtin_amdgcn_s_getreg((3 << 11) | 20) & 0xFu; }
#define XB_SPIN(cond, bar) do { unsigned _sp = 0; while (cond) { __builtin_amdgcn_s_sleep(1); \
    if ((++_sp & 255u) == 0u) { if (xb_ld(&(bar)[XB_TMO])) break; if (_sp > XB_SPIN_CAP) { atomicAdd(&(bar)[XB_TMO], 1u); break; } } } } while (0)

struct XcdBarrier {
    unsigned* bar; unsigned x;
    volatile LAS unsigned* st;
};

__device__ __forceinline__ XcdBarrier xcd_barrier_post(unsigned* bar, volatile LAS unsigned* st) {
    XcdBarrier b; b.bar = bar; b.x = xb_xcc_id(); b.st = st;
    if (threadIdx.x == 0) (void)xb_add(&bar[XB_XCNT(b.x)], 1u);
    return b;
}
__device__ __forceinline__ void xcd_barrier_complete(unsigned* bar, unsigned x, unsigned& nloc, unsigned& nx) {
    const unsigned G = gridDim.x * gridDim.y * gridDim.z;
    unsigned sum, cnt, mine, sp = 0u;
    for (;;) {
        sum = 0u; cnt = 0u; mine = 0u;
#pragma unroll
        for (unsigned j = 0; j < 16; ++j) { const unsigned c = xb_ld(&bar[XB_XCNT(j)]); sum += c; cnt += (c > 0u) ? 1u : 0u; mine = (j == x) ? c : mine; }
        if (sum == G) break;
        __builtin_amdgcn_s_sleep(1);
        if ((++sp & 255u) == 0u) { if (xb_ld(&bar[XB_TMO])) break; if (sp > XB_SPIN_CAP) { atomicAdd(&bar[XB_TMO], 1u); break; } }
    }
    nloc = mine > 0u ? mine : 1u; nx = cnt > 0u ? cnt : 1u;
}

__device__ __forceinline__ void xcd_barrier(const XcdBarrier& b) {
    asm volatile("s_waitcnt vmcnt(0)" ::: "memory");
    __syncthreads();
    if (threadIdx.x == 0) {
        unsigned* bar = b.bar;
        __builtin_amdgcn_s_waitcnt(0);
        unsigned nloc = b.st[0], nx = b.st[1];
        if (nloc == 0u) { xcd_barrier_complete(bar, b.x, nloc, nx); b.st[0] = nloc; b.st[1] = nx; }
        const unsigned old = xb_add(&bar[XB_XSUB(b.x)], 1u);
        const unsigned gen = old / nloc;
        if (old + 1u == (gen + 1u) * nloc) {
            __builtin_amdgcn_fence(__ATOMIC_RELEASE, "agent");
            asm volatile("s_waitcnt vmcnt(0)" ::: "memory");
            const unsigned og = xb_add(&bar[XB_TOP], 1u);
            const unsigned tg = og / nx;
            if (og + 1u == (tg + 1u) * nx) xb_add(&bar[XB_TOPGEN], 1u);
            else XB_SPIN(xb_ld(&bar[XB_TOPGEN]) == tg, bar);
            __builtin_amdgcn_fence(__ATOMIC_ACQUIRE, "agent");
            xb_add(&bar[XB_XGEN(b.x)], 1u);
            asm volatile("s_waitcnt vmcnt(0)" ::: "memory");
        } else {
            XB_SPIN(xb_ld(&bar[XB_XGEN(b.x)]) == gen, bar);
            __builtin_amdgcn_fence(__ATOMIC_ACQUIRE, "agent");
            asm volatile("s_waitcnt vmcnt(0)" ::: "memory");
        }
    }
    __syncthreads();
}
typedef unsigned u32x4 __attribute__((ext_vector_type(4)));
constexpr int NWAVES = 8, NTHR = 512;
constexpr int BATCH = 2, SEQ = 8192, DM = 1024, M = BATCH * SEQ;
constexpr int EVEN_IN = 9232, ODD_IN = 6656;
constexpr float RMS_EPS = 1e-6f;
constexpr int NPHASE = 13;

constexpr size_t MiB = 1u << 20;
constexpr size_t WS_CTL = 0, CTL_ZERO_BYTES = 64 * 1024;
constexpr size_t WS_GATES = 1 * MiB;
constexpr size_t WS_PART = 2 * MiB;
constexpr size_t WS_RS0 = 3 * MiB;
constexpr size_t WS_ROPE = 3 * MiB + 64 * 1024;
constexpr size_t WS_NST = 3 * MiB + 128 * 1024;
constexpr size_t WS_CHSC = 3 * MiB + 640 * 1024;
constexpr size_t WS_W1T = 4 * MiB, WS_W2T = 22 * MiB, WS_U0 = 26 * MiB, WS_W3T = 26 * MiB;
constexpr size_t WS_A0 = 58 * MiB, WS_A1 = 90 * MiB, WS_A2 = 122 * MiB, WS_A3 = 154 * MiB, WS_MIX0 = 186 * MiB, WS_W4T = 250 * MiB;
constexpr size_t WS_H1B = WS_A0, WS_GQ = WS_A1, WS_GZ = WS_A2, WS_XC = WS_A3, WS_CG = 186 * MiB, WS_GK = 218 * MiB, WS_GV = 226 * MiB, WS_MIX1 = 4 * MiB;
constexpr size_t WS_END = 256 * MiB;
constexpr int CW_BAR = 4096;
constexpr int RING_BYTES = 131072, LDSCTL_OFF = 143360, MISC_OFF = LDSCTL_OFF + 320, LDS_BYTES = 147456;
static_assert(66560 + 128 * 528 <= LDSCTL_OFF, "LDS map");

typedef unsigned short bf16_t;
typedef short s16x4 __attribute__((ext_vector_type(4)));
typedef float f32x16 __attribute__((ext_vector_type(16)));
typedef unsigned u32x2 __attribute__((ext_vector_type(2)));
using pg8::cvt_pk_bf16; using pg8::fexp;

__device__ __forceinline__ float bf2f(unsigned short v) { return __uint_as_float((unsigned)v << 16); }
__device__ __forceinline__ bf16_t f2b(float x) { return (bf16_t)(cvt_pk_bf16(x, 0.f) & 0xffffu); }
__device__ __forceinline__ int crow(int r, int hi) { return (r & 3) + 8 * (r >> 2) + 4 * hi; }
__device__ __forceinline__ int v_st(int k, int c) { const int kk = (k & ~0xC) | ((k & 4) << 1) | ((k & 8) >> 1); return ((kk >> 3) * 4 + (c >> 5)) * 512 + ((kk & 7) * 32 + (c & 31)) * 2; }
__device__ __forceinline__ int v_rd_base(int lane) { return ((lane & 3) << 3) | (((lane >> 2) & 3) << 6) | (((lane >> 4) & 1) << 5) | (((lane >> 5) & 1) << 8); }
__device__ __forceinline__ int kswz512(int row, int colB) { return row * 528 + colB; }
__device__ __forceinline__ int kswz256(int row, int colB) { return row * 256 + (colB ^ ((row & 7) << 4)); }
typedef short v4i16_t __attribute__((ext_vector_type(4)));
__device__ __forceinline__ s16x4 vtr(LAS unsigned char* p) { return __builtin_bit_cast(s16x4, __builtin_amdgcn_ds_read_tr16_b64_v4i16((LAS v4i16_t*)p)); }
__device__ __forceinline__ bf16x8 tr_frag(LAS unsigned char* img_plus_rdbase, int d0, int ks) {
    LAS unsigned char* p = img_plus_rdbase + d0 * 512 + ks * 4096; const s16x4 lo = vtr(p), hi = vtr(p + 2048);
    return (bf16x8){lo[0], lo[1], lo[2], lo[3], hi[0], hi[1], hi[2], hi[3]};
}
__device__ __forceinline__ float swap_add(float v) { auto rr = __builtin_amdgcn_permlane32_swap(__float_as_uint(v), __float_as_uint(v), false, false); return __uint_as_float(rr[0]) + __uint_as_float(rr[1]); }
__device__ __forceinline__ float swap_max(float v) { auto rr = __builtin_amdgcn_permlane32_swap(__float_as_uint(v), __float_as_uint(v), false, false); return fmaxf(__uint_as_float(rr[0]), __uint_as_float(rr[1])); }
#define PK4(P, BASE, OUT) do { unsigned a0_ = cvt_pk_bf16(P[BASE + 0], P[BASE + 1]), a1_ = cvt_pk_bf16(P[BASE + 2], P[BASE + 3]);   \
    unsigned b0_ = cvt_pk_bf16(P[BASE + 4], P[BASE + 5]), b1_ = cvt_pk_bf16(P[BASE + 6], P[BASE + 7]);                              \
    auto r0_ = __builtin_amdgcn_permlane32_swap(a0_, b0_, false, false); auto r1_ = __builtin_amdgcn_permlane32_swap(a1_, b1_, false, false); \
    u32x4 w_ = {r0_[0], r1_[0], r0_[1], r1_[1]}; OUT = __builtin_bit_cast(bf16x8, w_); } while (0)

struct Args { const float* in[14]; float* out; unsigned char* ws; int ph_lo, ph_hi; };
#define LAUNDER_S(p) asm volatile("" : "+s"(p))
struct Frame {
    LAS unsigned char* lds; volatile LAS unsigned* MISC; gu32* ctl;
    int tid, lane, wave, vcu, G;
    GAS float* out; GAS unsigned char* ws;
};
#define WSP(T, off) ((GAS T*)(F.ws + (off)))
#ifdef DIAG_A
#define STAMP(k) do { if (blockIdx.x == 0 && F.tid == 0) __hip_atomic_store((unsigned*)(F.ctl + 12288 + (k)), (unsigned)__builtin_amdgcn_s_memrealtime(), __ATOMIC_RELAXED, __HIP_MEMORY_SCOPE_AGENT); } while (0)
#else
#define STAMP(k) do { } while (0)
#endif
__device__ __forceinline__ const GAS float* inp(Frame& F, int k) {
    volatile LAS unsigned* t = (volatile LAS unsigned*)(F.lds + LDSCTL_OFF + 1024) + 2 * k;
    const unsigned lo = __builtin_amdgcn_readfirstlane(t[0]), hi = __builtin_amdgcn_readfirstlane(t[1]);
    return (const GAS float*)(((unsigned long long)hi << 32) | lo);
}
__device__ __forceinline__ bool phase_enter(Frame& F) { LAUNDER_S(F.ws); LAUNDER_S(F.out); asm volatile("" : "+v"(F.tid)); F.lane = F.tid & 63; F.wave = __builtin_amdgcn_readfirstlane(F.tid >> 6); return true; }

__device__ __forceinline__ int map_w1(int d) {
    const int tile = d >> 8, r = d & 255;
    if (tile < 12) return d;
    if (tile < 20) { const int t = tile - 12; return r < 128 ? 3072 + 128 * t + r : 4096 + 128 * t + (r - 128); }
    return 5136 + (d - 5120);
}
__device__ __forceinline__ int map_w3(int d) {
    const int tile = d >> 8, r = d & 255;
    if (tile < 10) return d;
    if (tile < 18) { const int t = tile - 10; return r < 128 ? 3584 + 128 * t + r : 4608 + 128 * t + (r - 128); }
    { const int t = tile - 18; return r < 128 ? 2560 + 128 * t + r : 5632 + 128 * t + (r - 128); }
}
__device__ __forceinline__ void transpose_item(const GAS float* W, int ldw, int K, GAS bf16_t* WT, int drow0, int scol0, const GAS float* gain, LAS float* scr, int kb, int lane) {
    const int k0 = 64 * kb;
#pragma unroll 8
    for (int i = 0; i < 32; ++i) { const int kk = 2 * i + (lane >> 5); const float gs = gain ? gain[k0 + kk] : 1.f; scr[kk * 33 + (lane & 31)] = W[(size_t)(k0 + kk) * ldw + scol0 + (lane & 31)] * gs; }
    LDS_WAIT(); asm volatile("" ::: "memory");
    const int c = lane & 7;
#pragma unroll
    for (int j = 0; j < 4; ++j) { const int n = (lane >> 3) + 8 * j; const LAS float* s = scr + (8 * c) * 33 + n;
        v4u o; o.x = cvt_pk_bf16(s[0 * 33], s[1 * 33]); o.y = cvt_pk_bf16(s[2 * 33], s[3 * 33]); o.z = cvt_pk_bf16(s[4 * 33], s[5 * 33]); o.w = cvt_pk_bf16(s[6 * 33], s[7 * 33]);
        *(GAS v4u*)(WT + (size_t)(drow0 + n) * K + k0 + 8 * c) = o; }
    LDS_WAIT(); asm volatile("" ::: "memory");
}
__device__ __forceinline__ float logsigmoidf_(float x) { return fminf(x, 0.f) - log1pf(expf(-fabsf(x))); }
__device__ __forceinline__ void p0_prologue(Frame& F, const Args& A_) {
    LAS float* scr = (LAS float*)(F.lds + F.wave * 16384);
    const int gw = F.vcu * NWAVES + F.wave, NGW = F.G * NWAVES;
    constexpr int I_W1 = 16 * 288, I_W2 = 32 * 32, I_W4 = 32 * 32;
    for (int it = gw; it < I_W1 + I_W2 + I_W4; it += NGW) {
        int r = it;
        if (r < I_W1) { const int kb = r / 288, d = 32 * (r % 288); transpose_item(inp(F, 3), EVEN_IN, 1024, WSP(bf16_t, WS_W1T), d, map_w1(d), nullptr, scr, kb, F.lane); continue; } r -= I_W1;
        if (r < I_W2) { const int kb = r / 32, d = 32 * (r % 32); transpose_item(inp(F, 5), 1024, 2048, WSP(bf16_t, WS_W2T), d, d, nullptr, scr, kb, F.lane); continue; } r -= I_W2;
        { const int kb = r / 32, d = 32 * (r % 32); transpose_item(inp(F, 9), 1024, 2048, WSP(bf16_t, WS_W4T), d, d, nullptr, scr, kb, F.lane); }
    }
    { const int gt = blockIdx.x * NTHR + F.tid;
      if (gt < 6144) { const int isc = gt >= 4096; const int e = isc ? gt - 4096 : gt; const int pos = e >> 5, i = e & 31;
          const float inv = powf(10000.f, -(float)i / 32.f); const float ang = (float)pos * inv;
          GAS float* tb = WSP(float, WS_ROPE) + (isc ? 8192 : 0); tb[e * 2] = cosf(ang); tb[e * 2 + 1] = sinf(ang); } }
    __syncthreads();
    LAS float* wg = (LAS float*)F.lds;
    { const GAS float* W = inp(F, 3); const GAS float* g0 = inp(F, 1);
      for (int idx = F.tid; idx < 16384; idx += NTHR) { const int k = idx >> 4, j = idx & 15; wg[k * 17 + j] = g0[k] * W[(size_t)k * EVEN_IN + 5120 + j]; } }
    __syncthreads();
    const GAS float* x = inp(F, 0); const GAS float* g0 = inp(F, 1); const GAS float* gb = inp(F, 4);
    GAS bf16_t* U0 = WSP(bf16_t, WS_U0); GAS float* rs0 = WSP(float, WS_RS0); GAS float* gates = WSP(float, WS_GATES);
    for (int task = F.wave * F.G + F.vcu; task < M / 16; task += NGW) {
        const int i = F.lane & 15, kk = F.lane >> 4; const int row = task * 16 + i;
        const GAS float* xr = x + (size_t)row * 1024 + 4 * kk; GAS bf16_t* ur = U0 + (size_t)row * 1024 + 4 * kk;
        f32x4 acc = {0.f, 0.f, 0.f, 0.f}; float ss = 0.f;
#pragma unroll 4
        for (int s = 0; s < 64; ++s) {
            const f32x4 xv = *(const GAS f32x4*)(xr + 16 * s); const f32x4 gv = *(const GAS f32x4*)(g0 + 16 * s + 4 * kk);
            ss += (xv[0] * xv[0] + xv[1] * xv[1]) + (xv[2] * xv[2] + xv[3] * xv[3]);
            u32x2 w; w.x = cvt_pk_bf16(xv[0] * gv[0], xv[1] * gv[1]); w.y = cvt_pk_bf16(xv[2] * gv[2], xv[3] * gv[3]); *(GAS u32x2*)(ur + 16 * s) = w;
#pragma unroll
            for (int e = 0; e < 4; ++e) { const float bv = wg[(16 * s + 4 * kk + e) * 17 + i]; acc = __builtin_amdgcn_mfma_f32_16x16x4f32(xv[e], bv, acc, 0, 0, 0); }
        }
        ss += __shfl_xor(ss, 16); ss += __shfl_xor(ss, 32);
        const float r = 1.0f / sqrtf(ss * (1.f / 1024.f) + RMS_EPS);
        if (kk == 0) { rs0[row] = r; WSP(float, WS_PART)[row] = 0.f; }
        const int j = i, gi = j >> 2, hh = j & 3; const float bias = gb[j];
        f32x4 gv;
#pragma unroll
        for (int reg = 0; reg < 4; ++reg) { const float rr = __shfl(r, 4 * kk + reg); float g = acc[reg] * rr + bias; if (gi & 1) g = logsigmoidf_(g); gv[reg] = g; }
        const int row0 = task * 16 + 4 * kk; const int b = row0 >> 13, t = row0 & 8191;
        *(GAS f32x4*)(gates + ((size_t)((gi * 2 + b) * 4 + hh)) * 8192 + t) = gv;
    }
}

constexpr int L_TAB = 0, L_KIMG = 16384, L_VIMG = 50176, L_CIMG = 66560;
constexpr int T_IGF = 0, T_LFF = 256, T_IGB = 512, T_LFB = 768, T_BF = 1024, T_CB = 1280, T_X0 = 1536, T_X1 = 1792, T_X2 = 2048, T_X3 = 2304, T_AF2 = 3072, T_AB2 = 3328, T_NF = 3584, T_NB = 3840;
template <int OP> __device__ __forceinline__ float scan256(float v, LAS float* scr, int tid) {
    const int lane = tid & 63, w = tid >> 6;
#pragma unroll
    for (int o = 1; o < 64; o <<= 1) { const float t = __shfl_up(v, o); if (lane >= o) v = OP ? fmaxf(v, t) : v + t; }
    if (lane == 63) scr[w] = v;
    __syncthreads();
    const int w0 = w & 4;
    float pre = OP ? -3.0e38f : 0.f;
    for (int k = w0; k < w; ++k) pre = OP ? fmaxf(pre, scr[k]) : pre + scr[k];
    v = OP ? fmaxf(v, pre) : v + pre;
    __syncthreads();
    return v;
}
__device__ __forceinline__ void gate_tables(LAS float* T, const GAS float* gates, int b, int h, int c, int tid) {
    const int t = tid < 256 ? tid : 511 - tid;
    float ig, lf;
    if (tid < 256) { ig = gates[((size_t)((0 * 2 + b) * 4 + h)) * 8192 + c * 256 + t]; lf = gates[((size_t)((1 * 2 + b) * 4 + h)) * 8192 + c * 256 + t]; T[T_IGF + t] = ig; T[T_LFF + t] = lf; }
    else           { ig = gates[((size_t)((2 * 2 + b) * 4 + h)) * 8192 + c * 256 + t]; lf = gates[((size_t)((3 * 2 + b) * 4 + h)) * 8192 + c * 256 + t]; T[T_IGB + t] = ig; T[T_LFB + t] = lf; }
    const float cs = scan256<0>(lf, T + 2560, tid);
    T[(tid < 256 ? T_BF : T_CB) + t] = cs;
    __syncthreads();
}
#define GLD8(base, boff) (*(const GAS bf16x8*)((const GAS char*)(base) + (size_t)(unsigned)(boff)))
#define GP16(base, boff) (*(GAS bf16_t*)((GAS char*)(base) + (size_t)(unsigned)(boff)))
#define GPC16(base, boff) (*(const GAS bf16_t*)((const GAS char*)(base) + (size_t)(unsigned)(boff)))
__device__ __forceinline__ void stage_k256(LAS unsigned char* L, const GAS bf16_t* src, int ld, unsigned kgo, unsigned klo) {
#pragma unroll
    for (int i = 0; i < 4; ++i) *(LAS bf16x8*)(L + L_KIMG + klo + i * (16 * 528)) = GLD8(src + (size_t)(16 * i) * ld, kgo);
}
__device__ __forceinline__ void x1_unit(Frame& F, const Args& A_, int unit) {
    const int bh = unit >> 5, c = unit & 31, b = bh >> 2, h = bh & 3;
    int tid = F.tid; asm volatile("" : "+v"(tid)); const int lane = tid & 63, wave = F.wave, r32 = lane & 31, hi = lane >> 5;
    LAS unsigned char* L = F.lds; LAS float* T = (LAS float*)(L + L_TAB);
    const size_t grow0 = (size_t)b * SEQ + c * 256;
    const GAS bf16_t* kb = WSP(bf16_t, WS_A1) + ((size_t)h * M + grow0) * 256; const GAS bf16_t* vb = WSP(bf16_t, WS_A2) + ((size_t)h * M + grow0) * 256;
    GAS bf16_t* states = (GAS bf16_t*)F.out; GAS float* nst = WSP(float, WS_NST); GAS float* chsc = WSP(float, WS_CHSC);
    LAUNDER_S(kb); LAUNDER_S(vb); LAUNDER_S(states); LAUNDER_S(nst);
    gate_tables(T, WSP(float, WS_GATES), b, h, c, tid);
    const float Gf = T[T_BF + 255], Gb = T[T_CB + 0];
    if (tid < 256) { T[T_X0 + tid] = Gf - T[T_BF + tid] + T[T_IGF + tid]; T[T_X1 + tid] = Gb - T[T_CB + tid] + T[T_IGB + tid]; }
    __syncthreads();
    float mlf, mlb;
    { const int t = tid < 256 ? tid : 511 - tid; (void)scan256<1>(T[(tid < 256 ? T_X0 : T_X1) + t], T + 2560, tid);
      mlf = fmaxf(fmaxf(T[2560], T[2561]), fmaxf(T[2562], T[2563])); mlb = fmaxf(fmaxf(T[2564], T[2565]), fmaxf(T[2566], T[2567])); }
    __syncthreads();
    if (tid < 256) { T[T_X2 + tid] = expf(T[T_X0 + tid] - mlf); T[T_X3 + tid] = expf(T[T_X1 + tid] - mlb); }
    if (tid == 0) { GAS float* p = chsc + (size_t)((0 * 8 + bh) * 32 + c) * 4; p[0] = Gf; p[1] = mlf; GAS float* q = chsc + (size_t)((1 * 8 + bh) * 32 + c) * 4; q[0] = Gb; q[1] = mlb; }
    __syncthreads();
    const int sr = tid >> 4, sc8 = (tid & 15) * 8;
    const unsigned go = (unsigned)(sr * 256 + sc8) * 2u; const unsigned lo0 = (unsigned)v_st(sr, sc8), lo1 = (unsigned)v_st(32 + sr, sc8);
    LAS unsigned char* rdk = L + L_KIMG + v_rd_base(lane); LAS unsigned char* rdv = L + L_VIMG + (wave >> 2) * 16384 + (wave & 3) * 512 + v_rd_base(lane);
#pragma unroll 1
    for (int dir = 0; dir < 2; ++dir) {
        f32x16 acc[8];
#pragma unroll
        for (int j = 0; j < 8; ++j) acc[j] = f32x16{};
        float dn = 0.f; const int wofs = dir ? T_X3 : T_X2;
#pragma unroll 1
        for (int t4 = 0; t4 < 4; ++t4) {
            const GAS bf16_t* kt = kb + (size_t)(t4 * 64) * 256; const GAS bf16_t* vt = vb + (size_t)(t4 * 64) * 256;
#pragma unroll
            for (int half = 0; half < 2; ++half)
#pragma unroll
                for (int q = 0; q < 2; ++q) {
                    const bf16x8 kv = GLD8(kt + (size_t)(32 * q) * 256 + half * 128, go);
                    const bf16x8 vv = GLD8(vt + (size_t)(32 * q) * 256 + half * 128, go);
                    const float w = T[wofs + t4 * 64 + sr + 32 * q];
                    u32x4 pv; pv.x = cvt_pk_bf16(bf2f(vv[0]) * w, bf2f(vv[1]) * w); pv.y = cvt_pk_bf16(bf2f(vv[2]) * w, bf2f(vv[3]) * w); pv.z = cvt_pk_bf16(bf2f(vv[4]) * w, bf2f(vv[5]) * w); pv.w = cvt_pk_bf16(bf2f(vv[6]) * w, bf2f(vv[7]) * w);
                    *(LAS bf16x8*)(L + L_KIMG + half * 16384 + (q ? lo1 : lo0)) = kv;
                    *(LAS u32x4*)(L + L_VIMG + half * 16384 + (q ? lo1 : lo0)) = pv; }
            __syncthreads();
#pragma unroll
            for (int ks = 0; ks < 4; ++ks) { const bf16x8 Af = tr_frag(rdv, 0, ks);
#pragma unroll
                for (int j = 0; j < 8; ++j) { const bf16x8 Bf = tr_frag(rdk + (j >> 2) * 16384, j & 3, ks); acc[j] = __builtin_amdgcn_mfma_f32_32x32x16_bf16(Af, Bf, acc[j], 0, 0, 0); } }
            if (tid < 256) { const int k = tid; LAS unsigned char* kp = L + L_KIMG + (k >> 7) * 16384 + (((k & 127) >> 5) * 512 + (k & 31) * 2);
#pragma unroll 8
                for (int key = 0; key < 64; ++key) { const int kk = (key & ~0xC) | ((key & 4) << 1) | ((key & 8) >> 1);
                    dn += T[wofs + t4 * 64 + key] * bf2f(*(LAS bf16_t*)(kp + (kk >> 3) * 2048 + (kk & 7) * 64)); } }
            __syncthreads();
        }
        GAS bf16_t* dst = states + (size_t)((dir * 8 + bh) * 32 + c) * 65536 + (size_t)(32 * wave) * 256;
        const unsigned so = (unsigned)(4 * hi * 256 + r32) * 2u;
#pragma unroll
        for (int r = 0; r < 16; ++r) {
#pragma unroll
            for (int j = 0; j < 8; ++j) GP16(dst, so + ((r & 3) + 8 * (r >> 2)) * 512 + 64 * j) = f2b(acc[j][r]);
            if ((r & 3) == 3) asm volatile("" ::: "memory"); }
        if (tid < 256) nst[(size_t)((dir * 8 + bh) * 32 + c) * 256 + tid] = dn;
    }
    __syncthreads();
}
__device__ __forceinline__ void x2_scan(Frame& F) {
    const int bid = F.vcu, tid = F.tid; LAS float* T = (LAS float*)(F.lds);
    GAS bf16_t* states = (GAS bf16_t*)F.out; GAS float* nst = WSP(float, WS_NST); GAS float* chsc = WSP(float, WS_CHSC);
#pragma unroll 1
    for (int blk = bid; blk < 256; blk += F.G) {
        const int chain = blk >> 4, dir = chain >> 3; const bool first = (blk & 15) == 0;
        if (tid == 0) { float m = -1e30f;
            for (int i = 0; i < 32; ++i) { const int c = dir ? 31 - i : i; GAS float* p = chsc + (size_t)(chain * 32 + c) * 4; const float G = p[0], ml = p[1];
                if (first) p[2] = m; const float mo = fmaxf(G + m, ml); T[i] = expf(G + m - mo); T[32 + i] = expf(ml - mo); m = mo; } }
        __syncthreads();
        const unsigned e8 = (unsigned)((blk & 15) * 512 + tid) * 16u;
        float st[8];
#pragma unroll
        for (int j = 0; j < 8; ++j) st[j] = 0.f;
        GAS bf16_t* cb = states + (size_t)(chain * 32) * 65536;
#pragma unroll 4
        for (int i = 0; i < 32; ++i) { const int c = dir ? 31 - i : i; GAS bf16_t* p = (GAS bf16_t*)((GAS char*)(cb + (size_t)c * 65536) + (size_t)e8);
            const bf16x8 d = *(const GAS bf16x8*)p; const float so = T[i], sw = T[32 + i];
            u32x4 w; w.x = cvt_pk_bf16(st[0], st[1]); w.y = cvt_pk_bf16(st[2], st[3]); w.z = cvt_pk_bf16(st[4], st[5]); w.w = cvt_pk_bf16(st[6], st[7]); *(GAS u32x4*)p = w;
#pragma unroll
            for (int j = 0; j < 8; ++j) st[j] = so * st[j] + sw * bf2f(d[j]); }
        if (first && tid < 256) { float sn = 0.f;
            for (int i = 0; i < 32; ++i) { const int c = dir ? 31 - i : i; GAS float* p = nst + (size_t)(chain * 32 + c) * 256 + tid; const float d = *p; *p = sn; sn = T[i] * sn + T[32 + i] * d; } }
        __syncthreads();
    }
}
template <int NK> __device__ __forceinline__ void st_tile(f32x16& p0, f32x16& p1, LAS unsigned char* kp, const bf16x8* qr) {
    p0 = f32x16{}; p1 = f32x16{};
#pragma unroll
    for (int d0 = 0; d0 < NK; ++d0) { const bf16x8 b0 = *(const LAS bf16x8*)(kp + 32 * d0), b1 = *(const LAS bf16x8*)(kp + 32 * 528 + 32 * d0);
        p0 = __builtin_amdgcn_mfma_f32_32x32x16_bf16(b0, qr[d0], p0, 0, 0, 0); p1 = __builtin_amdgcn_mfma_f32_32x32x16_bf16(b1, qr[d0], p1, 0, 0, 0); }
}
constexpr int X3_KB0 = 16384, X3_KBS = 33280, X3_VB0 = X3_KB0 + 2 * X3_KBS  , X3_VBS = 16384;
static_assert(X3_VB0 + 2 * X3_VBS <= LDSCTL_OFF, "X3 LDS map");
#define GLDS16(gp, lp) __builtin_amdgcn_global_load_lds((const GAS unsigned*)(gp), (LAS unsigned*)(lp), 16, 0, 0)
__device__ __forceinline__ void dma_rows64(const GAS bf16_t* src, LAS unsigned char* ldsbuf, int wave, unsigned lane_off) {
    const GAS char* g = (const GAS char*)src + (size_t)(wave * 4096u) + (size_t)lane_off;
#pragma unroll
    for (int i = 0; i < 4; ++i) GLDS16(g + i * 1024, ldsbuf + (wave * 4 + i) * 1040);
}
__device__ __forceinline__ void dma_v64(const GAS bf16_t* src, LAS unsigned char* ldsbuf, int wave, const unsigned (&voff)[2]) {
#pragma unroll
    for (int i = 0; i < 2; ++i) GLDS16((const GAS char*)src + (size_t)voff[i], ldsbuf + (wave * 2 + i) * 1024);
}
template <int NK> __device__ __forceinline__ void st_tile2(f32x16& p0, f32x16& p1, LAS unsigned char* kp, const bf16x8* qr) {
    p0 = f32x16{}; p1 = f32x16{};
#pragma unroll
    for (int d0 = 0; d0 < NK; ++d0) { const bf16x8 b0 = *(const LAS bf16x8*)(kp + 32 * d0), b1 = *(const LAS bf16x8*)(kp + 16 * 1040 + 32 * d0);
        p0 = __builtin_amdgcn_mfma_f32_32x32x16_bf16(b0, qr[d0], p0, 0, 0, 0); p1 = __builtin_amdgcn_mfma_f32_32x32x16_bf16(b1, qr[d0], p1, 0, 0, 0); }
}
__device__ __forceinline__ void x3_unit(Frame& F, const Args& A_, int unit) {
    const int bh = unit >> 5, c = unit & 31, b = bh >> 2, h = bh & 3;
    int tid = F.tid; asm volatile("" : "+v"(tid)); const int lane = tid & 63, wave = F.wave, r32 = lane & 31, hi = lane >> 5;
    LAS unsigned char* L = F.lds; LAS float* T = (LAS float*)(L + L_TAB);
    const size_t grow0 = (size_t)b * SEQ + c * 256;
    const GAS bf16_t* qb = WSP(bf16_t, WS_A0) + ((size_t)h * M + grow0) * 256; const GAS bf16_t* kb = WSP(bf16_t, WS_A1) + ((size_t)h * M + grow0) * 256;
    const GAS bf16_t* vb = WSP(bf16_t, WS_A2) + ((size_t)h * M + grow0) * 256; const GAS bf16_t* gb = WSP(bf16_t, WS_A3) + ((size_t)h * M + grow0 + 32 * wave) * 256;
    const GAS bf16_t* states = (const GAS bf16_t*)F.out + (size_t)(bh * 32 + c) * 65536;
    const GAS float* nst = WSP(float, WS_NST); const GAS float* chsc = WSP(float, WS_CHSC);
    GAS bf16_t* mb0 = WSP(bf16_t, WS_MIX0) + (grow0 + 32 * wave) * 2048 + h * 256;
    const GAS float* ng = inp(F, 6) + h * 256;
    LAUNDER_S(qb); LAUNDER_S(kb); LAUNDER_S(vb); LAUNDER_S(gb); LAUNDER_S(mb0); LAUNDER_S(states);
    const unsigned lane_off = (unsigned)((lane >> 5) * 512 + (lane & 31) * 16);
    dma_rows64(kb, L + X3_KB0, wave, lane_off);
    gate_tables(T, WSP(float, WS_GATES), b, h, c, tid);
    if (tid < 256) { T[T_X0 + tid] = T[T_IGF + tid] - T[T_BF + tid]; T[T_NF + tid] = nst[(size_t)((0 * 8 + bh) * 32 + c) * 256 + tid]; }
    else { const int t = tid - 256; T[T_X1 + t] = T[T_IGB + t] - T[T_CB + t]; T[T_NB + t] = nst[(size_t)((1 * 8 + bh) * 32 + c) * 256 + t]; }
    const float mf = chsc[(size_t)((0 * 8 + bh) * 32 + c) * 4 + 2], mb = chsc[(size_t)((1 * 8 + bh) * 32 + c) * 4 + 2];
    __syncthreads();
    { const int t = tid < 256 ? tid : 511 - tid; const float pm = scan256<1>(T[(tid < 256 ? T_X0 : T_X1) + t], T + 2560, tid);
      T[(tid < 256 ? T_X2 : T_X3) + t] = fmaxf(pm, tid < 256 ? mf : mb); }
    const int tq = 32 * wave + r32;
    bf16x8 qr[16];
    { const unsigned qo = (unsigned)(tq * 256 + 8 * hi) * 2u;
#pragma unroll
      for (int d0 = 0; d0 < 16; ++d0) qr[d0] = GLD8(qb + 16 * d0, qo); }
    __syncthreads();
    STAMP(20);
    const float Rf = T[T_X2 + tq], Rb = T[T_X3 + tq];
    const unsigned kpo = (unsigned)((r32 >> 1) * 1040 + (r32 & 1) * 512 + 16 * hi);
    float denf = 0.f, denb = 0.f;
#pragma unroll 1
    for (int j = 0; j < 4; ++j) {
        if (j < 3) dma_rows64(kb + (size_t)(64 * (j + 1)) * 256, L + X3_KB0 + ((j + 1) & 1) * X3_KBS, wave, lane_off);
        else       dma_rows64(states + (size_t)0, L + X3_KB0, wave, lane_off);
        f32x16 p0, p1; st_tile2<16>(p0, p1, L + X3_KB0 + (j & 1) * X3_KBS + kpo, qr);
        LAS float* tf = T + T_X0 + 64 * j + 4 * hi; LAS float* tb = T + T_X1 + 64 * j + 4 * hi; const int sb0 = 64 * j + 4 * hi;
#pragma unroll
        for (int r = 0; r < 16; ++r) { const int cr = (r & 3) + 8 * (r >> 2);
            const float uf0 = tf[cr], uf1 = tf[cr + 32], ub0 = tb[cr], ub1 = tb[cr + 32];
            const float ef0 = fexp(uf0 - Rf), ef1 = fexp(uf1 - Rf), eb0 = fexp(ub0 - Rb), eb1 = fexp(ub1 - Rb);
            const int s0 = sb0 + cr, s1 = s0 + 32;
            denf += ((s0 <= tq) ? ef0 : 0.f) * p0[r] + ((s1 <= tq) ? ef1 : 0.f) * p1[r];
            denb += ((s0 >= tq) ? eb0 : 0.f) * p0[r] + ((s1 >= tq) ? eb1 : 0.f) * p1[r];
            if ((r & 3) == 3) asm volatile("" ::: "memory"); }
        __syncthreads();
    }
    STAMP(21);
    denf = swap_add(denf); denb = swap_add(denb);
    float nqf = 0.f, nqb = 0.f;
#pragma unroll
    for (int d0 = 0; d0 < 16; ++d0) {
#pragma unroll
        for (int jj = 0; jj < 8; ++jj) { const float qv = bf2f(qr[d0][jj]); nqf += qv * T[T_NF + 16 * d0 + 8 * hi + jj]; nqb += qv * T[T_NB + 16 * d0 + 8 * hi + jj]; }
        asm volatile("" ::: "memory"); }
    nqf = swap_add(nqf); nqb = swap_add(nqb);
    float sf, sb;
    { const float ef = fexp(mf - Rf), eb = fexp(mb - Rb);
      const float dtf = ef * nqf + denf, dtb = eb * nqb + denb;
      sf = 1.f / fmaxf(fabsf(dtf), expf(-T[T_BF + tq] - Rf)); sb = 1.f / fmaxf(fabsf(dtb), expf(-T[T_CB + tq] - Rb));
      if (hi == 0) { T[T_AF2 + tq] = ef * sf; T[T_AB2 + tq] = eb * sb; } }
    __syncthreads();
    STAMP(22);
    unsigned voff[2];
#pragma unroll
    for (int i = 0; i < 2; ++i) { const int st = 2 * (2 * wave + i) + (lane >> 5), kk = 8 * (st >> 2) + ((lane >> 2) & 7), key = (kk & ~0xC) | ((kk & 4) << 1) | ((kk & 8) >> 1);
        voff[i] = (unsigned)(key * 256 + 32 * (st & 3) + 8 * (lane & 3)) * 2u; }
    f32x16 o[4];
#pragma unroll 1
    for (int dvh = 0; dvh < 2; ++dvh) {
#pragma unroll
        for (int d = 0; d < 4; ++d) o[d] = f32x16{};
#pragma unroll 1
        for (int p = 0; p < 4; ++p) {
            if (p < 3) dma_rows64(states + (size_t)((p + 1) >> 1) * (8 * 32 * 65536) + (size_t)(128 * dvh + 64 * ((p + 1) & 1)) * 256, L + X3_KB0 + ((p + 1) & 1) * X3_KBS, wave, lane_off);
            else { dma_rows64(kb, L + X3_KB0, wave, lane_off); dma_v64(vb + 128 * dvh, L + X3_VB0, wave, voff); }
            LAS unsigned char* cp = L + X3_KB0 + (p & 1) * X3_KBS + kpo;
            LAS float* ta = T + ((p >> 1) ? T_AB2 : T_AF2) + 32 * wave + 4 * hi;
#pragma unroll
            for (int dd = 0; dd < 2; ++dd) { f32x16 tmp = f32x16{};
#pragma unroll
                for (int d0 = 0; d0 < 16; ++d0) { const bf16x8 Bf = *(const LAS bf16x8*)(cp + dd * (16 * 1040) + 32 * d0); tmp = __builtin_amdgcn_mfma_f32_32x32x16_bf16(qr[d0], Bf, tmp, 0, 0, 0); }
                if (p & 1) {
#pragma unroll
                    for (int r = 0; r < 16; ++r) o[2 + dd][r] += tmp[r] * ta[(r & 3) + 8 * (r >> 2)];
                } else {
#pragma unroll
                    for (int r = 0; r < 16; ++r) o[dd][r] += tmp[r] * ta[(r & 3) + 8 * (r >> 2)];
                } }
            __syncthreads();
        }
        STAMP(23 + 3 * dvh);
#pragma unroll 1
        for (int j = 0; j < 4; ++j) {
            if (j < 3) { dma_rows64(kb + (size_t)(64 * (j + 1)) * 256, L + X3_KB0 + ((j + 1) & 1) * X3_KBS, wave, lane_off); dma_v64(vb + (size_t)(64 * (j + 1)) * 256 + 128 * dvh, L + X3_VB0 + ((j + 1) & 1) * X3_VBS, wave, voff); }
            else if (dvh == 0) dma_rows64(states + (size_t)128 * 256, L + X3_KB0, wave, lane_off);
            f32x16 p0, p1; st_tile2<16>(p0, p1, L + X3_KB0 + (j & 1) * X3_KBS + kpo, qr);
            LAS float* tf = T + T_X0 + 64 * j + 4 * hi; LAS float* tb = T + T_X1 + 64 * j + 4 * hi; const int sb0 = 64 * j + 4 * hi;
#pragma unroll
            for (int r = 0; r < 16; ++r) { const int cr = (r & 3) + 8 * (r >> 2);
                const float uf0 = tf[cr], uf1 = tf[cr + 32], ub0 = tb[cr], ub1 = tb[cr + 32];
                const float ef0 = fexp(uf0 - Rf) * sf, ef1 = fexp(uf1 - Rf) * sf, eb0 = fexp(ub0 - Rb) * sb, eb1 = fexp(ub1 - Rb) * sb;
                const int s0 = sb0 + cr, s1 = s0 + 32;
                p0[r] *= ((s0 <= tq) ? ef0 : 0.f) + ((s0 >= tq) ? eb0 : 0.f);
                p1[r] *= ((s1 <= tq) ? ef1 : 0.f) + ((s1 >= tq) ? eb1 : 0.f);
                if ((r & 3) == 3) asm volatile("" ::: "memory"); }
            bf16x8 pa0, pa1, pa2, pa3;
            PK4(p0, 0, pa0); PK4(p0, 8, pa1); PK4(p1, 0, pa2); PK4(p1, 8, pa3);
            LAS unsigned char* rdv = L + X3_VB0 + (j & 1) * X3_VBS + v_rd_base(lane);
#pragma unroll
            for (int d = 0; d < 4; ++d) {
                o[d] = __builtin_amdgcn_mfma_f32_32x32x16_bf16(pa0, tr_frag(rdv, d, 0), o[d], 0, 0, 0);
                o[d] = __builtin_amdgcn_mfma_f32_32x32x16_bf16(pa1, tr_frag(rdv, d, 1), o[d], 0, 0, 0);
                o[d] = __builtin_amdgcn_mfma_f32_32x32x16_bf16(pa2, tr_frag(rdv, d, 2), o[d], 0, 0, 0);
                o[d] = __builtin_amdgcn_mfma_f32_32x32x16_bf16(pa3, tr_frag(rdv, d, 3), o[d], 0, 0, 0); }
            __syncthreads();
        }
        STAMP(24 + 3 * dvh);
        int l_ = lane; asm volatile("" : "+v"(l_));
        const unsigned oo = (unsigned)(4 * (l_ >> 5) * 2048 + (l_ & 31)) * 2u, go_ = (unsigned)(4 * (l_ >> 5) * 256 + (l_ & 31)) * 2u;
        if (dvh == 0) {
#pragma unroll
            for (int r = 0; r < 16; ++r) { unsigned ro = oo + ((r & 3) + 8 * (r >> 2)) * 4096; asm volatile("" : "+v"(ro));
#pragma unroll
                for (int d = 0; d < 4; ++d) GP16(mb0, ro + 64 * d) = f2b(o[d][r]);
                if ((r & 3) == 3) asm volatile("" ::: "memory"); }
        }
        STAMP(25 + 3 * dvh);
    }
    {
        int l_ = lane; asm volatile("" : "+v"(l_));
        const unsigned oo = (unsigned)(4 * (l_ >> 5) * 2048 + (l_ & 31)) * 2u, go_ = (unsigned)(4 * (l_ >> 5) * 256 + (l_ & 31)) * 2u;
            asm volatile("s_waitcnt vmcnt(0)" ::: "memory");
            float ngv[8];
#pragma unroll
            for (int d = 0; d < 4; ++d) { ngv[d] = ng[32 * d + r32]; ngv[4 + d] = ng[128 + 32 * d + r32]; }
#pragma unroll
            for (int rb = 0; rb < 16; rb += 8) {
                unsigned h0[4][8], g1[4][8];
#pragma unroll
                for (int q = 0; q < 8; ++q) { const int r = rb + q; const unsigned ro = oo + ((r & 3) + 8 * (r >> 2)) * 4096, rg = go_ + ((r & 3) + 8 * (r >> 2)) * 512;
#pragma unroll
                    for (int d = 0; d < 4; ++d) { h0[d][q] = GP16(mb0, ro + 64 * d); g1[d][q] = GPC16(gb, rg + 256 + 64 * d); } }
                float rinv[8];
#pragma unroll
                for (int q = 0; q < 8; ++q) { const int r = rb + q; float s = (o[0][r] * o[0][r] + o[1][r] * o[1][r]) + (o[2][r] * o[2][r] + o[3][r] * o[3][r]);
#pragma unroll
                    for (int d = 0; d < 4; ++d) { const float hv = bf2f((bf16_t)h0[d][q]); s += hv * hv; }
                    s += __shfl_xor(s, 1); s += __shfl_xor(s, 2); s += __shfl_xor(s, 4); s += __shfl_xor(s, 8); s += __shfl_xor(s, 16);
                    rinv[q] = 1.0f / sqrtf(s * (1.f / 256.f) + RMS_EPS); }
#pragma unroll
                for (int q = 0; q < 8; ++q) { const int r = rb + q; const unsigned ro = oo + ((r & 3) + 8 * (r >> 2)) * 4096;
#pragma unroll
                    for (int d = 0; d < 4; ++d) GP16(mb0, ro + 256 + 64 * d) = f2b(o[d][r] * rinv[q] * ngv[4 + d] * bf2f((bf16_t)g1[d][q])); }
#pragma unroll
                for (int q = 0; q < 8; ++q) { const int r = rb + q; const unsigned rg = go_ + ((r & 3) + 8 * (r >> 2)) * 512;
#pragma unroll
                    for (int d = 0; d < 4; ++d) g1[d][q] = GPC16(gb, rg + 64 * d); }
#pragma unroll
                for (int q = 0; q < 8; ++q) { const int r = rb + q; const unsigned ro = oo + ((r & 3) + 8 * (r >> 2)) * 4096;
#pragma unroll
                    for (int d = 0; d < 4; ++d) GP16(mb0, ro + 64 * d) = f2b(bf2f((bf16_t)h0[d][q]) * rinv[q] * ngv[d] * bf2f((bf16_t)g1[d][q])); }
                asm volatile("" ::: "memory");
            }
        }
    STAMP(29);
    __syncthreads();
}

constexpr int L_BT = 83968, L_MT = L_BT + 4 * 15 * 128 * 4;
template <int QB> __device__ __forceinline__ void na_scores(f32x16& p0, f32x16& p1, LAS unsigned char* bt, LAS unsigned char* mt, float& m, float& l, float& alpha, bool first) {
    float pmax = -1e30f;
#pragma unroll
    for (int rr = 0; rr < 16; ++rr) { const int cr = (rr & 3) + 8 * (rr >> 2);
        if (QB == 1 && rr < 8) { } else { p0[rr] = (p0[rr] + *(LAS float*)(bt + 4 * cr)) + *(LAS float*)(mt + 4 * cr); pmax = fmaxf(pmax, p0[rr]); }
        if (QB == 0 && rr >= 8) { } else { p1[rr] = (p1[rr] + *(LAS float*)(bt + 4 * (cr + 32))) + *(LAS float*)(mt + 4 * (cr + 32)); pmax = fmaxf(pmax, p1[rr]); } }
    pmax = swap_max(pmax);
    if (first) { m = pmax; alpha = 1.f; }
    else if (__builtin_expect(__all(pmax - m <= 8.f), 1)) { alpha = 1.f; }
    else { const float mn = fmaxf(m, pmax); alpha = fexp(m - mn); m = mn; }
    const float nm = -m * 1.4426950408889634f;
    float ps = 0.f;
#pragma unroll
    for (int rr = 0; rr < 16; ++rr) {
        if (QB == 1 && rr < 8) { } else { p0[rr] = __builtin_amdgcn_exp2f(fmaf(p0[rr], 1.4426950408889634f, nm)); ps += p0[rr]; }
        if (QB == 0 && rr >= 8) { } else { p1[rr] = __builtin_amdgcn_exp2f(fmaf(p1[rr], 1.4426950408889634f, nm)); ps += p1[rr]; } }
    ps = swap_add(ps); l = l * alpha + ps;
}
template <bool LOADS, bool STORE> __device__ __forceinline__ void na_phase(Frame& F, const Args& A_) {
#ifdef PROBE_NAMAP
    const int cu = blockIdx.x;
#else
    const int cu = F.vcu;
#endif
    if (cu >= 256) return;
    const int b = cu >> 7, r = cu & 127;
    int tid = F.tid; asm volatile("" : "+v"(tid)); const int lane = tid & 63, wave = F.wave, r32 = lane & 31, hi = lane >> 5;
    LAS unsigned char* L = F.lds; LAS float* wsf = (LAS float*)(L + 8192) + wave * 64;
    const GAS float* rpb = inp(F, 7);
    const int hd = wave >> 1, qb = wave & 1, cq = 32 * qb + r32;
    const int c0 = min(max(cq - 8, 0), 48), r0 = min(max(r - 4, 0), 120);
    const size_t rowq = (size_t)b * SEQ + r * 64;
    const GAS bf16_t* qbp = WSP(bf16_t, WS_A0) + (rowq + 32 * qb) * 256 + hd * 64;
    const GAS bf16_t* zbp = WSP(bf16_t, WS_A3) + (rowq + 32 * qb) * 256 + hd * 64;
    GAS bf16_t* obp = WSP(bf16_t, WS_MIX0) + (rowq + 32 * qb) * 2048 + 1024 + hd * 64;
    const GAS bf16_t* kbp = WSP(bf16_t, WS_A1) + ((size_t)b * SEQ + (size_t)r0 * 64) * 256;
    const GAS bf16_t* vbp = WSP(bf16_t, WS_A2) + ((size_t)b * SEQ + (size_t)r0 * 64) * 256;
    LAUNDER_S(qbp); LAUNDER_S(zbp); LAUNDER_S(obp); LAUNDER_S(kbp); LAUNDER_S(vbp);
    LAS unsigned char* rdv = L + L_VIMG + (hd >> 1) * 16384 + (2 * (hd & 1)) * 512 + v_rd_base(lane);
    LAS unsigned char* kp = L + L_KIMG + r32 * 528 + 128 * hd + 16 * hi;
    LAS unsigned char* bt0 = L + L_BT + (hd * 15 * 128 + 63 - cq + 4 * hi) * 4;
    LAS unsigned char* mt = L + L_MT + (48 - c0 + 4 * hi) * 4;
    const unsigned kgo = (unsigned)((tid >> 5) * 256 + (tid & 31) * 8) * 2u, klo = (unsigned)((tid >> 5) * 528 + (tid & 31) * 16);
    unsigned vlo[4];
#pragma unroll
    for (int q = 0; q < 4; ++q) { const int key = (tid >> 5) + 16 * q, col8 = (tid & 31) * 8; vlo[q] = (unsigned)((col8 >> 7) * 16384 + v_st(key, col8 & 127)); }
    bf16x8 kst[4], vst[4];
#define NA_FETCH(s_) do { const int hg_ = (s_) >> 3, t_ = (((s_) & 7) - r0) & 7;     const GAS bf16_t* kt_ = kbp + (size_t)hg_ * ((size_t)M * 256) + (size_t)(64 * t_) * 256; const GAS bf16_t* vt_ = vbp + (size_t)hg_ * ((size_t)M * 256) + (size_t)(64 * t_) * 256; \
        _Pragma("unroll") for (int q = 0; q < 4; ++q) { kst[q] = GLD8(kt_ + (size_t)(16 * q) * 256, kgo); vst[q] = GLD8(vt_ + (size_t)(16 * q) * 256, kgo); } } while (0)
#define NA_WRITE() do { _Pragma("unroll") for (int q = 0; q < 4; ++q) { *(LAS bf16x8*)(L + L_KIMG + klo + q * (16 * 528)) = kst[q]; *(LAS bf16x8*)(L + L_VIMG + vlo[q]) = vst[q]; } } while (0)
#define NA_BIAS(hg_) do { for (int idx = tid; idx < 4 * 15 * 128; idx += NTHR) { const int x = idx & 127, hr = idx >> 7; \
        ((LAS float*)(L + L_BT))[idx] = ((unsigned)(x - 48) < 31u) ? rpb[(size_t)((hg_) * 60 + hr) * 31 + (x - 48)] : 0.f; } } while (0)
    NA_FETCH(0);
    if (tid < 128) ((LAS float*)(L + L_MT))[tid] = ((unsigned)(tid - 48) < 16u) ? 0.f : -1e30f;
    NA_BIAS(0);
    __syncthreads();
    NA_WRITE();
    __syncthreads();
    bf16x8 qr[4]; float m = -1e30f, l = 0.f; f32x16 o[2]; o[0] = f32x16{}; o[1] = f32x16{};
#pragma unroll 1
    for (int s = 0; s < 32; ++s) {
        const int hg = s >> 3, tau = s & 7, i = (tau - r0) & 7;
        if (tau == 0) { const unsigned qo = (unsigned)(r32 * 256 + 8 * hi) * 2u;
#pragma unroll
            for (int d0 = 0; d0 < 4; ++d0) qr[d0] = GLD8(qbp + (size_t)hg * ((size_t)M * 256) + 16 * d0, qo);
            l = 0.f; o[0] = f32x16{}; o[1] = f32x16{}; }
        if (LOADS && s + 1 < 32) NA_FETCH(s + 1);
        f32x16 p0, p1; st_tile<4>(p0, p1, kp, qr);
        const int dr = r0 + i - r + 7; LAS unsigned char* bt = bt0 + dr * 512;
        float alpha; bf16x8 pa0, pa1, pa2, pa3;
        if (qb == 0) { na_scores<0>(p0, p1, bt, mt, m, l, alpha, tau == 0); PK4(p0, 0, pa0); PK4(p0, 8, pa1); PK4(p1, 0, pa2); }
        else         { na_scores<1>(p0, p1, bt, mt, m, l, alpha, tau == 0); PK4(p0, 8, pa1); PK4(p1, 0, pa2); PK4(p1, 8, pa3); }
        if (__any(alpha < 1.f)) { if (hi == 0) wsf[r32] = alpha;
#pragma unroll
            for (int d = 0; d < 2; ++d)
#pragma unroll
                for (int rr = 0; rr < 16; ++rr) o[d][rr] *= wsf[crow(rr, hi)]; }
#pragma unroll
        for (int d = 0; d < 2; ++d) {
            if (qb == 1) { } else o[d] = __builtin_amdgcn_mfma_f32_32x32x16_bf16(pa0, tr_frag(rdv, d, 0), o[d], 0, 0, 0);
            o[d] = __builtin_amdgcn_mfma_f32_32x32x16_bf16(pa1, tr_frag(rdv, d, 1), o[d], 0, 0, 0);
            o[d] = __builtin_amdgcn_mfma_f32_32x32x16_bf16(pa2, tr_frag(rdv, d, 2), o[d], 0, 0, 0);
            if (qb == 0) { } else o[d] = __builtin_amdgcn_mfma_f32_32x32x16_bf16(pa3, tr_frag(rdv, d, 3), o[d], 0, 0, 0); }
        if (STORE && tau == 7) {
            if (hi == 0) wsf[32 + r32] = l;
            const unsigned zo = (unsigned)(4 * hi * 256 + r32) * 2u, oo = (unsigned)(4 * hi * 2048 + r32) * 2u + 512u * hg; const GAS bf16_t* zh = zbp + (size_t)hg * ((size_t)M * 256);
#pragma unroll
            for (int rr = 0; rr < 16; ++rr) { const float rli = __builtin_amdgcn_rcpf(wsf[32 + crow(rr, hi)]); const int cr = (rr & 3) + 8 * (rr >> 2);
#pragma unroll
                for (int d = 0; d < 2; ++d) GP16(obp, oo + cr * 4096 + 64 * d) = f2b(o[d][rr] * rli * bf2f(GPC16(zh, zo + cr * 512 + 64 * d)));
                if ((rr & 3) == 3) asm volatile("" ::: "memory"); }
        }
        __syncthreads();
        if (LOADS && s + 1 < 32) { NA_WRITE(); if (tau == 7) NA_BIAS(hg + 1); }
        __syncthreads();
    }
#undef NA_FETCH
#undef NA_WRITE
#undef NA_BIAS
}

__device__ __forceinline__ void p9_krope_conv(Frame& F, const Args& A_) {
    const int gw = F.vcu * NWAVES + F.wave, NGW = F.G * NWAVES, lane = F.lane;
    GAS bf16_t* gk = WSP(bf16_t, WS_GK); const GAS float* kng = inp(F, 11); const GAS float* ropeR = WSP(float, WS_ROPE); const GAS float* ropeC = ropeR + 8192;
    for (int row = gw; row < M; row += NGW) {
        const int hd = lane >> 5, i = lane & 31; GAS bf16_t* p = gk + ((size_t)hd * M + row) * 128 + i;
        float x[4]; float ss = 0.f;
#pragma unroll
        for (int e = 0; e < 4; ++e) { x[e] = bf2f(p[32 * e]); ss += x[e] * x[e]; }
        ss += __shfl_xor(ss, 1); ss += __shfl_xor(ss, 2); ss += __shfl_xor(ss, 4); ss += __shfl_xor(ss, 8); ss += __shfl_xor(ss, 16);
        const float rr = 1.0f / sqrtf(ss * (1.f / 128.f) + RMS_EPS);
#pragma unroll
        for (int e = 0; e < 4; ++e) x[e] = x[e] * rr * kng[32 * e + i];
        const int t = row & 8191, pr = t >> 6, pc = t & 63;
        const float cr = ropeR[(pr * 32 + i) * 2], sr = ropeR[(pr * 32 + i) * 2 + 1], cc = ropeC[(pc * 32 + i) * 2], sc = ropeC[(pc * 32 + i) * 2 + 1];
        p[0] = f2b(x[0] * cr - x[1] * sr); p[32] = f2b(x[0] * sr + x[1] * cr); p[64] = f2b(x[2] * cc - x[3] * sc); p[96] = f2b(x[2] * sc + x[3] * cc);
    }
    const GAS bf16_t* xc = WSP(bf16_t, WS_XC); const GAS bf16_t* cg = WSP(bf16_t, WS_CG); GAS bf16_t* mix1 = WSP(bf16_t, WS_MIX1); const GAS float* cw = inp(F, 12); const GAS float* cbv = inp(F, 13);
    const int gt = F.vcu * NTHR + F.tid, NGT = F.G * NTHR;
    for (int it = gt; it < M * 128; it += NGT) {
        const int row = it >> 7, c8 = (it & 127) * 8, t = row & 8191;
        const bf16x8 z8 = {0, 0, 0, 0, 0, 0, 0, 0};
        const bf16x8 x0 = *(const GAS bf16x8*)(xc + (size_t)row * 1024 + c8);
        const bf16x8 xm = t > 0 ? *(const GAS bf16x8*)(xc + (size_t)(row - 1) * 1024 + c8) : z8;
        const bf16x8 xp = t < SEQ - 1 ? *(const GAS bf16x8*)(xc + (size_t)(row + 1) * 1024 + c8) : z8;
        const bf16x8 g8 = *(const GAS bf16x8*)(cg + (size_t)row * 1024 + c8);
        float y[8];
#pragma unroll
        for (int j = 0; j < 8; ++j) y[j] = bf2f(g8[j]) * (bf2f(xm[j]) * cw[c8 + j] + bf2f(x0[j]) * cw[1024 + c8 + j] + bf2f(xp[j]) * cw[2048 + c8 + j] + cbv[c8 + j]);
        u32x4 w; w.x = cvt_pk_bf16(y[0], y[1]); w.y = cvt_pk_bf16(y[2], y[3]); w.z = cvt_pk_bf16(y[4], y[5]); w.w = cvt_pk_bf16(y[6], y[7]);
        *(GAS u32x4*)(mix1 + (size_t)row * 2048 + 1024 + c8) = w;
    }
}

namespace gqa {
constexpr int D = 128, NW = 8, QBLK = 32, KVBLK = 64, LDQ = 1024, LDK = 128;
constexpr float SCALE = 0.088388347648318440f;
constexpr float THR = 8.f;
constexpr size_t SHM_V = KVBLK * D * 2, SHM_K = KVBLK * D * 2;
#define KSWZ(row, colB) ((row) * 256 + ((colB) ^ (((row) & 7) << 4)))
#define SBAR() __builtin_amdgcn_sched_barrier(0)
__device__ __forceinline__ unsigned cvtpk(float lo, float hi) { unsigned r; asm volatile("v_cvt_pk_bf16_f32 %0, %1, %2" : "=v"(r) : "v"(lo), "v"(hi)); return r; }
__device__ __forceinline__ void partialSM(f32x16& p0, f32x16& p1, float& m_reg, float& mn, float& alpha) {
  constexpr float C = SCALE * 1.4426950408889634f;
  float pmax = p0[0]; for (int r = 1; r < 16; ++r) pmax = fmaxf(pmax, p0[r]); for (int r = 0; r < 16; ++r) pmax = fmaxf(pmax, p1[r]);
  { auto rr = __builtin_amdgcn_permlane32_swap(__float_as_uint(pmax), __float_as_uint(pmax), false, false);
    pmax = fmaxf(__uint_as_float(rr[0]), __uint_as_float(rr[1])); }
  if (__builtin_expect(__all(pmax - m_reg <= THR / SCALE), 1)) { mn = m_reg; alpha = 1.f; }
  else { mn = fmaxf(m_reg, pmax); alpha = __builtin_amdgcn_exp2f((m_reg - mn) * C); m_reg = mn; }
  float mnC = -mn * C;
  for (int r = 0; r < 16; ++r) p0[r] = fmaf(p0[r], C, mnC); for (int r = 0; r < 16; ++r) p1[r] = fmaf(p1[r], C, mnC);
  for (int r = 0; r < 16; ++r) p0[r] = __builtin_amdgcn_exp2f(p0[r]);
}
__device__ __forceinline__ void finishSM(f32x16& p0, f32x16& p1, float alpha, float& l_reg, bf16x8& pa0, bf16x8& pa1, bf16x8& pa2, bf16x8& pa3) {
  for (int r = 0; r < 16; ++r) p1[r] = __builtin_amdgcn_exp2f(p1[r]);
  float ps = 0; for (int r = 0; r < 16; ++r) ps += p0[r]; for (int r = 0; r < 16; ++r) ps += p1[r];
  { auto rr = __builtin_amdgcn_permlane32_swap(__float_as_uint(ps), __float_as_uint(ps), false, false);
    ps = __uint_as_float(rr[0]) + __uint_as_float(rr[1]); }
  l_reg = l_reg * alpha + ps;
#define GPK4(P, BASE, OUT) do { unsigned a0 = cvtpk(P[BASE + 0], P[BASE + 1]), a1 = cvtpk(P[BASE + 2], P[BASE + 3]);   \
    unsigned b0 = cvtpk(P[BASE + 4], P[BASE + 5]), b1 = cvtpk(P[BASE + 6], P[BASE + 7]);                              \
    auto r0 = __builtin_amdgcn_permlane32_swap(a0, b0, false, false); auto r1 = __builtin_amdgcn_permlane32_swap(a1, b1, false, false); \
    u32x4 w = {r0[0], r1[0], r0[1], r1[1]}; OUT = *reinterpret_cast<bf16x8*>(&w); } while (0)
  GPK4(p0, 0, pa0); GPK4(p0, 8, pa1); GPK4(p1, 0, pa2); GPK4(p1, 8, pa3);
#undef GPK4
}
__device__ __forceinline__ void qkt(f32x16& p0, f32x16& p1, const LAS bf16_t* Ks, const bf16x8* qr, int r32, int hi) {
  p0 = f32x16{}; p1 = f32x16{};
  for (int d0 = 0; d0 < 8; ++d0) { int cb = (d0 * 16 + hi * 8) * 2;
    bf16x8 b0 = *(const LAS bf16x8*)((const LAS char*)Ks + KSWZ(r32, cb));
    bf16x8 b1 = *(const LAS bf16x8*)((const LAS char*)Ks + KSWZ(32 + r32, cb));
    p0 = __builtin_amdgcn_mfma_f32_32x32x16_bf16(b0, qr[d0], p0, 0, 0, 0);
    p1 = __builtin_amdgcn_mfma_f32_32x32x16_bf16(b1, qr[d0], p1, 0, 0, 0); }
}
constexpr int v_rd_off(int d0, int ks, int half) { return d0 * 512 + ks * 4096 + half * 2048; }
template <int OFF> __device__ __forceinline__ s16x4 tr_read(int vb) {
  s16x4 r; asm volatile("ds_read_b64_tr_b16 %0, %1 offset:%2" : "=&v"(r) : "v"(vb), "i"(OFF) : "memory"); return r;
}
template <int D0> __device__ __forceinline__ void pv_one(f32x16& od, int vb, bf16x8 pa0, bf16x8 pa1, bf16x8 pa2, bf16x8 pa3) {
  const s16x4 l0 = tr_read<v_rd_off(D0, 0, 0)>(vb), h0 = tr_read<v_rd_off(D0, 0, 1)>(vb), l1 = tr_read<v_rd_off(D0, 1, 0)>(vb), h1 = tr_read<v_rd_off(D0, 1, 1)>(vb);
  const s16x4 l2 = tr_read<v_rd_off(D0, 2, 0)>(vb), h2 = tr_read<v_rd_off(D0, 2, 1)>(vb), l3 = tr_read<v_rd_off(D0, 3, 0)>(vb), h3 = tr_read<v_rd_off(D0, 3, 1)>(vb);
  asm volatile("s_waitcnt lgkmcnt(0)" ::: "memory"); SBAR();
#define PK(L, H) (bf16x8){L[0], L[1], L[2], L[3], H[0], H[1], H[2], H[3]}
  od = __builtin_amdgcn_mfma_f32_32x32x16_bf16(pa0, PK(l0, h0), od, 0, 0, 0);
  od = __builtin_amdgcn_mfma_f32_32x32x16_bf16(pa1, PK(l1, h1), od, 0, 0, 0);
  od = __builtin_amdgcn_mfma_f32_32x32x16_bf16(pa2, PK(l2, h2), od, 0, 0, 0);
  od = __builtin_amdgcn_mfma_f32_32x32x16_bf16(pa3, PK(l3, h3), od, 0, 0, 0);
#undef PK
}
__device__ __forceinline__ void pv_d0(f32x16* o, int vb, bf16x8 pa0, bf16x8 pa1, bf16x8 pa2, bf16x8 pa3) {
  pv_one<0>(o[0], vb, pa0, pa1, pa2, pa3); pv_one<1>(o[1], vb, pa0, pa1, pa2, pa3); pv_one<2>(o[2], vb, pa0, pa1, pa2, pa3); pv_one<3>(o[3], vb, pa0, pa1, pa2, pa3);
}
__device__ __forceinline__ void unit(const GAS bf16_t* __restrict__ GQ, const GAS bf16_t* __restrict__ Kh, const GAS bf16_t* __restrict__ Vh, const GAS bf16_t* __restrict__ GZ, GAS bf16_t* __restrict__ MIX,
                                     const GAS float* __restrict__ qng, const GAS float* __restrict__ ropeR, const GAS float* __restrict__ ropeC, int qrow0, int head, int seq, LAS char* lds, int tid_in) {
  int tid = tid_in; asm volatile("" : "+v"(tid)); const int wid = __builtin_amdgcn_readfirstlane(tid >> 6), lane = tid & 63, r32 = lane & 31, hi = lane >> 5;
  LAUNDER_S(Kh); LAUNDER_S(Vh); LAUNDER_S(GQ); LAUNDER_S(GZ); LAUNDER_S(MIX);
  LAS bf16_t* V_lds = (LAS bf16_t*)lds; LAS bf16_t* K_lds = (LAS bf16_t*)(lds + 2 * SHM_V);
  LAS float* ws = (LAS float*)(lds + 2 * SHM_V + 2 * SHM_K) + wid * 64; LAS float* li_l = ws; LAS float* al_l = ws + 32;
  float m_reg = -1e30f, l_reg = 0; f32x16 o[4] = {}; bf16x8 qr[8];
  {
    const int row = qrow0 + wid * QBLK + r32; const GAS bf16_t* qp_ = GQ + (size_t)(qrow0 + wid * QBLK) * LDQ + head * D; const unsigned qo_ = (unsigned)(r32 * LDQ + hi * 8) * 2u;
    bf16x8 v[8]; float ss = 0.f;
#pragma unroll
    for (int d0 = 0; d0 < 8; ++d0) { v[d0] = GLD8(qp_ + d0 * 16, qo_);
#pragma unroll
      for (int j = 0; j < 8; ++j) { const float f = bf2f(v[d0][j]); ss += f * f; } }
    ss = swap_add(ss);
    const float rq = 1.0f / sqrtf(ss * (1.f / 128.f) + RMS_EPS);
    const int t = row & 8191, pr = t >> 6, pc = t & 63;
#pragma unroll
    for (int ax = 0; ax < 2; ++ax)
#pragma unroll
      for (int dd = 0; dd < 2; ++dd) { const int da = 4 * ax + dd, db = da + 2; const GAS float* tb = ax ? ropeC + (size_t)pc * 64 : ropeR + (size_t)pr * 64;
        float o1[8], o2[8];
#pragma unroll
        for (int j = 0; j < 8; ++j) { const int i = 16 * dd + 8 * hi + j; const float c = tb[i * 2], s = tb[i * 2 + 1];
          const float x1 = bf2f(v[da][j]) * rq * qng[16 * da + 8 * hi + j], x2 = bf2f(v[db][j]) * rq * qng[16 * db + 8 * hi + j];
          o1[j] = x1 * c - x2 * s; o2[j] = x1 * s + x2 * c; }
        { u32x4 w = {cvt_pk_bf16(o1[0], o1[1]), cvt_pk_bf16(o1[2], o1[3]), cvt_pk_bf16(o1[4], o1[5]), cvt_pk_bf16(o1[6], o1[7])}; qr[da] = __builtin_bit_cast(bf16x8, w); }
        { u32x4 w = {cvt_pk_bf16(o2[0], o2[1]), cvt_pk_bf16(o2[2], o2[3]), cvt_pk_bf16(o2[4], o2[5]), cvt_pk_bf16(o2[6], o2[7])}; qr[db] = __builtin_bit_cast(bf16x8, w); }
        asm volatile("" ::: "memory"); }
  }
  const int sr = tid >> 4, sc = (tid & 15) * 8, vst0 = v_st(sr, sc), vst1 = v_st(32 + sr, sc);
  const int vb0 = (int)(unsigned)(uintptr_t)V_lds + v_rd_base(lane);
  struct { bf16x8 vs0, vs1, ks0, ks1; } sr_[1];
  const unsigned so0 = (unsigned)(sr * LDK + sc) * 2u, so1 = (unsigned)((32 + sr) * LDK + sc) * 2u;
#define SLOAD(i, k0) do { const GAS bf16_t* vt_ = Vh + (size_t)(k0) * LDK; const GAS bf16_t* kt_ = Kh + (size_t)(k0) * LDK; \
    sr_[i].vs0 = GLD8(vt_, so0); sr_[i].vs1 = GLD8(vt_, so1); sr_[i].ks0 = GLD8(kt_, so0); sr_[i].ks1 = GLD8(kt_, so1); } while (0)
#define SWRITE(b, i) do { *(LAS bf16x8*)((LAS char*)V_lds + (b) * SHM_V + vst0) = sr_[i].vs0;          \
    *(LAS bf16x8*)((LAS char*)V_lds + (b) * SHM_V + vst1) = sr_[i].vs1; int kc = sc * 2;               \
    *(LAS bf16x8*)((LAS char*)K_lds + (b) * SHM_K + KSWZ(sr, kc)) = sr_[i].ks0;                       \
    *(LAS bf16x8*)((LAS char*)K_lds + (b) * SHM_K + KSWZ(32 + sr, kc)) = sr_[i].ks1; } while (0)
#define SWAIT() asm volatile("s_waitcnt vmcnt(0)" ::: "memory")
#define RESC(a) do { if (__any((a) < 1.f)) { if (hi == 0) al_l[r32] = (a); asm volatile("s_waitcnt lgkmcnt(0)" ::: "memory"); \
    for (int d = 0; d < 4; ++d) for (int r = 0; r < 16; ++r) o[d][r] *= al_l[crow(r, hi)]; } } while (0)
  f32x16 pA0, pA1, pB0, pB1; float mnA, mnB, alA, alB; bf16x8 pa0, pa1, pa2, pa3; const int NT = seq / KVBLK;
  constexpr int SE = 0, SO = 0;
  SLOAD(SE, 0); asm volatile("s_waitcnt vmcnt(0)" ::: "memory"); SWRITE(0, SE); __syncthreads();
  qkt(pA0, pA1, K_lds, qr, r32, hi); partialSM(pA0, pA1, m_reg, mnA, alA);
  SLOAD(SO, KVBLK);
  SWAIT(); SWRITE(1, SO); __syncthreads();
  for (int j = 1; j + 1 < NT; j += 2) {
    SBAR(); qkt(pB0, pB1, (LAS bf16_t*)((LAS char*)K_lds + SHM_K), qr, r32, hi);
    finishSM(pA0, pA1, alA, l_reg, pa0, pa1, pa2, pa3); SBAR();
    SLOAD(SO, (j + 1) * KVBLK); SBAR();
    pv_d0(o, vb0, pa0, pa1, pa2, pa3); partialSM(pB0, pB1, m_reg, mnB, alB);
    __syncthreads(); SWAIT(); SWRITE(0, SE);
    RESC(alB); __syncthreads();
    SBAR(); qkt(pA0, pA1, K_lds, qr, r32, hi);
    finishSM(pB0, pB1, alB, l_reg, pa0, pa1, pa2, pa3); SBAR();
    SLOAD(SE, (j + 2) * KVBLK); SBAR();
    pv_d0(o, vb0 + (int)SHM_V, pa0, pa1, pa2, pa3); partialSM(pA0, pA1, m_reg, mnA, alA);
    __syncthreads(); SWAIT(); SWRITE(1, SO);
    RESC(alA); __syncthreads();
  }
  SBAR(); qkt(pB0, pB1, (LAS bf16_t*)((LAS char*)K_lds + SHM_K), qr, r32, hi);
  finishSM(pA0, pA1, alA, l_reg, pa0, pa1, pa2, pa3); SBAR();
  pv_d0(o, vb0, pa0, pa1, pa2, pa3); partialSM(pB0, pB1, m_reg, mnB, alB);
  __syncthreads(); RESC(alB);
  finishSM(pB0, pB1, alB, l_reg, pa0, pa1, pa2, pa3); SBAR();
  pv_d0(o, vb0 + (int)SHM_V, pa0, pa1, pa2, pa3);
  if (hi == 0) li_l[r32] = l_reg; asm volatile("s_waitcnt lgkmcnt(0)" ::: "memory");
  const GAS bf16_t* zb_ = GZ + (size_t)(qrow0 + wid * QBLK) * 1024 + head * D; GAS bf16_t* ob_ = MIX + (size_t)(qrow0 + wid * QBLK) * 2048 + head * D;
  const unsigned zo_ = (unsigned)(4 * hi * 1024 + r32) * 2u, oo_ = (unsigned)(4 * hi * 2048 + r32) * 2u;
#pragma unroll
  for (int r = 0; r < 16; ++r) { const float rli = __builtin_amdgcn_rcpf(li_l[crow(r, hi)]); const int cr = (r & 3) + 8 * (r >> 2);
#pragma unroll
    for (int d0 = 0; d0 < 4; ++d0) GP16(ob_, oo_ + cr * 4096 + 64 * d0) = f2b(o[d0][r] * rli * bf2f(GPC16(zb_, zo_ + cr * 2048 + 64 * d0)));
    if ((r & 3) == 3) asm volatile("" ::: "memory"); }
  __syncthreads();
#undef SLOAD
#undef SWRITE
#undef SWAIT
#undef RESC
}
#undef KSWZ
#undef SBAR
}

__device__ __forceinline__ void p12_final(Frame& F, const Args& A_) {
    const int gw = F.vcu * NWAVES + F.wave, NGW = F.G * NWAVES; const GAS float* fg = inp(F, 2);
    for (int row = gw; row < M; row += NGW) {
        GAS f32x4* p = (GAS f32x4*)(F.out + (size_t)row * 1024) + F.lane; f32x4 v[4]; float s = 0.f;
#pragma unroll
        for (int j = 0; j < 4; ++j) { v[j] = p[64 * j]; s += (v[j][0] * v[j][0] + v[j][1] * v[j][1]) + (v[j][2] * v[j][2] + v[j][3] * v[j][3]); }
#pragma unroll
        for (int o = 1; o < 64; o <<= 1) s += __shfl_xor(s, o);
        const float r = 1.0f / sqrtf(s * (1.f / 1024.f) + RMS_EPS);
#pragma unroll
        for (int j = 0; j < 4; ++j) { const f32x4 g = *((const GAS f32x4*)fg + F.lane + 64 * j); p[64 * j] = v[j] * r * g; }
    }
}

#ifndef PG8_ALIGN_ACT
#define PG8_ALIGN_ACT true
#endif
__global__ void __launch_bounds__(NTHR, 2) mega_fwd(Args args) {
    extern __shared__ __attribute__((aligned(16))) unsigned char lds[];
    Frame F;
    F.lds = (LAS unsigned char*)lds; F.MISC = (volatile LAS unsigned*)(F.lds + MISC_OFF);
    F.tid = threadIdx.x; F.lane = F.tid & 63; F.wave = __builtin_amdgcn_readfirstlane(F.tid >> 6);
    F.G = gridDim.x; { const int bx = blockIdx.x; F.vcu = (F.G % 8 == 0) ? (bx % 8) * (F.G / 8) + bx / 8 : bx; }
    F.ws = (GAS unsigned char*)args.ws; F.out = (GAS float*)args.out; F.ctl = (gu32*)(args.ws + WS_CTL);
    for (int u = F.tid; u < (LDS_BYTES - LDSCTL_OFF) / 4; u += NTHR) ((LAS unsigned*)(F.lds + LDSCTL_OFF))[u] = 0u;
    __syncthreads();
    if (F.tid == 0) { volatile LAS unsigned long long* t = (volatile LAS unsigned long long*)(F.lds + LDSCTL_OFF + 1024);
#pragma unroll
        for (int i = 0; i < 14; ++i) t[i] = (unsigned long long)args.in[i]; }
    __syncthreads();
    XcdBarrier bar = xcd_barrier_post((unsigned*)(F.ctl + CW_BAR), F.MISC + 8);
    const int lo = args.ph_lo, hi = args.ph_hi;
#ifndef PHMASK
#define PHMASK 0x1fff
#endif
#define IN(k) (((PHMASK >> (k)) & 1) && lo <= (k) && (k) < hi && phase_enter(F))
#define SEAM(k) do { if (IN(k) && IN((k) + 1)) xcd_barrier(bar); STAMP((k) + 1); } while (0)

    STAMP(0);
    if (IN(0)) { p0_prologue(F, args); } SEAM(0);
    if (IN(1)) {
        pg8::Gemm g{(const bf16_t*)WSP(bf16_t, WS_U0), (const bf16_t*)WSP(bf16_t, WS_W1T), M, 5120, 1024}; pg8::StaticOrder S; S.init(M, 5120, F.G, (int)blockIdx.x);
        pg8::EpiAct E{0, WSP(bf16_t, WS_A0), WSP(bf16_t, WS_A1), WSP(bf16_t, WS_A2), WSP(bf16_t, WS_A3), nullptr, nullptr, WSP(float, WS_RS0), 1};
        pg8::gemm_phase<pg8::EpiAct, pg8::StaticOrder, PG8_ALIGN_ACT, true>(F.lds, g, S, E);
    } SEAM(1);
    if (IN(2)) { for (int u = F.vcu; u < 256; u += F.G) x1_unit(F, args, u); } SEAM(2);
    if (IN(3)) { x2_scan(F); } SEAM(3);
    if (IN(4)) { for (int u = F.vcu; u < 256; u += F.G) x3_unit(F, args, u); } SEAM(4);
    if (IN(5)) {
        pg8::Gemm g{(const bf16_t*)WSP(bf16_t, WS_U0), (const bf16_t*)(WSP(bf16_t, WS_W1T) + (size_t)5120 * 1024), M, 4096, 1024}; pg8::StaticOrder S; S.init(M, 4096, F.G, (int)blockIdx.x);
        pg8::EpiAct E{1, WSP(bf16_t, WS_A0), WSP(bf16_t, WS_A1), WSP(bf16_t, WS_A2), WSP(bf16_t, WS_A3), nullptr, nullptr, WSP(float, WS_RS0), 1};
        pg8::gemm_phase<pg8::EpiAct, pg8::StaticOrder, PG8_ALIGN_ACT, true>(F.lds, g, S, E);
    } SEAM(5);
    if (IN(6)) {
        { LAS float* scr = (LAS float*)(F.lds + F.wave * 16384); const int gw = F.vcu * NWAVES + F.wave, NGW = F.G * NWAVES;
          for (int it = gw; it < 16 * 208; it += NGW) { const int kb = it / 208, d = 32 * (it % 208); transpose_item(inp(F, 8), ODD_IN, 1024, WSP(bf16_t, WS_W3T), d, map_w3(d), inp(F, 1) + 1024, scr, kb, F.lane); }
          __syncthreads(); }
        STAMP(14);
        na_phase<true, true>(F, args);
#ifdef PROBE_NA
        __syncthreads(); STAMP(15); na_phase<false, false>(F, args); __syncthreads(); STAMP(16);
#endif
    } SEAM(6);
    if (IN(7)) {
        pg8::Gemm g{(const bf16_t*)WSP(bf16_t, WS_MIX0), (const bf16_t*)WSP(bf16_t, WS_W2T), M, 1024, 2048}; pg8::StaticOrder S; S.init(M, 1024, F.G, (int)blockIdx.x);
        pg8::EpiResid E{inp(F, 0), F.out, WSP(bf16_t, WS_H1B), WSP(float, WS_PART)};
        pg8::gemm_phase<pg8::EpiResid, pg8::StaticOrder, false, true>(F.lds, g, S, E);
    } SEAM(7);
    if (IN(8)) {
        pg8::Gemm g{(const bf16_t*)WSP(bf16_t, WS_H1B), (const bf16_t*)WSP(bf16_t, WS_W3T), M, 6656, 1024}; pg8::StaticOrder S; S.init(M, 6656, F.G, (int)blockIdx.x);
        pg8::EpiAct E{2, WSP(bf16_t, WS_GQ), WSP(bf16_t, WS_GK), WSP(bf16_t, WS_GV), WSP(bf16_t, WS_GZ), WSP(bf16_t, WS_XC), WSP(bf16_t, WS_CG), WSP(float, WS_PART), 2};
        pg8::gemm_phase<pg8::EpiAct, pg8::StaticOrder, PG8_ALIGN_ACT, true>(F.lds, g, S, E);
    } SEAM(8);
    if (IN(9)) { p9_krope_conv(F, args); } SEAM(9);
    if (IN(10)) {
        const int combo = F.vcu >> 6, b = combo >> 1, kvh = combo & 1, idx = F.vcu & 63;
        if (F.vcu < 256)
#pragma unroll 1
        for (int i = 0; i < 2; ++i) { const int uu = idx * 2 + i, head = 4 * kvh + (uu >> 5), qblk = uu & 31;
            gqa::unit(WSP(bf16_t, WS_GQ), WSP(bf16_t, WS_GK) + ((size_t)kvh * M + (size_t)b * SEQ) * 128, WSP(bf16_t, WS_GV) + ((size_t)kvh * M + (size_t)b * SEQ) * 128, WSP(bf16_t, WS_GZ), WSP(bf16_t, WS_MIX1),
                      inp(F, 10), WSP(float, WS_ROPE), WSP(float, WS_ROPE) + 8192, b * SEQ + 256 * qblk, head, SEQ, (LAS char*)F.lds, F.tid); }
    } SEAM(10);
    if (IN(11)) {
        pg8::Gemm g{(const bf16_t*)WSP(bf16_t, WS_MIX1), (const bf16_t*)WSP(bf16_t, WS_W4T), M, 1024, 2048}; pg8::StaticOrder S; S.init(M, 1024, F.G, (int)blockIdx.x);
        pg8::EpiResid E{F.out, F.out, nullptr, nullptr};
        pg8::gemm_phase<pg8::EpiResid, pg8::StaticOrder, false, true>(F.lds, g, S, E);
    } SEAM(11);
    if (IN(12)) { p12_final(F, args); }
#ifdef DIAG_A
    __syncthreads(); STAMP(13); xcd_barrier(bar);
    if (blockIdx.x == 0) { unsigned* ts = (unsigned*)(F.ctl + 12288);
        asm volatile("s_waitcnt vmcnt(0)" ::: "memory");
        const unsigned a0 = __hip_atomic_load(ts + DIAG_A, __ATOMIC_RELAXED, __HIP_MEMORY_SCOPE_AGENT), a1 = __hip_atomic_load(ts + DIAG_B, __ATOMIC_RELAXED, __HIP_MEMORY_SCOPE_AGENT);
        const unsigned b0 = a0, b1 = a1;
        const float da = (float)(a1 - a0) * 0.0001f, db = (float)(b1 - b0) * 0.0001f;
        if (F.tid == 0) F.out[0] += da;
        for (int i = F.tid; i < DIAG_NB; i += NTHR) F.out[1024 + i] += db; }
#endif
#undef IN
#undef SEAM
}

extern "C" void kernel_launch(void* const* d_in, const int* in_sizes, int n_in, void* d_out, int out_size, void* d_ws, size_t ws_size, hipStream_t stream) {
    static int grid = 0;
    if (grid == 0) {
        if (n_in != 14 || in_sizes[0] != M * DM || out_size != M * DM || ws_size < WS_END) { fprintf(stderr, "kernel_launch: unexpected shapes/workspace: n_in %d in0 %d out %d ws %zu\n", n_in, n_in > 0 ? in_sizes[0] : -1, out_size, ws_size); grid = -1; return; }
        int dev = 0, cus = 0, per_cu = 0;
        if (hipGetDevice(&dev) != hipSuccess || hipDeviceGetAttribute(&cus, hipDeviceAttributeMultiprocessorCount, dev) != hipSuccess) { grid = -1; return; }
        if (hipFuncSetAttribute((const void*)mega_fwd, hipFuncAttributeMaxDynamicSharedMemorySize, LDS_BYTES) != hipSuccess) { fprintf(stderr, "kernel_launch: hipFuncSetAttribute failed\n"); grid = -1; return; }
        if (hipOccupancyMaxActiveBlocksPerMultiprocessor(&per_cu, (const void*)mega_fwd, NTHR, LDS_BYTES) != hipSuccess || per_cu < 1) { fprintf(stderr, "kernel_launch: occupancy query reports %d\n", per_cu); per_cu = 1; }
        (void)hipGetLastError();
        grid = cus;
    }
    if (grid < 0) return;
    if (hipMemsetAsync((char*)d_ws + WS_CTL, 0, CTL_ZERO_BYTES, stream) != hipSuccess) return;
    Args a{};
    for (int i = 0; i < 14; ++i) a.in[i] = (const float*)d_in[i];
    a.out = (float*)d_out; a.ws = (unsigned char*)d_ws;
#ifdef MK_SPLIT
    for (int p = 0; p < NPHASE; ++p) { a.ph_lo = p; a.ph_hi = p + 1; hipLaunchKernelGGL(mega_fwd, dim3(grid), dim3(NTHR), LDS_BYTES, stream, a); }
#else
    a.ph_lo = 0; a.ph_hi = NPHASE;
    hipLaunchKernelGGL(mega_fwd, dim3(grid), dim3(NTHR), LDS_BYTES, stream, a);
#endif
}
```

```cpp
#include <hip/hip_runtime.h>
#include <cstdio>
#include <cstdint>
#include <cmath>
namespace pg8 {
#define PG8_LAS __attribute__((address_space(3)))
typedef unsigned short bf16_t;
typedef short bf16x8 __attribute__((ext_vector_type(8)));
typedef float f32x4 __attribute__((ext_vector_type(4)));
typedef unsigned u32x4 __attribute__((ext_vector_type(4)));
constexpr int BM = 256, BK = 64, HALF = 128, HTB = HALF * BK * 2  , STAGE_BYTES = 8 * HTB, NXCD = 8, WGM = 8;

__host__ __device__ __forceinline__ int lds_byte(int r, int c) { const int st = (r >> 4) * 2 + (c >> 5), rr = r & 15, cc = c & 31, ob = rr * 64 + cc * 2; return st * 1024 + (ob ^ (((ob >> 9) & 1) << 5)); }
__host__ __device__ __forceinline__ void stage_rc(int b, int& R, int& C) { const int st = b / 1024, sb = b % 1024, swz = sb ^ (((sb >> 9) & 1) << 5); R = (st >> 1) * 16 + swz / 64; C = (st & 1) * 32 + (swz % 64) / 2; }
__host__ __device__ __forceinline__ int perm32(int rho) { const int n = rho >> 4, i = rho & 15; return 8 * (i >> 2) + 4 * n + (i & 3); }

struct Unit { int pm, pn; };
struct Gemm { const bf16_t* A; const bf16_t* Bt; int M, N, K; };

struct StaticOrder {
    int nM, nN, nwg, G, c;
    __host__ __device__ void init(int M, int N, int G_, int c_) { nM = M / BM; nN = N / BM; nwg = nM * nN; G = G_; c = c_; }
    __host__ __device__ bool next(int i, Unit& u) const {
        const long L = (long)i * G + c; if (L >= nwg) return false;
        int wgid = (int)L; { const int q = nwg / NXCD, r = nwg % NXCD, xcd = wgid % NXCD, off = wgid / NXCD; wgid = (xcd < r ? xcd * (q + 1) : r * (q + 1) + (xcd - r) * q) + off; }
        const int nig = WGM * nN, gid = wgid / nig, fm = gid * WGM, gsz = (nM - fm) < WGM ? (nM - fm) : WGM;
        u.pm = fm + ((wgid % nig) % gsz); u.pn = (wgid % nig) / gsz; return true;
    }
    __device__ __forceinline__ void a_ready(const Unit&) const {}
    __device__ __forceinline__ void done(const Unit&) const {}
};

typedef float f32x2 __attribute__((ext_vector_type(2)));
typedef __bf16 bf16x2_t __attribute__((ext_vector_type(2)));
__device__ __forceinline__ unsigned cvt_pk_bf16(float lo, float hi) { f32x2 v = {lo, hi}; bf16x2_t b = __builtin_convertvector(v, bf16x2_t); return __builtin_bit_cast(unsigned, b); }
__device__ __forceinline__ float fexp(float x) { return __builtin_amdgcn_exp2f(x * 1.4426950408889634f); }
__device__ __forceinline__ float sigm(float x) { return __builtin_amdgcn_rcpf(1.f + fexp(-x)); }
__device__ __forceinline__ float silu(float x) { return x * sigm(x); }

#define PG8_GAS __attribute__((address_space(1)))
struct TileOut { PG8_GAS bf16_t* dst; int ldc; int col0; int mode; float scale; int hstride; };
constexpr size_t PM_ = 16384;
struct EpiAct {
    static constexpr bool PERM = true, AFTER_DRAIN = false;
    int gid;
    PG8_GAS bf16_t *T0, *T1, *T2, *T3, *T4, *T5;
    const PG8_GAS float* rs; int rs_mode;
    __device__ __forceinline__ TileOut tile(int pn) const {
        TileOut t;
        if (gid == 0) {
            if (pn < 4)       t = TileOut{T0 + (size_t)pn * (PM_ * 256), 256, 0, 0, 1.f, 128};
            else if (pn < 8)  t = TileOut{T1 + (size_t)(pn - 4) * (PM_ * 256), 256, 0, 0, 0.0625f, 128};
            else if (pn < 12) t = TileOut{T2 + (size_t)(pn - 8) * (PM_ * 256), 256, 0, 0, 1.f, 128};
            else              t = TileOut{T3 + (size_t)((pn - 12) >> 1) * (PM_ * 256), 256, 128 * ((pn - 12) & 1), 2, 1.f, 128};
        } else if (gid == 1) {
            if (pn < 4)       t = TileOut{T0 + (size_t)pn * (PM_ * 256), 256, 0, 0, 0.125f, 128};
            else if (pn < 8)  t = TileOut{T1 + (size_t)(pn - 4) * (PM_ * 256), 256, 0, 0, 1.f, 128};
            else if (pn < 12) t = TileOut{T2 + (size_t)(pn - 8) * (PM_ * 256), 256, 0, 0, 1.f, 128};
            else              t = TileOut{T3 + (size_t)(pn - 12) * (PM_ * 256), 256, 0, 1, 1.f, 128};
        } else {
            if (pn < 4)        t = TileOut{T0, 1024, 256 * pn, 0, 1.f, 128};
            else if (pn == 4)  t = TileOut{T1, 128, 0, 0, 1.f, (int)(PM_ * 128)};
            else if (pn == 5)  t = TileOut{T2, 128, 0, 0, 1.f, (int)(PM_ * 128)};
            else if (pn < 10)  t = TileOut{T3, 1024, 256 * (pn - 6), 1, 1.f, 128};
            else if (pn < 18)  t = TileOut{T4, 1024, 128 * (pn - 10), 3, 1.f, 128};
            else               t = TileOut{T5, 1024, 128 * (pn - 18), 4, 1.f, 128};
        }
        return t;
    }
    __device__ __forceinline__ void operator()(const f32x4 (&acc)[2][2][4][2], const Unit& u, int wr, int wc, int fr, int fq) const {
        const TileOut t = tile(u.pn);
        const int rbase = u.pm * BM + wr * 64 + fr, cl = wc * 32 + 8 * fq;
        float rsc[2][4];
#pragma unroll
        for (int ai = 0; ai < 2; ++ai)
#pragma unroll
            for (int m = 0; m < 4; ++m) rsc[ai][m] = rs[rbase + ai * HALF + m * 16];
        asm volatile("" ::: "memory");
#pragma unroll
        for (int ai = 0; ai < 2; ++ai)
#pragma unroll
            for (int m = 0; m < 4; ++m) {
                const int row = rbase + ai * HALF + m * 16;
                float r = t.scale;
                if (rs_mode == 1) r *= rsc[ai][m];
                else r *= __builtin_amdgcn_rsqf(rsc[ai][m] * (1.f / 1024.f) + 1e-6f);
                PG8_GAS bf16_t* rowp = t.dst + (size_t)row * t.ldc + t.col0 + cl;
                if (t.mode <= 1) {
#pragma unroll
                    for (int bj = 0; bj < 2; ++bj) { f32x4 v0 = acc[ai][bj][m][0] * r, v1 = acc[ai][bj][m][1] * r;
                        if (t.mode == 1) {
#pragma unroll
                            for (int j = 0; j < 4; ++j) { v0[j] = silu(v0[j]); v1[j] = silu(v1[j]); } }
                        u32x4 w; w.x = cvt_pk_bf16(v0[0], v0[1]); w.y = cvt_pk_bf16(v0[2], v0[3]); w.z = cvt_pk_bf16(v1[0], v1[1]); w.w = cvt_pk_bf16(v1[2], v1[3]);
                        *(PG8_GAS u32x4*)(rowp + (size_t)bj * t.hstride) = w; }
                } else {
                    f32x4 o[2];
#pragma unroll
                    for (int n = 0; n < 2; ++n) { const f32x4 a = acc[ai][0][m][n] * r, b = acc[ai][1][m][n] * r;
#pragma unroll
                        for (int j = 0; j < 4; ++j) o[n][j] = (t.mode == 2) ? sigm(a[j]) * silu(b[j]) : (t.mode == 3) ? a[j] * b[j] : a[j] * silu(b[j]); }
                    u32x4 w; w.x = cvt_pk_bf16(o[0][0], o[0][1]); w.y = cvt_pk_bf16(o[0][2], o[0][3]); w.z = cvt_pk_bf16(o[1][0], o[1][1]); w.w = cvt_pk_bf16(o[1][2], o[1][3]);
                    *(PG8_GAS u32x4*)rowp = w;
                }
            }
    }
};
struct EpiResid {
    static constexpr bool PERM = false, AFTER_DRAIN = false;
    const PG8_GAS float* base; PG8_GAS float* out; PG8_GAS bf16_t* outb; PG8_GAS float* rsum;
    __device__ __forceinline__ void operator()(const f32x4 (&acc)[2][2][4][2], const Unit& u, int wr, int wc, int fr, int fq) const {
        typedef unsigned u32x2v __attribute__((ext_vector_type(2)));
        const int col0 = u.pn * BM + wc * 32 + 4 * fq;
#pragma unroll
        for (int ai = 0; ai < 2; ++ai) {
            f32x4 bs[4][2][2];
#pragma unroll
            for (int m = 0; m < 4; ++m) { const int row = u.pm * BM + ai * HALF + wr * 64 + m * 16 + fr; const size_t off = (size_t)row * 1024 + col0;
#pragma unroll
                for (int bj = 0; bj < 2; ++bj)
#pragma unroll
                    for (int n = 0; n < 2; ++n) bs[m][bj][n] = *(const PG8_GAS f32x4*)(base + off + bj * HALF + n * 16); }
            asm volatile("" ::: "memory");
#pragma unroll
            for (int m = 0; m < 4; ++m) { const int row = u.pm * BM + ai * HALF + wr * 64 + m * 16 + fr; const size_t off = (size_t)row * 1024 + col0; float ss = 0.f;
#pragma unroll
                for (int bj = 0; bj < 2; ++bj)
#pragma unroll
                    for (int n = 0; n < 2; ++n) { const f32x4 o = bs[m][bj][n] + acc[ai][bj][m][n];
                        *(PG8_GAS f32x4*)(out + off + bj * HALF + n * 16) = o; ss += (o[0] * o[0] + o[1] * o[1]) + (o[2] * o[2] + o[3] * o[3]);
                        if (outb) { u32x2v w; w.x = cvt_pk_bf16(o[0], o[1]); w.y = cvt_pk_bf16(o[2], o[3]); *(PG8_GAS u32x2v*)(outb + off + bj * HALF + n * 16) = w; } }
                if (rsum) { ss += __shfl_xor(ss, 16); ss += __shfl_xor(ss, 32);
                    if (fq == 0) __hip_atomic_fetch_add(rsum + row, ss, __ATOMIC_RELAXED, __HIP_MEMORY_SCOPE_AGENT); } }
            asm volatile("" ::: "memory");
        }
    }
};

template <class Epi, class Sched, bool ALIGN_EPI = false, bool SP2 = false>
__device__ __forceinline__ void gemm_phase(PG8_LAS unsigned char* lds, const Gemm g, const Sched& S, const Epi& E) {
    const int tid = threadIdx.x, wid = __builtin_amdgcn_readfirstlane(tid >> 6), lane = tid & 63, wr = wid >> 2, wc = wid & 3, fr = lane & 15, fq = lane >> 4;
    const int K = g.K, nt = K / BK;
    unsigned voffA[2], voffB[2];
#pragma unroll
    for (int i = 0; i < 2; ++i) { int R, C; stage_rc(tid * 16 + i * 8192, R, C); const int Rb = Epi::PERM ? ((R & ~31) + perm32(R & 31)) : R;
        voffA[i] = (unsigned)(R * K + C) * 2u; voffB[i] = (unsigned)(Rb * K + C) * 2u; }
    const size_t kstep = (size_t)(BK * 2);
    const size_t hstep = (size_t)HALF * K * 2;
    const size_t tstep = 2 * hstep;
    const unsigned ldsw = (unsigned)wid * 1024u;
    const int aoff = lds_byte(wr * 64 + fr, fq * 8), boff = lds_byte(wc * 32 + fr, fq * 8);
#define PG8_SA(b, h) (((b) * 2 + (h)) * HTB)
#define PG8_SB(b, h) ((4 + (b) * 2 + (h)) * HTB)
#define PG8_STAGE(bufoff, gbase, voff) do { _Pragma("unroll") for (int _i = 0; _i < 2; ++_i) \
        __builtin_amdgcn_global_load_lds((const unsigned*)((const char*)(gbase) + (voff)[_i]), (PG8_LAS unsigned*)(lds + (bufoff) + ldsw + _i * 8192), 16, 0, 0); } while (0)
#define PG8_LDA(dst, b, h) do { _Pragma("unroll") for (int m = 0; m < 4; ++m) _Pragma("unroll") for (int k = 0; k < 2; ++k) dst[m][k] = *(const PG8_LAS bf16x8*)(lds + PG8_SA(b, h) + aoff + m * 2048 + k * 1024); } while (0)
#define PG8_LDB(dst, b, h) do { _Pragma("unroll") for (int n = 0; n < 2; ++n) _Pragma("unroll") for (int k = 0; k < 2; ++k) dst[n][k] = *(const PG8_LAS bf16x8*)(lds + PG8_SB(b, h) + boff + n * 2048 + k * 1024); } while (0)
#define PG8_MMA(ai, bj, At, Bt) do { __builtin_amdgcn_s_setprio(1); _Pragma("unroll") for (int m = 0; m < 4; ++m) _Pragma("unroll") for (int n = 0; n < 2; ++n) _Pragma("unroll") for (int k = 0; k < 2; ++k) \
        acc[ai][bj][m][n] = __builtin_amdgcn_mfma_f32_16x16x32_bf16(Bt[n][k], At[m][k], acc[ai][bj][m][n], 0, 0, 0); __builtin_amdgcn_s_setprio(0); } while (0)
#define PG8_WAIT_V(n) asm volatile("s_waitcnt vmcnt(" #n ")" ::: "memory")
#define PG8_WAIT_L(n) asm volatile("s_waitcnt lgkmcnt(" #n ")" ::: "memory")
#define PG8_BAR __builtin_amdgcn_s_barrier()
#define PG8_SCHED __builtin_amdgcn_sched_barrier(0)
    Unit cur, nxt; int ui = 0;
    if (!S.next(0, cur)) return;
    f32x4 acc[2][2][4][2];
#pragma unroll
    for (int a = 0; a < 2; ++a)
#pragma unroll
        for (int b = 0; b < 2; ++b)
#pragma unroll
            for (int m = 0; m < 4; ++m)
#pragma unroll
                for (int n = 0; n < 2; ++n) acc[a][b][m][n] = (f32x4){0.f, 0.f, 0.f, 0.f};
    bf16x8 At[4][2], B0[2][2], B1[2][2];
    const char* cA = (const char*)g.A + (size_t)cur.pm * tstep; const char* cB = (const char*)g.Bt + (size_t)cur.pn * tstep;
    S.a_ready(cur);
    if constexpr (SP2) {
        PG8_STAGE(PG8_SB(0, 0), cB, voffB); PG8_STAGE(PG8_SB(0, 1), cB + hstep, voffB); PG8_STAGE(PG8_SA(0, 0), cA, voffA); PG8_STAGE(PG8_SA(0, 1), cA + hstep, voffA);
        if (wr == 1) PG8_BAR;
        PG8_WAIT_V(2); PG8_BAR;
        PG8_STAGE(PG8_SB(1, 0), cB + kstep, voffB); PG8_STAGE(PG8_SA(1, 0), cA + kstep, voffA); PG8_STAGE(PG8_SB(1, 1), cB + hstep + kstep, voffB);
        PG8_WAIT_V(6); PG8_BAR;
    } else {
        PG8_STAGE(PG8_SB(0, 0), cB, voffB); PG8_STAGE(PG8_SA(0, 0), cA, voffA); PG8_STAGE(PG8_SB(0, 1), cB + hstep, voffB); PG8_STAGE(PG8_SA(0, 1), cA + hstep, voffA);
        if (wr == 1) PG8_BAR;
        PG8_WAIT_V(4); PG8_BAR;
        PG8_STAGE(PG8_SB(1, 0), cB + kstep, voffB); PG8_STAGE(PG8_SA(1, 0), cA + kstep, voffA); PG8_STAGE(PG8_SB(1, 1), cB + hstep + kstep, voffB);
        PG8_WAIT_V(6); PG8_BAR;
    }
    for (;;) {
        const bool has_next = S.next(ui + 1, nxt);
        const char* nA = has_next ? (const char*)g.A + (size_t)nxt.pm * tstep : cA; const char* nB = has_next ? (const char*)g.Bt + (size_t)nxt.pn * tstep : cB;
        for (int t = 0; t < nt; t += 2) {
            const bool last = (t == nt - 2);
            const char* a1 = cA + (size_t)(t + 1) * kstep;
            const char* a2 = last ? nA : cA + (size_t)(t + 2) * kstep; const char* b2 = last ? nB : cB + (size_t)(t + 2) * kstep;
            const char* a3 = a2 + kstep; const char* b3 = b2 + kstep;
            if (last && has_next) S.a_ready(nxt);
            if constexpr (SP2) {
            PG8_LDB(B0, 0, 0); PG8_LDB(B1, 0, 1); PG8_SCHED; PG8_LDA(At, 0, 0); PG8_STAGE(PG8_SA(1, 1), a1 + hstep, voffA);
            PG8_WAIT_V(8); PG8_WAIT_L(0); PG8_BAR; PG8_MMA(0, 0, At, B0); PG8_MMA(0, 1, At, B1); PG8_BAR; PG8_SCHED;
            PG8_LDA(At, 0, 1); PG8_STAGE(PG8_SB(0, 0), b2, voffB); PG8_STAGE(PG8_SB(0, 1), b2 + hstep, voffB); PG8_STAGE(PG8_SA(0, 0), a2, voffA);
            PG8_WAIT_V(8); PG8_WAIT_L(0); PG8_BAR; PG8_MMA(1, 0, At, B0); PG8_MMA(1, 1, At, B1); PG8_BAR; PG8_SCHED;
            PG8_LDB(B0, 1, 0); PG8_LDB(B1, 1, 1); PG8_SCHED; PG8_LDA(At, 1, 0); PG8_STAGE(PG8_SA(0, 1), a2 + hstep, voffA);
            PG8_WAIT_V(8); PG8_WAIT_L(0); PG8_BAR; PG8_MMA(0, 0, At, B0); PG8_MMA(0, 1, At, B1); PG8_BAR; PG8_SCHED;
            PG8_LDA(At, 1, 1); PG8_STAGE(PG8_SB(1, 0), b3, voffB); PG8_STAGE(PG8_SB(1, 1), b3 + hstep, voffB); PG8_STAGE(PG8_SA(1, 0), a3, voffA);
            PG8_WAIT_V(8); PG8_WAIT_L(0); PG8_BAR; PG8_MMA(1, 0, At, B0); PG8_MMA(1, 1, At, B1); PG8_BAR; PG8_SCHED;
            } else {
            PG8_LDB(B0, 0, 0); PG8_SCHED; PG8_LDA(At, 0, 0); PG8_STAGE(PG8_SA(1, 1), a1 + hstep, voffA);
            PG8_WAIT_L(8); PG8_BAR; PG8_WAIT_L(0); PG8_MMA(0, 0, At, B0); PG8_BAR; PG8_SCHED;
            PG8_LDB(B1, 0, 1); PG8_STAGE(PG8_SB(0, 0), b2, voffB);
            PG8_BAR; PG8_WAIT_L(0); PG8_MMA(0, 1, At, B1); PG8_BAR;
            PG8_LDA(At, 0, 1); PG8_STAGE(PG8_SA(0, 0), a2, voffA);
            PG8_BAR; PG8_WAIT_L(0); PG8_MMA(1, 0, At, B0); PG8_BAR; PG8_SCHED;
            PG8_STAGE(PG8_SB(0, 1), b2 + hstep, voffB);
            PG8_WAIT_V(6); PG8_BAR; PG8_MMA(1, 1, At, B1); PG8_BAR;
            PG8_LDB(B0, 1, 0); PG8_SCHED; PG8_LDA(At, 1, 0); PG8_STAGE(PG8_SA(0, 1), a2 + hstep, voffA);
            PG8_WAIT_L(8); PG8_BAR; PG8_WAIT_L(0); PG8_MMA(0, 0, At, B0); PG8_BAR; PG8_SCHED;
            PG8_LDB(B1, 1, 1); PG8_STAGE(PG8_SB(1, 0), b3, voffB);
            PG8_BAR; PG8_WAIT_L(0); PG8_MMA(0, 1, At, B1); PG8_BAR;
            PG8_LDA(At, 1, 1); PG8_STAGE(PG8_SA(1, 0), a3, voffA);
            PG8_BAR; PG8_WAIT_L(0); PG8_MMA(1, 0, At, B0); PG8_BAR; PG8_SCHED;
            PG8_STAGE(PG8_SB(1, 1), b3 + hstep, voffB);
            PG8_WAIT_V(6); PG8_BAR; PG8_MMA(1, 1, At, B1); PG8_BAR;
            }
        }
        if constexpr (ALIGN_EPI) { if (wr == 0) PG8_BAR; }
        if constexpr (!Epi::AFTER_DRAIN) { E(acc, cur, wr, wc, fr, fq); S.done(cur); }
        if (!has_next) break;
#pragma unroll
        for (int a = 0; a < 2; ++a)
#pragma unroll
            for (int b = 0; b < 2; ++b)
#pragma unroll
                for (int m = 0; m < 4; ++m)
#pragma unroll
                    for (int n = 0; n < 2; ++n) acc[a][b][m][n] = (f32x4){0.f, 0.f, 0.f, 0.f};
        cur = nxt; cA = nA; cB = nB; ++ui;
        if constexpr (ALIGN_EPI) { if (wr == 1) PG8_BAR; }
    }
    PG8_WAIT_V(0);
    if constexpr (!ALIGN_EPI) { if (wr == 0) PG8_BAR; }
    PG8_BAR;
    if constexpr (Epi::AFTER_DRAIN) { E.fused(acc, cur, wr, wc, fr, fq, lds, wid, lane); S.done(cur); }
#undef PG8_SA
#undef PG8_SB
#undef PG8_STAGE
#undef PG8_LDA
#undef PG8_LDB
#undef PG8_MMA
#undef PG8_WAIT_V
#undef PG8_WAIT_L
#undef PG8_BAR
#undef PG8_SCHED
}
}
#define GAS __attribute__((address_space(1)))
#define LAS __attribute__((address_space(3)))
typedef unsigned short bf16;
typedef unsigned v4u __attribute__((ext_vector_type(4)));
typedef float f32x4 __attribute__((ext_vector_type(4)));
typedef short bf16x8 __attribute__((ext_vector_type(8)));
typedef GAS unsigned gu32;
typedef GAS unsigned long long gu64;
#define RLX_AGENT __ATOMIC_RELAXED, __HIP_MEMORY_SCOPE_AGENT
#define LDS_WAIT() asm volatile("s_waitcnt lgkmcnt(0)" ::: "memory")
#define VM_WAIT() asm volatile("s_waitcnt vmcnt(0)" ::: "memory")
__device__ __forceinline__ unsigned long long rt() { return __builtin_amdgcn_s_memrealtime(); }
__device__ __forceinline__ unsigned f2bf(float f) { unsigned u = __builtin_bit_cast(unsigned, f); return (u + 0x7fffu + ((u >> 16) & 1u)) >> 16; }
__device__ __forceinline__ unsigned pk2(float lo, float hi) { return f2bf(lo) | (f2bf(hi) << 16); }

#define XB_TMO      128
#define XB_XCNT(j)  (256  + 64 * (j))
#define XB_XSUB(j)  (1280 + 64 * (j))
#define XB_XGEN(j)  (2304 + 64 * (j))
#define XB_TOP      3328
#define XB_TOPGEN   3392
#define XCD_BAR_WORDS 3456
#define XB_SPIN_CAP (1u << 18)

__device__ __forceinline__ unsigned xb_ld(unsigned* p)              { return __hip_atomic_load(p, __ATOMIC_RELAXED, __HIP_MEMORY_SCOPE_AGENT); }
__device__ __forceinline__ unsigned xb_add(unsigned* p, unsigned v) { return __hip_atomic_fetch_add(p, v, __ATOMIC_RELAXED, __HIP_MEMORY_SCOPE_AGENT); }
__device__ __forceinline__ unsigned xb_xcc_id() { return (unsigned)__builtin_amdgcn_s_getreg((3 << 11) | 20) & 0xFu; }
#define XB_SPIN(cond, bar) do { unsigned _sp = 0; while (cond) { __builtin_amdgcn_s_sleep(1); \
    if ((++_sp & 255u) == 0u) { if (xb_ld(&(bar)[XB_TMO])) break; if (_sp > XB_SPIN_CAP) { atomicAdd(&(bar)[XB_TMO], 1u); break; } } } } while (0)

struct XcdBarrier {
    unsigned* bar; unsigned x;
    volatile LAS unsigned* st;
};

__device__ __forceinline__ XcdBarrier xcd_barrier_post(unsigned* bar, volatile LAS unsigned* st) {
    XcdBarrier b; b.bar = bar; b.x = xb_xcc_id(); b.st = st;
    if (threadIdx.x == 0) (void)xb_add(&bar[XB_XCNT(b.x)], 1u);
    return b;
}
__device__ __forceinline__ void xcd_barrier_complete(unsigned* bar, unsigned x, unsigned& nloc, unsigned& nx) {
    const unsigned G = gridDim.x * gridDim.y * gridDim.z;
    unsigned sum, cnt, mine, sp = 0u;
    for (;;) {
        sum = 0u; cnt = 0u; mine = 0u;
#pragma unroll
        for (unsigned j = 0; j < 16; ++j) { const unsigned c = xb_ld(&bar[XB_XCNT(j)]); sum += c; cnt += (c > 0u) ? 1u : 0u; mine = (j == x) ? c : mine; }
        if (sum == G) break;
        __builtin_amdgcn_s_sleep(1);
        if ((++sp & 255u) == 0u) { if (xb_ld(&bar[XB_TMO])) break; if (sp > XB_SPIN_CAP) { atomicAdd(&bar[XB_TMO], 1u); break; } }
    }
    nloc = mine > 0u ? mine : 1u; nx = cnt > 0u ? cnt : 1u;
}

__device__ __forceinline__ void xcd_barrier(const XcdBarrier& b) {
    asm volatile("s_waitcnt vmcnt(0)" ::: "memory");
    __syncthreads();
    if (threadIdx.x == 0) {
        unsigned* bar = b.bar;
        __builtin_amdgcn_s_waitcnt(0);
        unsigned nloc = b.st[0], nx = b.st[1];
        if (nloc == 0u) { xcd_barrier_complete(bar, b.x, nloc, nx); b.st[0] = nloc; b.st[1] = nx; }
        const unsigned old = xb_add(&bar[XB_XSUB(b.x)], 1u);
        const unsigned gen = old / nloc;
        if (old + 1u == (gen + 1u) * nloc) {
            __builtin_amdgcn_fence(__ATOMIC_RELEASE, "agent");
            asm volatile("s_waitcnt vmcnt(0)" ::: "memory");
            const unsigned og = xb_add(&bar[XB_TOP], 1u);
            const unsigned tg = og / nx;
            if (og + 1u == (tg + 1u) * nx) xb_add(&bar[XB_TOPGEN], 1u);
            else XB_SPIN(xb_ld(&bar[XB_TOPGEN]) == tg, bar);
            __builtin_amdgcn_fence(__ATOMIC_ACQUIRE, "agent");
            xb_add(&bar[XB_XGEN(b.x)], 1u);
            asm volatile("s_waitcnt vmcnt(0)" ::: "memory");
        } else {
            XB_SPIN(xb_ld(&bar[XB_XGEN(b.x)]) == gen, bar);
            __builtin_amdgcn_fence(__ATOMIC_ACQUIRE, "agent");
            asm volatile("s_waitcnt vmcnt(0)" ::: "memory");
        }
    }
    __syncthreads();
}
typedef unsigned u32x4 __attribute__((ext_vector_type(4)));
constexpr int NWAVES = 8, NTHR = 512;
constexpr int BATCH = 2, SEQ = 8192, DM = 1024, M = BATCH * SEQ;
constexpr int EVEN_IN = 9232, ODD_IN = 6656;
constexpr float RMS_EPS = 1e-6f;
constexpr int NPHASE = 13;

constexpr size_t MiB = 1u << 20;
constexpr size_t WS_CTL = 0, CTL_ZERO_BYTES = 64 * 1024;
constexpr size_t WS_GATES = 1 * MiB;
constexpr size_t WS_PART = 2 * MiB;
constexpr size_t WS_RS0 = 3 * MiB;
constexpr size_t WS_ROPE = 3 * MiB + 64 * 1024;
constexpr size_t WS_NST = 3 * MiB + 128 * 1024;
constexpr size_t WS_CHSC = 3 * MiB + 640 * 1024;
constexpr size_t WS_W1T = 4 * MiB, WS_W2T = 22 * MiB, WS_U0 = 26 * MiB, WS_W3T = 26 * MiB;
constexpr size_t WS_A0 = 58 * MiB, WS_A1 = 90 * MiB, WS_A2 = 122 * MiB, WS_A3 = 154 * MiB, WS_MIX0 = 186 * MiB, WS_W4T = 250 * MiB;
constexpr size_t WS_H1B = WS_A0, WS_GQ = WS_A1, WS_GZ = WS_A2, WS_XC = WS_A3, WS_CG = 186 * MiB, WS_GK = 218 * MiB, WS_GV = 226 * MiB, WS_MIX1 = 4 * MiB;
constexpr size_t WS_END = 256 * MiB;
constexpr int CW_BAR = 4096;
constexpr int RING_BYTES = 131072, LDSCTL_OFF = 143360, MISC_OFF = LDSCTL_OFF + 320, LDS_BYTES = 147456;
static_assert(66560 + 128 * 528 <= LDSCTL_OFF, "LDS map");

typedef unsigned short bf16_t;
typedef short s16x4 __attribute__((ext_vector_type(4)));
typedef float f32x16 __attribute__((ext_vector_type(16)));
typedef unsigned u32x2 __attribute__((ext_vector_type(2)));
using pg8::cvt_pk_bf16; using pg8::fexp;

__device__ __forceinline__ float bf2f(unsigned short v) { return __uint_as_float((unsigned)v << 16); }
__device__ __forceinline__ bf16_t f2b(float x) { return (bf16_t)(cvt_pk_bf16(x, 0.f) & 0xffffu); }
__device__ __forceinline__ int crow(int r, int hi) { return (r & 3) + 8 * (r >> 2) + 4 * hi; }
__device__ __forceinline__ int v_st(int k, int c) { const int kk = (k & ~0xC) | ((k & 4) << 1) | ((k & 8) >> 1); return ((kk >> 3) * 4 + (c >> 5)) * 512 + ((kk & 7) * 32 + (c & 31)) * 2; }
__device__ __forceinline__ int v_rd_base(int lane) { return ((lane & 3) << 3) | (((lane >> 2) & 3) << 6) | (((lane >> 4) & 1) << 5) | (((lane >> 5) & 1) << 8); }
__device__ __forceinline__ int kswz512(int row, int colB) { return row * 528 + colB; }
__device__ __forceinline__ int kswz256(int row, int colB) { return row * 256 + (colB ^ ((row & 7) << 4)); }
typedef short v4i16_t __attribute__((ext_vector_type(4)));
__device__ __forceinline__ s16x4 vtr(LAS unsigned char* p) { return __builtin_bit_cast(s16x4, __builtin_amdgcn_ds_read_tr16_b64_v4i16((LAS v4i16_t*)p)); }
__device__ __forceinline__ bf16x8 tr_frag(LAS unsigned char* img_plus_rdbase, int d0, int ks) {
    LAS unsigned char* p = img_plus_rdbase + d0 * 512 + ks * 4096; const s16x4 lo = vtr(p), hi = vtr(p + 2048);
    return (bf16x8){lo[0], lo[1], lo[2], lo[3], hi[0], hi[1], hi[2], hi[3]};
}
__device__ __forceinline__ float swap_add(float v) { auto rr = __builtin_amdgcn_permlane32_swap(__float_as_uint(v), __float_as_uint(v), false, false); return __uint_as_float(rr[0]) + __uint_as_float(rr[1]); }
__device__ __forceinline__ float swap_max(float v) { auto rr = __builtin_amdgcn_permlane32_swap(__float_as_uint(v), __float_as_uint(v), false, false); return fmaxf(__uint_as_float(rr[0]), __uint_as_float(rr[1])); }
#define PK4(P, BASE, OUT) do { unsigned a0_ = cvt_pk_bf16(P[BASE + 0], P[BASE + 1]), a1_ = cvt_pk_bf16(P[BASE + 2], P[BASE + 3]);   \
    unsigned b0_ = cvt_pk_bf16(P[BASE + 4], P[BASE + 5]), b1_ = cvt_pk_bf16(P[BASE + 6], P[BASE + 7]);                              \
    auto r0_ = __builtin_amdgcn_permlane32_swap(a0_, b0_, false, false); auto r1_ = __builtin_amdgcn_permlane32_swap(a1_, b1_, false, false); \
    u32x4 w_ = {r0_[0], r1_[0], r0_[1], r1_[1]}; OUT = __builtin_bit_cast(bf16x8, w_); } while (0)

struct Args { const float* in[14]; float* out; unsigned char* ws; int ph_lo, ph_hi; };
#define LAUNDER_S(p) asm volatile("" : "+s"(p))
struct Frame {
    LAS unsigned char* lds; volatile LAS unsigned* MISC; gu32* ctl;
    int tid, lane, wave, vcu, G;
    GAS float* out; GAS unsigned char* ws;
};
#define WSP(T, off) ((GAS T*)(F.ws + (off)))
#ifdef DIAG_A
#define STAMP(k) do { if (blockIdx.x == 0 && F.tid == 0) __hip_atomic_store((unsigned*)(F.ctl + 12288 + (k)), (unsigned)__builtin_amdgcn_s_memrealtime(), __ATOMIC_RELAXED, __HIP_MEMORY_SCOPE_AGENT); } while (0)
#else
#define STAMP(k) do { } while (0)
#endif
__device__ __forceinline__ const GAS float* inp(Frame& F, int k) {
    volatile LAS unsigned* t = (volatile LAS unsigned*)(F.lds + LDSCTL_OFF + 1024) + 2 * k;
    const unsigned lo = __builtin_amdgcn_readfirstlane(t[0]), hi = __builtin_amdgcn_readfirstlane(t[1]);
    return (const GAS float*)(((unsigned long long)hi << 32) | lo);
}
__device__ __forceinline__ bool phase_enter(Frame& F) { LAUNDER_S(F.ws); LAUNDER_S(F.out); asm volatile("" : "+v"(F.tid)); F.lane = F.tid & 63; F.wave = __builtin_amdgcn_readfirstlane(F.tid >> 6); return true; }

__device__ __forceinline__ int map_w1(int d) {
    const int tile = d >> 8, r = d & 255;
    if (tile < 12) return d;
    if (tile < 20) { const int t = tile - 12; return r < 128 ? 3072 + 128 * t + r : 4096 + 128 * t + (r - 128); }
    return 5136 + (d - 5120);
}
__device__ __forceinline__ int map_w3(int d) {
    const int tile = d >> 8, r = d & 255;
    if (tile < 10) return d;
    if (tile < 18) { const int t = tile - 10; return r < 128 ? 3584 + 128 * t + r : 4608 + 128 * t + (r - 128); }
    { const int t = tile - 18; return r < 128 ? 2560 + 128 * t + r : 5632 + 128 * t + (r - 128); }
}
__device__ __forceinline__ void transpose_item(const GAS float* W, int ldw, int K, GAS bf16_t* WT, int drow0, int scol0, const GAS float* gain, LAS float* scr, int kb, int lane) {
    const int k0 = 64 * kb;
#pragma unroll 8
    for (int i = 0; i < 32; ++i) { const int kk = 2 * i + (lane >> 5); const float gs = gain ? gain[k0 + kk] : 1.f; scr[kk * 33 + (lane & 31)] = W[(size_t)(k0 + kk) * ldw + scol0 + (lane & 31)] * gs; }
    LDS_WAIT(); asm volatile("" ::: "memory");
    const int c = lane & 7;
#pragma unroll
    for (int j = 0; j < 4; ++j) { const int n = (lane >> 3) + 8 * j; const LAS float* s = scr + (8 * c) * 33 + n;
        v4u o; o.x = cvt_pk_bf16(s[0 * 33], s[1 * 33]); o.y = cvt_pk_bf16(s[2 * 33], s[3 * 33]); o.z = cvt_pk_bf16(s[4 * 33], s[5 * 33]); o.w = cvt_pk_bf16(s[6 * 33], s[7 * 33]);
        *(GAS v4u*)(WT + (size_t)(drow0 + n) * K + k0 + 8 * c) = o; }
    LDS_WAIT(); asm volatile("" ::: "memory");
}
__device__ __forceinline__ float logsigmoidf_(float x) { return fminf(x, 0.f) - log1pf(expf(-fabsf(x))); }
__device__ __forceinline__ void p0_prologue(Frame& F, const Args& A_) {
    LAS float* scr = (LAS float*)(F.lds + F.wave * 16384);
    const int gw = F.vcu * NWAVES + F.wave, NGW = F.G * NWAVES;
    constexpr int I_W1 = 16 * 288, I_W2 = 32 * 32, I_W4 = 32 * 32;
    for (int it = gw; it < I_W1 + I_W2 + I_W4; it += NGW) {
        int r = it;
        if (r < I_W1) { const int kb = r / 288, d = 32 * (r % 288); transpose_item(inp(F, 3), EVEN_IN, 1024, WSP(bf16_t, WS_W1T), d, map_w1(d), nullptr, scr, kb, F.lane); continue; } r -= I_W1;
        if (r < I_W2) { const int kb = r / 32, d = 32 * (r % 32); transpose_item(inp(F, 5), 1024, 2048, WSP(bf16_t, WS_W2T), d, d, nullptr, scr, kb, F.lane); continue; } r -= I_W2;
        { const int kb = r / 32, d = 32 * (r % 32); transpose_item(inp(F, 9), 1024, 2048, WSP(bf16_t, WS_W4T), d, d, nullptr, scr, kb, F.lane); }
    }
    { const int gt = blockIdx.x * NTHR + F.tid;
      if (gt < 6144) { const int isc = gt >= 4096; const int e = isc ? gt - 4096 : gt; const int pos = e >> 5, i = e & 31;
          const float inv = powf(10000.f, -(float)i / 32.f); const float ang = (float)pos * inv;
          GAS float* tb = WSP(float, WS_ROPE) + (isc ? 8192 : 0); tb[e * 2] = cosf(ang); tb[e * 2 + 1] = sinf(ang); } }
    __syncthreads();
    LAS float* wg = (LAS float*)F.lds;
    { const GAS float* W = inp(F, 3); const GAS float* g0 = inp(F, 1);
      for (int idx = F.tid; idx < 16384; idx += NTHR) { const int k = idx >> 4, j = idx & 15; wg[k * 17 + j] = g0[k] * W[(size_t)k * EVEN_IN + 5120 + j]; } }
    __syncthreads();
    const GAS float* x = inp(F, 0); const GAS float* g0 = inp(F, 1); const GAS float* gb = inp(F, 4);
    GAS bf16_t* U0 = WSP(bf16_t, WS_U0); GAS float* rs0 = WSP(float, WS_RS0); GAS float* gates = WSP(float, WS_GATES);
    for (int task = F.wave * F.G + F.vcu; task < M / 16; task += NGW) {
        const int i = F.lane & 15, kk = F.lane >> 4; const int row = task * 16 + i;
        const GAS float* xr = x + (size_t)row * 1024 + 4 * kk; GAS bf16_t* ur = U0 + (size_t)row * 1024 + 4 * kk;
        f32x4 acc = {0.f, 0.f, 0.f, 0.f}; float ss = 0.f;
#pragma unroll 4
        for (int s = 0; s < 64; ++s) {
            const f32x4 xv = *(const GAS f32x4*)(xr + 16 * s); const f32x4 gv = *(const GAS f32x4*)(g0 + 16 * s + 4 * kk);
            ss += (xv[0] * xv[0] + xv[1] * xv[1]) + (xv[2] * xv[2] + xv[3] * xv[3]);
            u32x2 w; w.x = cvt_pk_bf16(xv[0] * gv[0], xv[1] * gv[1]); w.y = cvt_pk_bf16(xv[2] * gv[2], xv[3] * gv[3]); *(GAS u32x2*)(ur + 16 * s) = w;
#pragma unroll
            for (int e = 0; e < 4; ++e) { const float bv = wg[(16 * s + 4 * kk + e) * 17 + i]; acc = __builtin_amdgcn_mfma_f32_16x16x4f32(xv[e], bv, acc, 0, 0, 0); }
        }
        ss += __shfl_xor(ss, 16); ss += __shfl_xor(ss, 32);
        const float r = 1.0f / sqrtf(ss * (1.f / 1024.f) + RMS_EPS);
        if (kk == 0) { rs0[row] = r; WSP(float, WS_PART)[row] = 0.f; }
        const int j = i, gi = j >> 2, hh = j & 3; const float bias = gb[j];
        f32x4 gv;
#pragma unroll
        for (int reg = 0; reg < 4; ++reg) { const float rr = __shfl(r, 4 * kk + reg); float g = acc[reg] * rr + bias; if (gi & 1) g = logsigmoidf_(g); gv[reg] = g; }
        const int row0 = task * 16 + 4 * kk; const int b = row0 >> 13, t = row0 & 8191;
        *(GAS f32x4*)(gates + ((size_t)((gi * 2 + b) * 4 + hh)) * 8192 + t) = gv;
    }
}

constexpr int L_TAB = 0, L_KIMG = 16384, L_VIMG = 50176, L_CIMG = 66560;
constexpr int T_IGF = 0, T_LFF = 256, T_IGB = 512, T_LFB = 768, T_BF = 1024, T_CB = 1280, T_X0 = 1536, T_X1 = 1792, T_X2 = 2048, T_X3 = 2304, T_AF2 = 3072, T_AB2 = 3328, T_NF = 3584, T_NB = 3840;
template <int OP> __device__ __forceinline__ float scan256(float v, LAS float* scr, int tid) {
    const int lane = tid & 63, w = tid >> 6;
#pragma unroll
    for (int o = 1; o < 64; o <<= 1) { const float t = __shfl_up(v, o); if (lane >= o) v = OP ? fmaxf(v, t) : v + t; }
    if (lane == 63) scr[w] = v;
    __syncthreads();
    const int w0 = w & 4;
    float pre = OP ? -3.0e38f : 0.f;
    for (int k = w0; k < w; ++k) pre = OP ? fmaxf(pre, scr[k]) : pre + scr[k];
    v = OP ? fmaxf(v, pre) : v + pre;
    __syncthreads();
    return v;
}
__device__ __forceinline__ void gate_tables(LAS float* T, const GAS float* gates, int b, int h, int c, int tid) {
    const int t = tid < 256 ? tid : 511 - tid;
    float ig, lf;
    if (tid < 256) { ig = gates[((size_t)((0 * 2 + b) * 4 + h)) * 8192 + c * 256 + t]; lf = gates[((size_t)((1 * 2 + b) * 4 + h)) * 8192 + c * 256 + t]; T[T_IGF + t] = ig; T[T_LFF + t] = lf; }
    else           { ig = gates[((size_t)((2 * 2 + b) * 4 + h)) * 8192 + c * 256 + t]; lf = gates[((size_t)((3 * 2 + b) * 4 + h)) * 8192 + c * 256 + t]; T[T_IGB + t] = ig; T[T_LFB + t] = lf; }
    const float cs = scan256<0>(lf, T + 2560, tid);
    T[(tid < 256 ? T_BF : T_CB) + t] = cs;
    __syncthreads();
}
#define GLD8(base, boff) (*(const GAS bf16x8*)((const GAS char*)(base) + (size_t)(unsigned)(boff)))
#define GP16(base, boff) (*(GAS bf16_t*)((GAS char*)(base) + (size_t)(unsigned)(boff)))
#define GPC16(base, boff) (*(const GAS bf16_t*)((const GAS char*)(base) + (size_t)(unsigned)(boff)))
__device__ __forceinline__ void stage_k256(LAS unsigned char* L, const GAS bf16_t* src, int ld, unsigned kgo, unsigned klo) {
#pragma unroll
    for (int i = 0; i < 4; ++i) *(LAS bf16x8*)(L + L_KIMG + klo + i * (16 * 528)) = GLD8(src + (size_t)(16 * i) * ld, kgo);
}
__device__ __forceinline__ void x1_unit(Frame& F, const Args& A_, int unit) {
    const int bh = unit >> 5, c = unit & 31, b = bh >> 2, h = bh & 3;
    int tid = F.tid; asm volatile("" : "+v"(tid)); const int lane = tid & 63, wave = F.wave, r32 = lane & 31, hi = lane >> 5;
    LAS unsigned char* L = F.lds; LAS float* T = (LAS float*)(L + L_TAB);
    const size_t grow0 = (size_t)b * SEQ + c * 256;
    const GAS bf16_t* kb = WSP(bf16_t, WS_A1) + ((size_t)h * M + grow0) * 256; const GAS bf16_t* vb = WSP(bf16_t, WS_A2) + ((size_t)h * M + grow0) * 256;
    GAS bf16_t* states = (GAS bf16_t*)F.out; GAS float* nst = WSP(float, WS_NST); GAS float* chsc = WSP(float, WS_CHSC);
    LAUNDER_S(kb); LAUNDER_S(vb); LAUNDER_S(states); LAUNDER_S(nst);
    gate_tables(T, WSP(float, WS_GATES), b, h, c, tid);
    const float Gf = T[T_BF + 255], Gb = T[T_CB + 0];
    if (tid < 256) { T[T_X0 + tid] = Gf - T[T_BF + tid] + T[T_IGF + tid]; T[T_X1 + tid] = Gb - T[T_CB + tid] + T[T_IGB + tid]; }
    __syncthreads();
    float mlf, mlb;
    { const int t = tid < 256 ? tid : 511 - tid; (void)scan256<1>(T[(tid < 256 ? T_X0 : T_X1) + t], T + 2560, tid);
      mlf = fmaxf(fmaxf(T[2560], T[2561]), fmaxf(T[2562], T[2563])); mlb = fmaxf(fmaxf(T[2564], T[2565]), fmaxf(T[2566], T[2567])); }
    __syncthreads();
    if (tid < 256) { T[T_X2 + tid] = expf(T[T_X0 + tid] - mlf); T[T_X3 + tid] = expf(T[T_X1 + tid] - mlb); }
    if (tid == 0) { GAS float* p = chsc + (size_t)((0 * 8 + bh) * 32 + c) * 4; p[0] = Gf; p[1] = mlf; GAS float* q = chsc + (size_t)((1 * 8 + bh) * 32 + c) * 4; q[0] = Gb; q[1] = mlb; }
    __syncthreads();
    const int sr = tid >> 4, sc8 = (tid & 15) * 8;
    const unsigned go = (unsigned)(sr * 256 + sc8) * 2u; const unsigned lo0 = (unsigned)v_st(sr, sc8), lo1 = (unsigned)v_st(32 + sr, sc8);
    LAS unsigned char* rdk = L + L_KIMG + v_rd_base(lane); LAS unsigned char* rdv = L + L_VIMG + (wave >> 2) * 16384 + (wave & 3) * 512 + v_rd_base(lane);
#pragma unroll 1
    for (int dir = 0; dir < 2; ++dir) {
        f32x16 acc[8];
#pragma unroll
        for (int j = 0; j < 8; ++j) acc[j] = f32x16{};
        float dn = 0.f; const int wofs = dir ? T_X3 : T_X2;
#pragma unroll 1
        for (int t4 = 0; t4 < 4; ++t4) {
            const GAS bf16_t* kt = kb + (size_t)(t4 * 64) * 256; const GAS bf16_t* vt = vb + (size_t)(t4 * 64) * 256;
#pragma unroll
            for (int half = 0; half < 2; ++half)
#pragma unroll
                for (int q = 0; q < 2; ++q) {
                    const bf16x8 kv = GLD8(kt + (size_t)(32 * q) * 256 + half * 128, go);
                    const bf16x8 vv = GLD8(vt + (size_t)(32 * q) * 256 + half * 128, go);
                    const float w = T[wofs + t4 * 64 + sr + 32 * q];
                    u32x4 pv; pv.x = cvt_pk_bf16(bf2f(vv[0]) * w, bf2f(vv[1]) * w); pv.y = cvt_pk_bf16(bf2f(vv[2]) * w, bf2f(vv[3]) * w); pv.z = cvt_pk_bf16(bf2f(vv[4]) * w, bf2f(vv[5]) * w); pv.w = cvt_pk_bf16(bf2f(vv[6]) * w, bf2f(vv[7]) * w);
                    *(LAS bf16x8*)(L + L_KIMG + half * 16384 + (q ? lo1 : lo0)) = kv;
                    *(LAS u32x4*)(L + L_VIMG + half * 16384 + (q ? lo1 : lo0)) = pv; }
            __syncthreads();
#pragma unroll
            for (int ks = 0; ks < 4; ++ks) { const bf16x8 Af = tr_frag(rdv, 0, ks);
#pragma unroll
                for (int j = 0; j < 8; ++j) { const bf16x8 Bf = tr_frag(rdk + (j >> 2) * 16384, j & 3, ks); acc[j] = __builtin_amdgcn_mfma_f32_32x32x16_bf16(Af, Bf, acc[j], 0, 0, 0); } }
            if (tid < 256) { const int k = tid; LAS unsigned char* kp = L + L_KIMG + (k >> 7) * 16384 + (((k & 127) >> 5) * 512 + (k & 31) * 2);
#pragma unroll 8
                for (int key = 0; key < 64; ++key) { const int kk = (key & ~0xC) | ((key & 4) << 1) | ((key & 8) >> 1);
                    dn += T[wofs + t4 * 64 + key] * bf2f(*(LAS bf16_t*)(kp + (kk >> 3) * 2048 + (kk & 7) * 64)); } }
            __syncthreads();
        }
        GAS bf16_t* dst = states + (size_t)((dir * 8 + bh) * 32 + c) * 65536 + (size_t)(32 * wave) * 256;
        const unsigned so = (unsigned)(4 * hi * 256 + r32) * 2u;
#pragma unroll
        for (int r = 0; r < 16; ++r) {
#pragma unroll
            for (int j = 0; j < 8; ++j) GP16(dst, so + ((r & 3) + 8 * (r >> 2)) * 512 + 64 * j) = f2b(acc[j][r]);
            if ((r & 3) == 3) asm volatile("" ::: "memory"); }
        if (tid < 256) nst[(size_t)((dir * 8 + bh) * 32 + c) * 256 + tid] = dn;
    }
    __syncthreads();
}
__device__ __forceinline__ void x2_scan(Frame& F) {
    const int bid = F.vcu, tid = F.tid; LAS float* T = (LAS float*)(F.lds);
    GAS bf16_t* states = (GAS bf16_t*)F.out; GAS float* nst = WSP(float, WS_NST); GAS float* chsc = WSP(float, WS_CHSC);
#pragma unroll 1
    for (int blk = bid; blk < 256; blk += F.G) {
        const int chain = blk >> 4, dir = chain >> 3; const bool first = (blk & 15) == 0;
        if (tid == 0) { float m = -1e30f;
            for (int i = 0; i < 32; ++i) { const int c = dir ? 31 - i : i; GAS float* p = chsc + (size_t)(chain * 32 + c) * 4; const float G = p[0], ml = p[1];
                if (first) p[2] = m; const float mo = fmaxf(G + m, ml); T[i] = expf(G + m - mo); T[32 + i] = expf(ml - mo); m = mo; } }
        __syncthreads();
        const unsigned e8 = (unsigned)((blk & 15) * 512 + tid) * 16u;
        float st[8];
#pragma unroll
        for (int j = 0; j < 8; ++j) st[j] = 0.f;
        GAS bf16_t* cb = states + (size_t)(chain * 32) * 65536;
#pragma unroll 4
        for (int i = 0; i < 32; ++i) { const int c = dir ? 31 - i : i; GAS bf16_t* p = (GAS bf16_t*)((GAS char*)(cb + (size_t)c * 65536) + (size_t)e8);
            const bf16x8 d = *(const GAS bf16x8*)p; const float so = T[i], sw = T[32 + i];
            u32x4 w; w.x = cvt_pk_bf16(st[0], st[1]); w.y = cvt_pk_bf16(st[2], st[3]); w.z = cvt_pk_bf16(st[4], st[5]); w.w = cvt_pk_bf16(st[6], st[7]); *(GAS u32x4*)p = w;
#pragma unroll
            for (int j = 0; j < 8; ++j) st[j] = so * st[j] + sw * bf2f(d[j]); }
        if (first && tid < 256) { float sn = 0.f;
            for (int i = 0; i < 32; ++i) { const int c = dir ? 31 - i : i; GAS float* p = nst + (size_t)(chain * 32 + c) * 256 + tid; const float d = *p; *p = sn; sn = T[i] * sn + T[32 + i] * d; } }
        __syncthreads();
    }
}
template <int NK> __device__ __forceinline__ void st_tile(f32x16& p0, f32x16& p1, LAS unsigned char* kp, const bf16x8* qr) {
    p0 = f32x16{}; p1 = f32x16{};
#pragma unroll
    for (int d0 = 0; d0 < NK; ++d0) { const bf16x8 b0 = *(const LAS bf16x8*)(kp + 32 * d0), b1 = *(const LAS bf16x8*)(kp + 32 * 528 + 32 * d0);
        p0 = __builtin_amdgcn_mfma_f32_32x32x16_bf16(b0, qr[d0], p0, 0, 0, 0); p1 = __builtin_amdgcn_mfma_f32_32x32x16_bf16(b1, qr[d0], p1, 0, 0, 0); }
}
constexpr int X3_KB0 = 16384, X3_KBS = 33280, X3_VB0 = X3_KB0 + 2 * X3_KBS  , X3_VBS = 16384;
static_assert(X3_VB0 + 2 * X3_VBS <= LDSCTL_OFF, "X3 LDS map");
#define GLDS16(gp, lp) __builtin_amdgcn_global_load_lds((const GAS unsigned*)(gp), (LAS unsigned*)(lp), 16, 0, 0)
__device__ __forceinline__ void dma_rows64(const GAS bf16_t* src, LAS unsigned char* ldsbuf, int wave, unsigned lane_off) {
    const GAS char* g = (const GAS char*)src + (size_t)(wave * 4096u) + (size_t)lane_off;
#pragma unroll
    for (int i = 0; i < 4; ++i) GLDS16(g + i * 1024, ldsbuf + (wave * 4 + i) * 1040);
}
__device__ __forceinline__ void dma_v64(const GAS bf16_t* src, LAS unsigned char* ldsbuf, int wave, const unsigned (&voff)[2]) {
#pragma unroll
    for (int i = 0; i < 2; ++i) GLDS16((const GAS char*)src + (size_t)voff[i], ldsbuf + (wave * 2 + i) * 1024);
}
template <int NK> __device__ __forceinline__ void st_tile2(f32x16& p0, f32x16& p1, LAS unsigned char* kp, const bf16x8* qr) {
    p0 = f32x16{}; p1 = f32x16{};
#pragma unroll
    for (int d0 = 0; d0 < NK; ++d0) { const bf16x8 b0 = *(const LAS bf16x8*)(kp + 32 * d0), b1 = *(const LAS bf16x8*)(kp + 16 * 1040 + 32 * d0);
        p0 = __builtin_amdgcn_mfma_f32_32x32x16_bf16(b0, qr[d0], p0, 0, 0, 0); p1 = __builtin_amdgcn_mfma_f32_32x32x16_bf16(b1, qr[d0], p1, 0, 0, 0); }
}
__device__ __forceinline__ void x3_unit(Frame& F, const Args& A_, int unit) {
    const int bh = unit >> 5, c = unit & 31, b = bh >> 2, h = bh & 3;
    int tid = F.tid; asm volatile("" : "+v"(tid)); const int lane = tid & 63, wave = F.wave, r32 = lane & 31, hi = lane >> 5;
    LAS unsigned char* L = F.lds; LAS float* T = (LAS float*)(L + L_TAB);
    const size_t grow0 = (size_t)b * SEQ + c * 256;
    const GAS bf16_t* qb = WSP(bf16_t, WS_A0) + ((size_t)h * M + grow0) * 256; const GAS bf16_t* kb = WSP(bf16_t, WS_A1) + ((size_t)h * M + grow0) * 256;
    const GAS bf16_t* vb = WSP(bf16_t, WS_A2) + ((size_t)h * M + grow0) * 256; const GAS bf16_t* gb = WSP(bf16_t, WS_A3) + ((size_t)h * M + grow0 + 32 * wave) * 256;
    const GAS bf16_t* states = (const GAS bf16_t*)F.out + (size_t)(bh * 32 + c) * 65536;
    const GAS float* nst = WSP(float, WS_NST); const GAS float* chsc = WSP(float, WS_CHSC);
    GAS bf16_t* mb0 = WSP(bf16_t, WS_MIX0) + (grow0 + 32 * wave) * 2048 + h * 256;
    const GAS float* ng = inp(F, 6) + h * 256;
    LAUNDER_S(qb); LAUNDER_S(kb); LAUNDER_S(vb); LAUNDER_S(gb); LAUNDER_S(mb0); LAUNDER_S(states);
    const unsigned lane_off = (unsigned)((lane >> 5) * 512 + (lane & 31) * 16);
    dma_rows64(kb, L + X3_KB0, wave, lane_off);
    gate_tables(T, WSP(float, WS_GATES), b, h, c, tid);
    if (tid < 256) { T[T_X0 + tid] = T[T_IGF + tid] - T[T_BF + tid]; T[T_NF + tid] = nst[(size_t)((0 * 8 + bh) * 32 + c) * 256 + tid]; }
    else { const int t = tid - 256; T[T_X1 + t] = T[T_IGB + t] - T[T_CB + t]; T[T_NB + t] = nst[(size_t)((1 * 8 + bh) * 32 + c) * 256 + t]; }
    const float mf = chsc[(size_t)((0 * 8 + bh) * 32 + c) * 4 + 2], mb = chsc[(size_t)((1 * 8 + bh) * 32 + c) * 4 + 2];
    __syncthreads();
    { const int t = tid < 256 ? tid : 511 - tid; const float pm = scan256<1>(T[(tid < 256 ? T_X0 : T_X1) + t], T + 2560, tid);
      T[(tid < 256 ? T_X2 : T_X3) + t] = fmaxf(pm, tid < 256 ? mf : mb); }
    const int tq = 32 * wave + r32;
    bf16x8 qr[16];
    { const unsigned qo = (unsigned)(tq * 256 + 8 * hi) * 2u;
#pragma unroll
      for (int d0 = 0; d0 < 16; ++d0) qr[d0] = GLD8(qb + 16 * d0, qo); }
    __syncthreads();
    STAMP(20);
    const float Rf = T[T_X2 + tq], Rb = T[T_X3 + tq];
    const unsigned kpo = (unsigned)((r32 >> 1) * 1040 + (r32 & 1) * 512 + 16 * hi);
    float denf = 0.f, denb = 0.f;
#pragma unroll 1
    for (int j = 0; j < 4; ++j) {
        if (j < 3) dma_rows64(kb + (size_t)(64 * (j + 1)) * 256, L + X3_KB0 + ((j + 1) & 1) * X3_KBS, wave, lane_off);
        else       dma_rows64(states + (size_t)0, L + X3_KB0, wave, lane_off);
        f32x16 p0, p1; st_tile2<16>(p0, p1, L + X3_KB0 + (j & 1) * X3_KBS + kpo, qr);
        LAS float* tf = T + T_X0 + 64 * j + 4 * hi; LAS float* tb = T + T_X1 + 64 * j + 4 * hi; const int sb0 = 64 * j + 4 * hi;
#pragma unroll
        for (int r = 0; r < 16; ++r) { const int cr = (r & 3) + 8 * (r >> 2);
            const float uf0 = tf[cr], uf1 = tf[cr + 32], ub0 = tb[cr], ub1 = tb[cr + 32];
            const float ef0 = fexp(uf0 - Rf), ef1 = fexp(uf1 - Rf), eb0 = fexp(ub0 - Rb), eb1 = fexp(ub1 - Rb);
            const int s0 = sb0 + cr, s1 = s0 + 32;
            denf += ((s0 <= tq) ? ef0 : 0.f) * p0[r] + ((s1 <= tq) ? ef1 : 0.f) * p1[r];
            denb += ((s0 >= tq) ? eb0 : 0.f) * p0[r] + ((s1 >= tq) ? eb1 : 0.f) * p1[r];
            if ((r & 3) == 3) asm volatile("" ::: "memory"); }
        __syncthreads();
    }
    STAMP(21);
    denf = swap_add(denf); denb = swap_add(denb);
    float nqf = 0.f, nqb = 0.f;
#pragma unroll
    for (int d0 = 0; d0 < 16; ++d0) {
#pragma unroll
        for (int jj = 0; jj < 8; ++jj) { const float qv = bf2f(qr[d0][jj]); nqf += qv * T[T_NF + 16 * d0 + 8 * hi + jj]; nqb += qv * T[T_NB + 16 * d0 + 8 * hi + jj]; }
        asm volatile("" ::: "memory"); }
    nqf = swap_add(nqf); nqb = swap_add(nqb);
    float sf, sb;
    { const float ef = fexp(mf - Rf), eb = fexp(mb - Rb);
      const float dtf = ef * nqf + denf, dtb = eb * nqb + denb;
      sf = 1.f / fmaxf(fabsf(dtf), expf(-T[T_BF + tq] - Rf)); sb = 1.f / fmaxf(fabsf(dtb), expf(-T[T_CB + tq] - Rb));
      if (hi == 0) { T[T_AF2 + tq] = ef * sf; T[T_AB2 + tq] = eb * sb; } }
    __syncthreads();
    STAMP(22);
    unsigned voff[2];
#pragma unroll
    for (int i = 0; i < 2; ++i) { const int st = 2 * (2 * wave + i) + (lane >> 5), kk = 8 * (st >> 2) + ((lane >> 2) & 7), key = (kk & ~0xC) | ((kk & 4) << 1) | ((kk & 8) >> 1);
        voff[i] = (unsigned)(key * 256 + 32 * (st & 3) + 8 * (lane & 3)) * 2u; }
    f32x16 o[4];
#pragma unroll 1
    for (int dvh = 0; dvh < 2; ++dvh) {
#pragma unroll
        for (int d = 0; d < 4; ++d) o[d] = f32x16{};
#pragma unroll 1
        for (int p = 0; p < 4; ++p) {
            if (p < 3) dma_rows64(states + (size_t)((p + 1) >> 1) * (8 * 32 * 65536) + (size_t)(128 * dvh + 64 * ((p + 1) & 1)) * 256, L + X3_KB0 + ((p + 1) & 1) * X3_KBS, wave, lane_off);
            else { dma_rows64(kb, L + X3_KB0, wave, lane_off); dma_v64(vb + 128 * dvh, L + X3_VB0, wave, voff); }
            LAS unsigned char* cp = L + X3_KB0 + (p & 1) * X3_KBS + kpo;
            LAS float* ta = T + ((p >> 1) ? T_AB2 : T_AF2) + 32 * wave + 4 * hi;
#pragma unroll
            for (int dd = 0; dd < 2; ++dd) { f32x16 tmp = f32x16{};
#pragma unroll
                for (int d0 = 0; d0 < 16; ++d0) { const bf16x8 Bf = *(const LAS bf16x8*)(cp + dd * (16 * 1040) + 32 * d0); tmp = __builtin_amdgcn_mfma_f32_32x32x16_bf16(qr[d0], Bf, tmp, 0, 0, 0); }
                if (p & 1) {
#pragma unroll
                    for (int r = 0; r < 16; ++r) o[2 + dd][r] += tmp[r] * ta[(r & 3) + 8 * (r >> 2)];
                } else {
#pragma unroll
                    for (int r = 0; r < 16; ++r) o[dd][r] += tmp[r] * ta[(r & 3) + 8 * (r >> 2)];
                } }
            __syncthreads();
        }
        STAMP(23 + 3 * dvh);
#pragma unroll 1
        for (int j = 0; j < 4; ++j) {
            if (j < 3) { dma_rows64(kb + (size_t)(64 * (j + 1)) * 256, L + X3_KB0 + ((j + 1) & 1) * X3_KBS, wave, lane_off); dma_v64(vb + (size_t)(64 * (j + 1)) * 256 + 128 * dvh, L + X3_VB0 + ((j + 1) & 1) * X3_VBS, wave, voff); }
            else if (dvh == 0) dma_rows64(states + (size_t)128 * 256, L + X3_KB0, wave, lane_off);
            f32x16 p0, p1; st_tile2<16>(p0, p1, L + X3_KB0 + (j & 1) * X3_KBS + kpo, qr);
            LAS float* tf = T + T_X0 + 64 * j + 4 * hi; LAS float* tb = T + T_X1 + 64 * j + 4 * hi; const int sb0 = 64 * j + 4 * hi;
#pragma unroll
            for (int r = 0; r < 16; ++r) { const int cr = (r & 3) + 8 * (r >> 2);
                const float uf0 = tf[cr], uf1 = tf[cr + 32], ub0 = tb[cr], ub1 = tb[cr + 32];
                const float ef0 = fexp(uf0 - Rf) * sf, ef1 = fexp(uf1 - Rf) * sf, eb0 = fexp(ub0 - Rb) * sb, eb1 = fexp(ub1 - Rb) * sb;
                const int s0 = sb0 + cr, s1 = s0 + 32;
                p0[r] *= ((s0 <= tq) ? ef0 : 0.f) + ((s0 >= tq) ? eb0 : 0.f);
                p1[r] *= ((s1 <= tq) ? ef1 : 0.f) + ((s1 >= tq) ? eb1 : 0.f);
                if ((r & 3) == 3) asm volatile("" ::: "memory"); }
            bf16x8 pa0, pa1, pa2, pa3;
            PK4(p0, 0, pa0); PK4(p0, 8, pa1); PK4(p1, 0, pa2); PK4(p1, 8, pa3);
            LAS unsigned char* rdv = L + X3_VB0 + (j & 1) * X3_VBS + v_rd_base(lane);
#pragma unroll
            for (int d = 0; d < 4; ++d) {
                o[d] = __builtin_amdgcn_mfma_f32_32x32x16_bf16(pa0, tr_frag(rdv, d, 0), o[d], 0, 0, 0);
                o[d] = __builtin_amdgcn_mfma_f32_32x32x16_bf16(pa1, tr_frag(rdv, d, 1), o[d], 0, 0, 0);
                o[d] = __builtin_amdgcn_mfma_f32_32x32x16_bf16(pa2, tr_frag(rdv, d, 2), o[d], 0, 0, 0);
                o[d] = __builtin_amdgcn_mfma_f32_32x32x16_bf16(pa3, tr_frag(rdv, d, 3), o[d], 0, 0, 0); }
            __syncthreads();
        }
        STAMP(24 + 3 * dvh);
        int l_ = lane; asm volatile("" : "+v"(l_));
        const unsigned oo = (unsigned)(4 * (l_ >> 5) * 2048 + (l_ & 31)) * 2u, go_ = (unsigned)(4 * (l_ >> 5) * 256 + (l_ & 31)) * 2u;
        if (dvh == 0) {
#pragma unroll
            for (int r = 0; r < 16; ++r) { unsigned ro = oo + ((r & 3) + 8 * (r >> 2)) * 4096; asm volatile("" : "+v"(ro));
#pragma unroll
                for (int d = 0; d < 4; ++d) GP16(mb0, ro + 64 * d) = f2b(o[d][r]);
                if ((r & 3) == 3) asm volatile("" ::: "memory"); }
        }
        STAMP(25 + 3 * dvh);
    }
    {
        int l_ = lane; asm volatile("" : "+v"(l_));
        const unsigned oo = (unsigned)(4 * (l_ >> 5) * 2048 + (l_ & 31)) * 2u, go_ = (unsigned)(4 * (l_ >> 5) * 256 + (l_ & 31)) * 2u;
            asm volatile("s_waitcnt vmcnt(0)" ::: "memory");
            float ngv[8];
#pragma unroll
            for (int d = 0; d < 4; ++d) { ngv[d] = ng[32 * d + r32]; ngv[4 + d] = ng[128 + 32 * d + r32]; }
#pragma unroll
            for (int rb = 0; rb < 16; rb += 8) {
                unsigned h0[4][8], g1[4][8];
#pragma unroll
                for (int q = 0; q < 8; ++q) { const int r = rb + q; const unsigned ro = oo + ((r & 3) + 8 * (r >> 2)) * 4096, rg = go_ + ((r & 3) + 8 * (r >> 2)) * 512;
#pragma unroll
                    for (int d = 0; d < 4; ++d) { h0[d][q] = GP16(mb0, ro + 64 * d); g1[d][q] = GPC16(gb, rg + 256 + 64 * d); } }
                float rinv[8];
#pragma unroll
                for (int q = 0; q < 8; ++q) { const int r = rb + q; float s = (o[0][r] * o[0][r] + o[1][r] * o[1][r]) + (o[2][r] * o[2][r] + o[3][r] * o[3][r]);
#pragma unroll
                    for (int d = 0; d < 4; ++d) { const float hv = bf2f((bf16_t)h0[d][q]); s += hv * hv; }
                    s += __shfl_xor(s, 1); s += __shfl_xor(s, 2); s += __shfl_xor(s, 4); s += __shfl_xor(s, 8); s += __shfl_xor(s, 16);
                    rinv[q] = 1.0f / sqrtf(s * (1.f / 256.f) + RMS_EPS); }
#pragma unroll
                for (int q = 0; q < 8; ++q) { const int r = rb + q; const unsigned ro = oo + ((r & 3) + 8 * (r >> 2)) * 4096;
#pragma unroll
                    for (int d = 0; d < 4; ++d) GP16(mb0, ro + 256 + 64 * d) = f2b(o[d][r] * rinv[q] * ngv[4 + d] * bf2f((bf16_t)g1[d][q])); }
#pragma unroll
                for (int q = 0; q < 8; ++q) { const int r = rb + q; const unsigned rg = go_ + ((r & 3) + 8 * (r >> 2)) * 512;
#pragma unroll
                    for (int d = 0; d < 4; ++d) g1[d][q] = GPC16(gb, rg + 64 * d); }
#pragma unroll
                for (int q = 0; q < 8; ++q) { const int r = rb + q; const unsigned ro = oo + ((r & 3) + 8 * (r >> 2)) * 4096;
#pragma unroll
                    for (int d = 0; d < 4; ++d) GP16(mb0, ro + 64 * d) = f2b(bf2f((bf16_t)h0[d][q]) * rinv[q] * ngv[d] * bf2f((bf16_t)g1[d][q])); }
                asm volatile("" ::: "memory");
            }
        }
    STAMP(29);
    __syncthreads();
}

constexpr int L_BT = 83968, L_MT = L_BT + 4 * 15 * 128 * 4;
template <int QB> __device__ __forceinline__ void na_scores(f32x16& p0, f32x16& p1, LAS unsigned char* bt, LAS unsigned char* mt, float& m, float& l, float& alpha, bool first) {
    float pmax = -1e30f;
#pragma unroll
    for (int rr = 0; rr < 16; ++rr) { const int cr = (rr & 3) + 8 * (rr >> 2);
        if (QB == 1 && rr < 8) { } else { p0[rr] = (p0[rr] + *(LAS float*)(bt + 4 * cr)) + *(LAS float*)(mt + 4 * cr); pmax = fmaxf(pmax, p0[rr]); }
        if (QB == 0 && rr >= 8) { } else { p1[rr] = (p1[rr] + *(LAS float*)(bt + 4 * (cr + 32))) + *(LAS float*)(mt + 4 * (cr + 32)); pmax = fmaxf(pmax, p1[rr]); } }
    pmax = swap_max(pmax);
    if (first) { m = pmax; alpha = 1.f; }
    else if (__builtin_expect(__all(pmax - m <= 8.f), 1)) { alpha = 1.f; }
    else { const float mn = fmaxf(m, pmax); alpha = fexp(m - mn); m = mn; }
    const float nm = -m * 1.4426950408889634f;
    float ps = 0.f;
#pragma unroll
    for (int rr = 0; rr < 16; ++rr) {
        if (QB == 1 && rr < 8) { } else { p0[rr] = __builtin_amdgcn_exp2f(fmaf(p0[rr], 1.4426950408889634f, nm)); ps += p0[rr]; }
        if (QB == 0 && rr >= 8) { } else { p1[rr] = __builtin_amdgcn_exp2f(fmaf(p1[rr], 1.4426950408889634f, nm)); ps += p1[rr]; } }
    ps = swap_add(ps); l = l * alpha + ps;
}
template <bool LOADS, bool STORE> __device__ __forceinline__ void na_phase(Frame& F, const Args& A_) {
#ifdef PROBE_NAMAP
    const int cu = blockIdx.x;
#else
    const int cu = F.vcu;
#endif
    if (cu >= 256) return;
    const int b = cu >> 7, r = cu & 127;
    int tid = F.tid; asm volatile("" : "+v"(tid)); const int lane = tid & 63, wave = F.wave, r32 = lane & 31, hi = lane >> 5;
    LAS unsigned char* L = F.lds; LAS float* wsf = (LAS float*)(L + 8192) + wave * 64;
    const GAS float* rpb = inp(F, 7);
    const int hd = wave >> 1, qb = wave & 1, cq = 32 * qb + r32;
    const int c0 = min(max(cq - 8, 0), 48), r0 = min(max(r - 4, 0), 120);
    const size_t rowq = (size_t)b * SEQ + r * 64;
    const GAS bf16_t* qbp = WSP(bf16_t, WS_A0) + (rowq + 32 * qb) * 256 + hd * 64;
    const GAS bf16_t* zbp = WSP(bf16_t, WS_A3) + (rowq + 32 * qb) * 256 + hd * 64;
    GAS bf16_t* obp = WSP(bf16_t, WS_MIX0) + (rowq + 32 * qb) * 2048 + 1024 + hd * 64;
    const GAS bf16_t* kbp = WSP(bf16_t, WS_A1) + ((size_t)b * SEQ + (size_t)r0 * 64) * 256;
    const GAS bf16_t* vbp = WSP(bf16_t, WS_A2) + ((size_t)b * SEQ + (size_t)r0 * 64) * 256;
    LAUNDER_S(qbp); LAUNDER_S(zbp); LAUNDER_S(obp); LAUNDER_S(kbp); LAUNDER_S(vbp);
    LAS unsigned char* rdv = L + L_VIMG + (hd >> 1) * 16384 + (2 * (hd & 1)) * 512 + v_rd_base(lane);
    LAS unsigned char* kp = L + L_KIMG + r32 * 528 + 128 * hd + 16 * hi;
    LAS unsigned char* bt0 = L + L_BT + (hd * 15 * 128 + 63 - cq + 4 * hi) * 4;
    LAS unsigned char* mt = L + L_MT + (48 - c0 + 4 * hi) * 4;
    const unsigned kgo = (unsigned)((tid >> 5) * 256 + (tid & 31) * 8) * 2u, klo = (unsigned)((tid >> 5) * 528 + (tid & 31) * 16);
    unsigned vlo[4];
#pragma unroll
    for (int q = 0; q < 4; ++q) { const int key = (tid >> 5) + 16 * q, col8 = (tid & 31) * 8; vlo[q] = (unsigned)((col8 >> 7) * 16384 + v_st(key, col8 & 127)); }
    bf16x8 kst[4], vst[4];
#define NA_FETCH(s_) do { const int hg_ = (s_) >> 3, t_ = (((s_) & 7) - r0) & 7;     const GAS bf16_t* kt_ = kbp + (size_t)hg_ * ((size_t)M * 256) + (size_t)(64 * t_) * 256; const GAS bf16_t* vt_ = vbp + (size_t)hg_ * ((size_t)M * 256) + (size_t)(64 * t_) * 256; \
        _Pragma("unroll") for (int q = 0; q < 4; ++q) { kst[q] = GLD8(kt_ + (size_t)(16 * q) * 256, kgo); vst[q] = GLD8(vt_ + (size_t)(16 * q) * 256, kgo); } } while (0)
#define NA_WRITE() do { _Pragma("unroll") for (int q = 0; q < 4; ++q) { *(LAS bf16x8*)(L + L_KIMG + klo + q * (16 * 528)) = kst[q]; *(LAS bf16x8*)(L + L_VIMG + vlo[q]) = vst[q]; } } while (0)
#define NA_BIAS(hg_) do { for (int idx = tid; idx < 4 * 15 * 128; idx += NTHR) { const int x = idx & 127, hr = idx >> 7; \
        ((LAS float*)(L + L_BT))[idx] = ((unsigned)(x - 48) < 31u) ? rpb[(size_t)((hg_) * 60 + hr) * 31 + (x - 48)] : 0.f; } } while (0)
    NA_FETCH(0);
    if (tid < 128) ((LAS float*)(L + L_MT))[tid] = ((unsigned)(tid - 48) < 16u) ? 0.f : -1e30f;
    NA_BIAS(0);
    __syncthreads();
    NA_WRITE();
    __syncthreads();
    bf16x8 qr[4]; float m = -1e30f, l = 0.f; f32x16 o[2];
#pragma unroll 1
    for (int hg = 0; hg < 4; ++hg) {
        { const unsigned qo = (unsigned)(r32 * 256 + 8 * hi) * 2u;
#pragma unroll
          for (int d0 = 0; d0 < 4; ++d0) qr[d0] = GLD8(qbp + (size_t)hg * ((size_t)M * 256) + 16 * d0, qo); }
        l = 0.f; o[0] = f32x16{}; o[1] = f32x16{};
        asm volatile("" :: "v"(qr[0]), "v"(qr[1]), "v"(qr[2]), "v"(qr[3]));
#pragma unroll 1
        for (int tau = 0; tau < 8; ++tau) {
            const int s = hg * 8 + tau, i = (tau - r0) & 7;
            if (LOADS) NA_FETCH(s + 1 < 32 ? s + 1 : 31);
            f32x16 p0, p1; st_tile<4>(p0, p1, kp, qr);
            const int dr = r0 + i - r + 7; LAS unsigned char* bt = bt0 + dr * 512;
            float alpha; bf16x8 pa0, pa1, pa2, pa3;
            if (qb == 0) { na_scores<0>(p0, p1, bt, mt, m, l, alpha, tau == 0); PK4(p0, 0, pa0); PK4(p0, 8, pa1); PK4(p1, 0, pa2); }
            else         { na_scores<1>(p0, p1, bt, mt, m, l, alpha, tau == 0); PK4(p0, 8, pa1); PK4(p1, 0, pa2); PK4(p1, 8, pa3); }
            if (__any(alpha < 1.f)) { if (hi == 0) wsf[r32] = alpha;
#pragma unroll
                for (int d = 0; d < 2; ++d)
#pragma unroll
                    for (int rr = 0; rr < 16; ++rr) o[d][rr] *= wsf[crow(rr, hi)]; }
#pragma unroll
            for (int d = 0; d < 2; ++d) {
                if (qb == 1) { } else o[d] = __builtin_amdgcn_mfma_f32_32x32x16_bf16(pa0, tr_frag(rdv, d, 0), o[d], 0, 0, 0);
                o[d] = __builtin_amdgcn_mfma_f32_32x32x16_bf16(pa1, tr_frag(rdv, d, 1), o[d], 0, 0, 0);
                o[d] = __builtin_amdgcn_mfma_f32_32x32x16_bf16(pa2, tr_frag(rdv, d, 2), o[d], 0, 0, 0);
                if (qb == 0) { } else o[d] = __builtin_amdgcn_mfma_f32_32x32x16_bf16(pa3, tr_frag(rdv, d, 3), o[d], 0, 0, 0); }
            __syncthreads();
            if (LOADS && s + 1 < 32) { NA_WRITE(); if (tau == 7) NA_BIAS(hg + 1); }
            __syncthreads();
        }
        if (STORE) {
            if (hi == 0) wsf[32 + r32] = l;
            const unsigned zo = (unsigned)(4 * hi * 256 + r32) * 2u, oo = (unsigned)(4 * hi * 2048 + r32) * 2u + 512u * hg; const GAS bf16_t* zh = zbp + (size_t)hg * ((size_t)M * 256);
            unsigned zv[2][16];
#pragma unroll
            for (int rr = 0; rr < 16; ++rr) { const int cr = (rr & 3) + 8 * (rr >> 2);
#pragma unroll
                for (int d = 0; d < 2; ++d) zv[d][rr] = GPC16(zh, zo + cr * 512 + 64 * d); }
#pragma unroll
            for (int rr = 0; rr < 16; ++rr) { const float rli = __builtin_amdgcn_rcpf(wsf[32 + crow(rr, hi)]); const int cr = (rr & 3) + 8 * (rr >> 2);
#pragma unroll
                for (int d = 0; d < 2; ++d) GP16(obp, oo + cr * 4096 + 64 * d) = f2b(o[d][rr] * rli * bf2f((bf16_t)zv[d][rr])); }
        }
    }
#undef NA_FETCH
#undef NA_WRITE
#undef NA_BIAS
}

__device__ __forceinline__ void p9_krope_conv(Frame& F, const Args& A_) {
    const int gw = F.vcu * NWAVES + F.wave, NGW = F.G * NWAVES, lane = F.lane;
    GAS bf16_t* gk = WSP(bf16_t, WS_GK); const GAS float* kng = inp(F, 11); const GAS float* ropeR = WSP(float, WS_ROPE); const GAS float* ropeC = ropeR + 8192;
    for (int row = gw; row < M; row += NGW) {
        const int hd = lane >> 5, i = lane & 31; GAS bf16_t* p = gk + ((size_t)hd * M + row) * 128 + i;
        float x[4]; float ss = 0.f;
#pragma unroll
        for (int e = 0; e < 4; ++e) { x[e] = bf2f(p[32 * e]); ss += x[e] * x[e]; }
        ss += __shfl_xor(ss, 1); ss += __shfl_xor(ss, 2); ss += __shfl_xor(ss, 4); ss += __shfl_xor(ss, 8); ss += __shfl_xor(ss, 16);
        const float rr = 1.0f / sqrtf(ss * (1.f / 128.f) + RMS_EPS);
#pragma unroll
        for (int e = 0; e < 4; ++e) x[e] = x[e] * rr * kng[32 * e + i];
        const int t = row & 8191, pr = t >> 6, pc = t & 63;
        const float cr = ropeR[(pr * 32 + i) * 2], sr = ropeR[(pr * 32 + i) * 2 + 1], cc = ropeC[(pc * 32 + i) * 2], sc = ropeC[(pc * 32 + i) * 2 + 1];
        p[0] = f2b(x[0] * cr - x[1] * sr); p[32] = f2b(x[0] * sr + x[1] * cr); p[64] = f2b(x[2] * cc - x[3] * sc); p[96] = f2b(x[2] * sc + x[3] * cc);
    }
    const GAS bf16_t* xc = WSP(bf16_t, WS_XC); const GAS bf16_t* cg = WSP(bf16_t, WS_CG); GAS bf16_t* mix1 = WSP(bf16_t, WS_MIX1); const GAS float* cw = inp(F, 12); const GAS float* cbv = inp(F, 13);
    const int gt = F.vcu * NTHR + F.tid, NGT = F.G * NTHR;
    for (int it = gt; it < M * 128; it += NGT) {
        const int row = it >> 7, c8 = (it & 127) * 8, t = row & 8191;
        const bf16x8 z8 = {0, 0, 0, 0, 0, 0, 0, 0};
        const bf16x8 x0 = *(const GAS bf16x8*)(xc + (size_t)row * 1024 + c8);
        const bf16x8 xm = t > 0 ? *(const GAS bf16x8*)(xc + (size_t)(row - 1) * 1024 + c8) : z8;
        const bf16x8 xp = t < SEQ - 1 ? *(const GAS bf16x8*)(xc + (size_t)(row + 1) * 1024 + c8) : z8;
        const bf16x8 g8 = *(const GAS bf16x8*)(cg + (size_t)row * 1024 + c8);
        float y[8];
#pragma unroll
        for (int j = 0; j < 8; ++j) y[j] = bf2f(g8[j]) * (bf2f(xm[j]) * cw[c8 + j] + bf2f(x0[j]) * cw[1024 + c8 + j] + bf2f(xp[j]) * cw[2048 + c8 + j] + cbv[c8 + j]);
        u32x4 w; w.x = cvt_pk_bf16(y[0], y[1]); w.y = cvt_pk_bf16(y[2], y[3]); w.z = cvt_pk_bf16(y[4], y[5]); w.w = cvt_pk_bf16(y[6], y[7]);
        *(GAS u32x4*)(mix1 + (size_t)row * 2048 + 1024 + c8) = w;
    }
}

namespace gqa {
constexpr int D = 128, NW = 8, QBLK = 32, KVBLK = 64, LDQ = 1024, LDK = 128;
constexpr float SCALE = 0.088388347648318440f;
constexpr float THR = 8.f;
constexpr size_t SHM_V = KVBLK * D * 2, SHM_K = KVBLK * D * 2;
#define KSWZ(row, colB) ((row) * 256 + ((colB) ^ (((row) & 7) << 4)))
#define SBAR() __builtin_amdgcn_sched_barrier(0)
__device__ __forceinline__ unsigned cvtpk(float lo, float hi) { unsigned r; asm volatile("v_cvt_pk_bf16_f32 %0, %1, %2" : "=v"(r) : "v"(lo), "v"(hi)); return r; }
__device__ __forceinline__ void partialSM(f32x16& p0, f32x16& p1, float& m_reg, float& mn, float& alpha) {
  constexpr float C = SCALE * 1.4426950408889634f;
  float pmax = p0[0]; for (int r = 1; r < 16; ++r) pmax = fmaxf(pmax, p0[r]); for (int r = 0; r < 16; ++r) pmax = fmaxf(pmax, p1[r]);
  { auto rr = __builtin_amdgcn_permlane32_swap(__float_as_uint(pmax), __float_as_uint(pmax), false, false);
    pmax = fmaxf(__uint_as_float(rr[0]), __uint_as_float(rr[1])); }
  if (__builtin_expect(__all(pmax - m_reg <= THR / SCALE), 1)) { mn = m_reg; alpha = 1.f; }
  else { mn = fmaxf(m_reg, pmax); alpha = __builtin_amdgcn_exp2f((m_reg - mn) * C); m_reg = mn; }
  float mnC = -mn * C;
  for (int r = 0; r < 16; ++r) p0[r] = fmaf(p0[r], C, mnC); for (int r = 0; r < 16; ++r) p1[r] = fmaf(p1[r], C, mnC);
  for (int r = 0; r < 16; ++r) p0[r] = __builtin_amdgcn_exp2f(p0[r]);
}
__device__ __forceinline__ void finishSM(f32x16& p0, f32x16& p1, float alpha, float& l_reg, bf16x8& pa0, bf16x8& pa1, bf16x8& pa2, bf16x8& pa3) {
  for (int r = 0; r < 16; ++r) p1[r] = __builtin_amdgcn_exp2f(p1[r]);
  float ps = 0; for (int r = 0; r < 16; ++r) ps += p0[r]; for (int r = 0; r < 16; ++r) ps += p1[r];
  { auto rr = __builtin_amdgcn_permlane32_swap(__float_as_uint(ps), __float_as_uint(ps), false, false);
    ps = __uint_as_float(rr[0]) + __uint_as_float(rr[1]); }
  l_reg = l_reg * alpha + ps;
#define GPK4(P, BASE, OUT) do { unsigned a0 = cvtpk(P[BASE + 0], P[BASE + 1]), a1 = cvtpk(P[BASE + 2], P[BASE + 3]);   \
    unsigned b0 = cvtpk(P[BASE + 4], P[BASE + 5]), b1 = cvtpk(P[BASE + 6], P[BASE + 7]);                              \
    auto r0 = __builtin_amdgcn_permlane32_swap(a0, b0, false, false); auto r1 = __builtin_amdgcn_permlane32_swap(a1, b1, false, false); \
    u32x4 w = {r0[0], r1[0], r0[1], r1[1]}; OUT = *reinterpret_cast<bf16x8*>(&w); } while (0)
  GPK4(p0, 0, pa0); GPK4(p0, 8, pa1); GPK4(p1, 0, pa2); GPK4(p1, 8, pa3);
#undef GPK4
}
template <int KOFF> __device__ __forceinline__ void qkt(f32x16& p0, f32x16& p1, LAS char* K_lds, const unsigned (&ka)[4], const bf16x8* qr) {
  p0 = f32x16{}; p1 = f32x16{};
#pragma unroll
  for (int d0 = 0; d0 < 8; ++d0) {
    bf16x8 b0 = *(const LAS bf16x8*)(K_lds + ka[d0 & 3] + (KOFF + (d0 >> 2) * 128));
    bf16x8 b1 = *(const LAS bf16x8*)(K_lds + ka[d0 & 3] + (KOFF + (d0 >> 2) * 128 + 8192));
    p0 = __builtin_amdgcn_mfma_f32_32x32x16_bf16(b0, qr[d0], p0, 0, 0, 0);
    p1 = __builtin_amdgcn_mfma_f32_32x32x16_bf16(b1, qr[d0], p1, 0, 0, 0); }
}
constexpr int v_rd_off(int d0, int ks, int half) { return d0 * 512 + ks * 4096 + half * 2048; }
template <int OFF> __device__ __forceinline__ s16x4 tr_read(int vb) {
  s16x4 r; asm volatile("ds_read_b64_tr_b16 %0, %1 offset:%2" : "=&v"(r) : "v"(vb), "i"(OFF) : "memory"); return r;
}
template <int D0> __device__ __forceinline__ void pv_one(f32x16& od, int vb, bf16x8 pa0, bf16x8 pa1, bf16x8 pa2, bf16x8 pa3) {
  const s16x4 l0 = tr_read<v_rd_off(D0, 0, 0)>(vb), h0 = tr_read<v_rd_off(D0, 0, 1)>(vb), l1 = tr_read<v_rd_off(D0, 1, 0)>(vb), h1 = tr_read<v_rd_off(D0, 1, 1)>(vb);
  const s16x4 l2 = tr_read<v_rd_off(D0, 2, 0)>(vb), h2 = tr_read<v_rd_off(D0, 2, 1)>(vb), l3 = tr_read<v_rd_off(D0, 3, 0)>(vb), h3 = tr_read<v_rd_off(D0, 3, 1)>(vb);
  asm volatile("s_waitcnt lgkmcnt(0)" ::: "memory"); SBAR();
#define PK(L, H) (bf16x8){L[0], L[1], L[2], L[3], H[0], H[1], H[2], H[3]}
  od = __builtin_amdgcn_mfma_f32_32x32x16_bf16(pa0, PK(l0, h0), od, 0, 0, 0);
  od = __builtin_amdgcn_mfma_f32_32x32x16_bf16(pa1, PK(l1, h1), od, 0, 0, 0);
  od = __builtin_amdgcn_mfma_f32_32x32x16_bf16(pa2, PK(l2, h2), od, 0, 0, 0);
  od = __builtin_amdgcn_mfma_f32_32x32x16_bf16(pa3, PK(l3, h3), od, 0, 0, 0);
#undef PK
}
__device__ __forceinline__ void pv_d0(f32x16* o, int vb, bf16x8 pa0, bf16x8 pa1, bf16x8 pa2, bf16x8 pa3) {
  pv_one<0>(o[0], vb, pa0, pa1, pa2, pa3); pv_one<1>(o[1], vb, pa0, pa1, pa2, pa3); pv_one<2>(o[2], vb, pa0, pa1, pa2, pa3); pv_one<3>(o[3], vb, pa0, pa1, pa2, pa3);
}
__device__ __forceinline__ void unit(const GAS bf16_t* __restrict__ GQ, const GAS bf16_t* __restrict__ Kh, const GAS bf16_t* __restrict__ Vh, const GAS bf16_t* __restrict__ GZ, GAS bf16_t* __restrict__ MIX,
                                     const GAS float* __restrict__ qng, const GAS float* __restrict__ ropeR, const GAS float* __restrict__ ropeC, int qrow0, int head, int seq, LAS char* lds, int tid_in) {
  int tid = tid_in; asm volatile("" : "+v"(tid)); const int wid = __builtin_amdgcn_readfirstlane(tid >> 6), lane = tid & 63, r32 = lane & 31, hi = lane >> 5;
  LAUNDER_S(Kh); LAUNDER_S(Vh); LAUNDER_S(GQ); LAUNDER_S(GZ); LAUNDER_S(MIX);
  LAS bf16_t* V_lds = (LAS bf16_t*)lds; LAS bf16_t* K_lds = (LAS bf16_t*)(lds + 4 * SHM_V);
  LAS float* ws = (LAS float*)(lds + 4 * SHM_V + 4 * SHM_K) + wid * 64; LAS float* li_l = ws; LAS float* al_l = ws + 32;
  float m_reg = -1e30f, l_reg = 0; f32x16 o[4] = {}; bf16x8 qr[8];
  {
    const int row = qrow0 + wid * QBLK + r32; const GAS bf16_t* qp_ = GQ + (size_t)(qrow0 + wid * QBLK) * LDQ + head * D; const unsigned qo_ = (unsigned)(r32 * LDQ + hi * 8) * 2u;
    bf16x8 v[8]; float ss = 0.f;
#pragma unroll
    for (int d0 = 0; d0 < 8; ++d0) { v[d0] = GLD8(qp_ + d0 * 16, qo_);
#pragma unroll
      for (int j = 0; j < 8; ++j) { const float f = bf2f(v[d0][j]); ss += f * f; } }
    ss = swap_add(ss);
    const float rq = 1.0f / sqrtf(ss * (1.f / 128.f) + RMS_EPS);
    const int t = row & 8191, pr = t >> 6, pc = t & 63;
#pragma unroll
    for (int ax = 0; ax < 2; ++ax)
#pragma unroll
      for (int dd = 0; dd < 2; ++dd) { const int da = 4 * ax + dd, db = da + 2; const GAS float* tb = ax ? ropeC + (size_t)pc * 64 : ropeR + (size_t)pr * 64;
        float o1[8], o2[8];
#pragma unroll
        for (int j = 0; j < 8; ++j) { const int i = 16 * dd + 8 * hi + j; const float c = tb[i * 2], s = tb[i * 2 + 1];
          const float x1 = bf2f(v[da][j]) * rq * qng[16 * da + 8 * hi + j], x2 = bf2f(v[db][j]) * rq * qng[16 * db + 8 * hi + j];
          o1[j] = x1 * c - x2 * s; o2[j] = x1 * s + x2 * c; }
        { u32x4 w = {cvt_pk_bf16(o1[0], o1[1]), cvt_pk_bf16(o1[2], o1[3]), cvt_pk_bf16(o1[4], o1[5]), cvt_pk_bf16(o1[6], o1[7])}; qr[da] = __builtin_bit_cast(bf16x8, w); }
        { u32x4 w = {cvt_pk_bf16(o2[0], o2[1]), cvt_pk_bf16(o2[2], o2[3]), cvt_pk_bf16(o2[4], o2[5]), cvt_pk_bf16(o2[6], o2[7])}; qr[db] = __builtin_bit_cast(bf16x8, w); }
        asm volatile("" ::: "memory"); }
  }
  const int sr = tid >> 4, sc = (tid & 15) * 8, vst0 = v_st(sr, sc), vst1 = v_st(32 + sr, sc);
  const int vb0 = (int)(unsigned)(uintptr_t)V_lds + v_rd_base(lane);
  struct { bf16x8 vs0, vs1, ks0, ks1; } sr_[1];
  unsigned ka[4];
#pragma unroll
  for (int i = 0; i < 4; ++i) ka[i] = (unsigned)(r32 * 256 + ((i * 32 + hi * 16) ^ ((r32 & 7) << 4)));
  const unsigned so0 = (unsigned)(sr * LDK + sc) * 2u, so1 = (unsigned)((32 + sr) * LDK + sc) * 2u;
#define SLOAD(i, k0) do { const GAS bf16_t* vt_ = Vh + (size_t)(k0) * LDK; const GAS bf16_t* kt_ = Kh + (size_t)(k0) * LDK; \
    sr_[i].vs0 = GLD8(vt_, so0); sr_[i].vs1 = GLD8(vt_, so1); sr_[i].ks0 = GLD8(kt_, so0); sr_[i].ks1 = GLD8(kt_, so1); } while (0)
#define SWRITE(b, i) do { *(LAS bf16x8*)((LAS char*)V_lds + (b) * SHM_V + vst0) = sr_[i].vs0;          \
    *(LAS bf16x8*)((LAS char*)V_lds + (b) * SHM_V + vst1) = sr_[i].vs1; int kc = sc * 2;               \
    *(LAS bf16x8*)((LAS char*)K_lds + (b) * SHM_K + KSWZ(sr, kc)) = sr_[i].ks0;                       \
    *(LAS bf16x8*)((LAS char*)K_lds + (b) * SHM_K + KSWZ(32 + sr, kc)) = sr_[i].ks1; } while (0)
#define SWAIT() asm volatile("s_waitcnt vmcnt(0)" ::: "memory")
#define RESC(a) do { if (__any((a) < 1.f)) { if (hi == 0) al_l[r32] = (a); asm volatile("s_waitcnt lgkmcnt(0)" ::: "memory"); \
    for (int d = 0; d < 4; ++d) for (int r = 0; r < 16; ++r) o[d][r] *= al_l[crow(r, hi)]; } } while (0)
  f32x16 pA0, pA1, pB0, pB1; float mnA, mnB, alA, alB; bf16x8 pa0, pa1, pa2, pa3; const int NT = seq / KVBLK;
#define STEP(C0, C1, MNC, ALC, P0, P1, ALP, t, LD) do { \
    const int kb_ = ((t) & 3) * (int)SHM_K, vp_ = (((t) - 1) & 3) * (int)SHM_V, wb_ = (((t) + 1) & 3); \
    SBAR(); qkt<0>(C0, C1, (LAS char*)K_lds + kb_, ka, qr); \
    finishSM(P0, P1, ALP, l_reg, pa0, pa1, pa2, pa3); SBAR(); \
    if (LD) { SLOAD(0, ((t) + 1) * KVBLK); } SBAR(); \
    pv_d0(o, vb0 + vp_, pa0, pa1, pa2, pa3); partialSM(C0, C1, m_reg, MNC, ALC); \
    if (LD) { SWAIT(); SWRITE(wb_, 0); } \
    RESC(ALC); __syncthreads(); } while (0)
  SLOAD(0, 0); asm volatile("s_waitcnt vmcnt(0)" ::: "memory"); SWRITE(0, 0); __syncthreads();
  qkt<0>(pA0, pA1, (LAS char*)K_lds, ka, qr); partialSM(pA0, pA1, m_reg, mnA, alA);
  SLOAD(0, KVBLK);
  SWAIT(); SWRITE(1, 0); __syncthreads();
  int t = 1;
#pragma unroll 1
  for (; t + 2 < NT; t += 2) {
    STEP(pB0, pB1, mnB, alB, pA0, pA1, alA, t, true);
    STEP(pA0, pA1, mnA, alA, pB0, pB1, alB, t + 1, true);
  }
  STEP(pB0, pB1, mnB, alB, pA0, pA1, alA, t, false);
  finishSM(pB0, pB1, alB, l_reg, pa0, pa1, pa2, pa3); SBAR();
  pv_d0(o, vb0 + ((NT - 1) & 3) * (int)SHM_V, pa0, pa1, pa2, pa3);
#undef STEP
  if (hi == 0) li_l[r32] = l_reg; asm volatile("s_waitcnt lgkmcnt(0)" ::: "memory");
  const GAS bf16_t* zb_ = GZ + (size_t)(qrow0 + wid * QBLK) * 1024 + head * D; GAS bf16_t* ob_ = MIX + (size_t)(qrow0 + wid * QBLK) * 2048 + head * D;
  const unsigned zo_ = (unsigned)(4 * hi * 1024 + r32) * 2u, oo_ = (unsigned)(4 * hi * 2048 + r32) * 2u;
#pragma unroll
  for (int r = 0; r < 16; ++r) { const float rli = __builtin_amdgcn_rcpf(li_l[crow(r, hi)]); const int cr = (r & 3) + 8 * (r >> 2);
#pragma unroll
    for (int d0 = 0; d0 < 4; ++d0) GP16(ob_, oo_ + cr * 4096 + 64 * d0) = f2b(o[d0][r] * rli * bf2f(GPC16(zb_, zo_ + cr * 2048 + 64 * d0)));
    if ((r & 3) == 3) asm volatile("" ::: "memory"); }
  __syncthreads();
#undef SLOAD
#undef SWRITE
#undef SWAIT
#undef RESC
}
#undef KSWZ
#undef SBAR
}

__device__ __forceinline__ void p12_final(Frame& F, const Args& A_) {
    const int gw = F.vcu * NWAVES + F.wave, NGW = F.G * NWAVES; const GAS float* fg = inp(F, 2);
    for (int row = gw; row < M; row += NGW) {
        GAS f32x4* p = (GAS f32x4*)(F.out + (size_t)row * 1024) + F.lane; f32x4 v[4]; float s = 0.f;
#pragma unroll
        for (int j = 0; j < 4; ++j) { v[j] = p[64 * j]; s += (v[j][0] * v[j][0] + v[j][1] * v[j][1]) + (v[j][2] * v[j][2] + v[j][3] * v[j][3]); }
#pragma unroll
        for (int o = 1; o < 64; o <<= 1) s += __shfl_xor(s, o);
        const float r = 1.0f / sqrtf(s * (1.f / 1024.f) + RMS_EPS);
#pragma unroll
        for (int j = 0; j < 4; ++j) { const f32x4 g = *((const GAS f32x4*)fg + F.lane + 64 * j); p[64 * j] = v[j] * r * g; }
    }
}

#ifndef PG8_ALIGN_ACT
#define PG8_ALIGN_ACT true
#endif
__global__ void __launch_bounds__(NTHR, 2) mega_fwd(Args args) {
    extern __shared__ __attribute__((aligned(16))) unsigned char lds[];
    Frame F;
    F.lds = (LAS unsigned char*)lds; F.MISC = (volatile LAS unsigned*)(F.lds + MISC_OFF);
    F.tid = threadIdx.x; F.lane = F.tid & 63; F.wave = __builtin_amdgcn_readfirstlane(F.tid >> 6);
    F.G = gridDim.x; { const int bx = blockIdx.x; F.vcu = (F.G % 8 == 0) ? (bx % 8) * (F.G / 8) + bx / 8 : bx; }
    F.ws = (GAS unsigned char*)args.ws; F.out = (GAS float*)args.out; F.ctl = (gu32*)(args.ws + WS_CTL);
    for (int u = F.tid; u < (LDS_BYTES - LDSCTL_OFF) / 4; u += NTHR) ((LAS unsigned*)(F.lds + LDSCTL_OFF))[u] = 0u;
    __syncthreads();
    if (F.tid == 0) { volatile LAS unsigned long long* t = (volatile LAS unsigned long long*)(F.lds + LDSCTL_OFF + 1024);
#pragma unroll
        for (int i = 0; i < 14; ++i) t[i] = (unsigned long long)args.in[i]; }
    __syncthreads();
    XcdBarrier bar = xcd_barrier_post((unsigned*)(F.ctl + CW_BAR), F.MISC + 8);
    const int lo = args.ph_lo, hi = args.ph_hi;
#ifndef PHMASK
#define PHMASK 0x1fff
#endif
#define IN(k) (((PHMASK >> (k)) & 1) && lo <= (k) && (k) < hi && phase_enter(F))
#define SEAM(k) do { if (IN(k) && IN((k) + 1)) xcd_barrier(bar); STAMP((k) + 1); } while (0)

    STAMP(0);
    if (IN(0)) { p0_prologue(F, args); } SEAM(0);
    if (IN(1)) {
        pg8::Gemm g{(const bf16_t*)WSP(bf16_t, WS_U0), (const bf16_t*)WSP(bf16_t, WS_W1T), M, 5120, 1024}; pg8::StaticOrder S; S.init(M, 5120, F.G, (int)blockIdx.x);
        pg8::EpiAct E{0, WSP(bf16_t, WS_A0), WSP(bf16_t, WS_A1), WSP(bf16_t, WS_A2), WSP(bf16_t, WS_A3), nullptr, nullptr, WSP(float, WS_RS0), 1};
        pg8::gemm_phase<pg8::EpiAct, pg8::StaticOrder, PG8_ALIGN_ACT, true>(F.lds, g, S, E);
    } SEAM(1);
    if (IN(2)) { for (int u = F.vcu; u < 256; u += F.G) x1_unit(F, args, u); } SEAM(2);
    if (IN(3)) { x2_scan(F); } SEAM(3);
    if (IN(4)) { for (int u = F.vcu; u < 256; u += F.G) x3_unit(F, args, u); } SEAM(4);
    if (IN(5)) {
        pg8::Gemm g{(const bf16_t*)WSP(bf16_t, WS_U0), (const bf16_t*)(WSP(bf16_t, WS_W1T) + (size_t)5120 * 1024), M, 4096, 1024}; pg8::StaticOrder S; S.init(M, 4096, F.G, (int)blockIdx.x);
        pg8::EpiAct E{1, WSP(bf16_t, WS_A0), WSP(bf16_t, WS_A1), WSP(bf16_t, WS_A2), WSP(bf16_t, WS_A3), nullptr, nullptr, WSP(float, WS_RS0), 1};
        pg8::gemm_phase<pg8::EpiAct, pg8::StaticOrder, PG8_ALIGN_ACT, true>(F.lds, g, S, E);
    } SEAM(5);
    if (IN(6)) {
        { LAS float* scr = (LAS float*)(F.lds + F.wave * 16384); const int gw = F.vcu * NWAVES + F.wave, NGW = F.G * NWAVES;
          for (int it = gw; it < 16 * 208; it += NGW) { const int kb = it / 208, d = 32 * (it % 208); transpose_item(inp(F, 8), ODD_IN, 1024, WSP(bf16_t, WS_W3T), d, map_w3(d), inp(F, 1) + 1024, scr, kb, F.lane); }
          __syncthreads(); }
        STAMP(14);
        na_phase<true, true>(F, args);
#ifdef PROBE_NA
        __syncthreads(); STAMP(15); na_phase<false, false>(F, args); __syncthreads(); STAMP(16);
#endif
    } SEAM(6);
    if (IN(7)) {
        pg8::Gemm g{(const bf16_t*)WSP(bf16_t, WS_MIX0), (const bf16_t*)WSP(bf16_t, WS_W2T), M, 1024, 2048}; pg8::StaticOrder S; S.init(M, 1024, F.G, (int)blockIdx.x);
        pg8::EpiResid E{inp(F, 0), F.out, WSP(bf16_t, WS_H1B), WSP(float, WS_PART)};
        pg8::gemm_phase<pg8::EpiResid, pg8::StaticOrder, false, true>(F.lds, g, S, E);
    } SEAM(7);
    if (IN(8)) {
        pg8::Gemm g{(const bf16_t*)WSP(bf16_t, WS_H1B), (const bf16_t*)WSP(bf16_t, WS_W3T), M, 6656, 1024}; pg8::StaticOrder S; S.init(M, 6656, F.G, (int)blockIdx.x);
        pg8::EpiAct E{2, WSP(bf16_t, WS_GQ), WSP(bf16_t, WS_GK), WSP(bf16_t, WS_GV), WSP(bf16_t, WS_GZ), WSP(bf16_t, WS_XC), WSP(bf16_t, WS_CG), WSP(float, WS_PART), 2};
        pg8::gemm_phase<pg8::EpiAct, pg8::StaticOrder, PG8_ALIGN_ACT, true>(F.lds, g, S, E);
    } SEAM(8);
    if (IN(9)) { p9_krope_conv(F, args); } SEAM(9);
    if (IN(10)) {
        const int combo = F.vcu >> 6, b = combo >> 1, kvh = combo & 1, idx = F.vcu & 63;
        if (F.vcu < 256)
#pragma unroll 1
        for (int i = 0; i < 2; ++i) { const int uu = idx * 2 + i, head = 4 * kvh + (uu >> 5), qblk = uu & 31;
            gqa::unit(WSP(bf16_t, WS_GQ), WSP(bf16_t, WS_GK) + ((size_t)kvh * M + (size_t)b * SEQ) * 128, WSP(bf16_t, WS_GV) + ((size_t)kvh * M + (size_t)b * SEQ) * 128, WSP(bf16_t, WS_GZ), WSP(bf16_t, WS_MIX1),
                      inp(F, 10), WSP(float, WS_ROPE), WSP(float, WS_ROPE) + 8192, b * SEQ + 256 * qblk, head, SEQ, (LAS char*)F.lds, F.tid); }
    } SEAM(10);
    if (IN(11)) {
        pg8::Gemm g{(const bf16_t*)WSP(bf16_t, WS_MIX1), (const bf16_t*)WSP(bf16_t, WS_W4T), M, 1024, 2048}; pg8::StaticOrder S; S.init(M, 1024, F.G, (int)blockIdx.x);
        pg8::EpiResid E{F.out, F.out, nullptr, nullptr};
        pg8::gemm_phase<pg8::EpiResid, pg8::StaticOrder, false, true>(F.lds, g, S, E);
    } SEAM(11);
    if (IN(12)) { p12_final(F, args); }
#ifdef DIAG_A
    __syncthreads(); STAMP(13); xcd_barrier(bar);
    if (blockIdx.x == 0) { unsigned* ts = (unsigned*)(F.ctl + 12288);
        asm volatile("s_waitcnt vmcnt(0)" ::: "memory");
        const unsigned a0 = __hip_atomic_load(ts + DIAG_A, __ATOMIC_RELAXED, __HIP_MEMORY_SCOPE_AGENT), a1 = __hip_atomic_load(ts + DIAG_B, __ATOMIC_RELAXED, __HIP_MEMORY_SCOPE_AGENT);
        const unsigned b0 = a0, b1 = a1;
        const float da = (float)(a1 - a0) * 0.0001f, db = (float)(b1 - b0) * 0.0001f;
        if (F.tid == 0) F.out[0] += da;
        for (int i = F.tid; i < DIAG_NB; i += NTHR) F.out[1024 + i] += db; }
#endif
#undef IN
#undef SEAM
}

extern "C" void kernel_launch(void* const* d_in, const int* in_sizes, int n_in, void* d_out, int out_size, void* d_ws, size_t ws_size, hipStream_t stream) {
    static int grid = 0;
    if (grid == 0) {
        if (n_in != 14 || in_sizes[0] != M * DM || out_size != M * DM || ws_size < WS_END) { fprintf(stderr, "kernel_launch: unexpected shapes/workspace: n_in %d in0 %d out %d ws %zu\n", n_in, n_in > 0 ? in_sizes[0] : -1, out_size, ws_size); grid = -1; return; }
        int dev = 0, cus = 0, per_cu = 0;
        if (hipGetDevice(&dev) != hipSuccess || hipDeviceGetAttribute(&cus, hipDeviceAttributeMultiprocessorCount, dev) != hipSuccess) { grid = -1; return; }
        if (hipFuncSetAttribute((const void*)mega_fwd, hipFuncAttributeMaxDynamicSharedMemorySize, LDS_BYTES) != hipSuccess) { fprintf(stderr, "kernel_launch: hipFuncSetAttribute failed\n"); grid = -1; return; }
        if (hipOccupancyMaxActiveBlocksPerMultiprocessor(&per_cu, (const void*)mega_fwd, NTHR, LDS_BYTES) != hipSuccess || per_cu < 1) { fprintf(stderr, "kernel_launch: occupancy query reports %d\n", per_cu); per_cu = 1; }
        (void)hipGetLastError();
        grid = cus;
    }
    if (grid < 0) return;
    if (hipMemsetAsync((char*)d_ws + WS_CTL, 0, CTL_ZERO_BYTES, stream) != hipSuccess) return;
    Args a{};
    for (int i = 0; i < 14; ++i) a.in[i] = (const float*)d_in[i];
    a.out = (float*)d_out; a.ws = (unsigned char*)d_ws;
#ifdef MK_SPLIT
    for (int p = 0; p < NPHASE; ++p) { a.ph_lo = p; a.ph_hi = p + 1; hipLaunchKernelGGL(mega_fwd, dim3(grid), dim3(NTHR), LDS_BYTES, stream, a); }
#else
    a.ph_lo = 0; a.ph_hi = NPHASE;
    hipLaunchKernelGGL(mega_fwd, dim3(grid), dim3(NTHR), LDS_BYTES, stream, a);
#endif
}
```
